# Optimizing an MI355X kernel written in HIP

```python
import jax, jax.numpy as jnp
from jax import lax
import numpy as np

D_MODEL = 2048
BATCH = 16
SEQ = 256
DEPTH = 2
DEC_BATCH = 2
DEC_SEQ = 4096
PAST_LEN = 512

GRID_W = 64
HEAD_DIM = 128
N_HEADS = D_MODEL // HEAD_DIM
N_KV_HEADS = N_HEADS // 4
GROUP = N_HEADS // N_KV_HEADS
WINDOW = 128
BLOCK = 128
ROPE_BASE = 10000.0
D_CONV_A = D_MODEL // 2
CONV_A_WIDTH = 31
D_CONV_B = D_MODEL // 2
CONV_B_WIDTH = 3
N_BRANCH = 3
D_FF = 5632
EPS = 1e-6
NEG_INF = -1e30
Q_DIM = N_HEADS * HEAD_DIM
KV_DIM = N_KV_HEADS * HEAD_DIM
IN_COLS = Q_DIM + 2 * KV_DIM + 2 * D_CONV_A + 3 * D_CONV_B + N_BRANCH * D_MODEL
SPLIT_IDX = (Q_DIM, Q_DIM + KV_DIM, Q_DIM + 2 * KV_DIM,
             Q_DIM + 2 * KV_DIM + 2 * D_CONV_A,
             Q_DIM + 2 * KV_DIM + 2 * D_CONV_A + 3 * D_CONV_B)
N_MOD = 9

kernel_name = "hybrid_diffusion_prefix_step"


def _rms_norm(x, g):
    xf = x.astype(jnp.float32)
    xf = xf * lax.rsqrt(jnp.mean(xf * xf, axis=-1, keepdims=True) + EPS)
    return xf.astype(x.dtype) * g


def _ada(cvec, w, b):
    m = jax.nn.silu(cvec) @ w + b
    return [t[:, None, :] for t in jnp.split(m, N_MOD, axis=-1)]


def _ffn_half(x, shift, scale, gate, g, w_in, w_out):
    h = _rms_norm(x, g) * (1 + scale) + shift
    u, v = jnp.split(h @ w_in, 2, axis=-1)
    return x + 0.5 * gate * ((jax.nn.silu(u) * v) @ w_out)


def _dwconv(x, w, width):
    pad = (width - 1) // 2
    return lax.conv_general_dilated(x, w, window_strides=(1,), padding=[(pad, pad)],
                                    dimension_numbers=('NWC', 'WIO', 'NWC'),
                                    feature_group_count=x.shape[-1])


def _rope_1d(x, ang):
    x1, x2 = jnp.split(x, 2, axis=-1)
    cos = jnp.cos(ang)[None, :, None, :]
    sin = jnp.sin(ang)[None, :, None, :]
    return jnp.concatenate([x1 * cos - x2 * sin, x2 * cos + x1 * sin], axis=-1)


def _rope_2d(x, rows):
    n_freq = HEAD_DIM // 4
    inv = ROPE_BASE ** (-jnp.arange(n_freq, dtype=jnp.float32) / n_freq)
    r = jnp.repeat(jnp.arange(rows, dtype=jnp.float32), GRID_W)
    col = jnp.tile(jnp.arange(GRID_W, dtype=jnp.float32), rows)
    xf = x.astype(jnp.float32)
    xr, xc = jnp.split(xf, 2, axis=-1)
    out = jnp.concatenate([_rope_1d(xr, r[:, None] * inv), _rope_1d(xc, col[:, None] * inv)], axis=-1)
    return out.astype(x.dtype)


def _sink_combine(parts, sink):
    b, hk, g, q = parts[0][0].shape[:4]
    sink_col = jnp.broadcast_to(sink.reshape(1, hk, g, 1, 1).astype(jnp.float32), (b, hk, g, q, 1))
    p = jax.nn.softmax(jnp.concatenate([s for s, _ in parts] + [sink_col], axis=-1), axis=-1)
    out = None
    off = 0
    for s, v in parts:
        n = s.shape[-1]
        o = jnp.einsum('bhgqk,bkhd->bqhgd', p[..., off:off + n].astype(v.dtype), v)
        out = o if out is None else out + o
        off += n
    return out


def _q_blocks(q):
    b, l = q.shape[:2]
    nblk = l // BLOCK
    qb = q.reshape(b, nblk, BLOCK, N_KV_HEADS, GROUP, HEAD_DIM) * (HEAD_DIM ** -0.5)
    return jnp.transpose(qb, (1, 0, 2, 3, 4, 5)), nblk


def _unblock(out, b, l):
    return jnp.transpose(out, (1, 0, 2, 3, 4, 5)).reshape(b, l, Q_DIM)


def _context_attention(q, k, v, sink):
    b, l = q.shape[:2]
    qb, _ = _q_blocks(q)

    def one(q_blk):
        s = jnp.einsum('bqhgd,bkhd->bhgqk', q_blk, k).astype(jnp.float32)
        return _sink_combine([(s, v)], sink)

    return _unblock(lax.map(one, qb), b, l)


def _latent_attention(q, k, v, k_ctx, v_ctx, sink):
    b, l = q.shape[:2]
    qb, nblk = _q_blocks(q)
    k_pad = jnp.pad(k, ((0, 0), (BLOCK, BLOCK), (0, 0), (0, 0)))
    v_pad = jnp.pad(v, ((0, 0), (BLOCK, BLOCK), (0, 0), (0, 0)))

    def one(args):
        q_blk, i = args
        start = i * BLOCK
        kw = lax.dynamic_slice_in_dim(k_pad, start, 3 * BLOCK, axis=1)
        vw = lax.dynamic_slice_in_dim(v_pad, start, 3 * BLOCK, axis=1)
        qp = start + jnp.arange(BLOCK)
        kp = start - BLOCK + jnp.arange(3 * BLOCK)
        valid = (kp >= 0)[None, :] & (kp < l)[None, :] & (jnp.abs(qp[:, None] - kp[None, :]) <= WINDOW)
        s_w = jnp.einsum('bqhgd,bkhd->bhgqk', q_blk, kw).astype(jnp.float32)
        s_w = jnp.where(valid, s_w, NEG_INF)
        s_c = jnp.einsum('bqhgd,bkhd->bhgqk', q_blk, k_ctx).astype(jnp.float32)
        return _sink_combine([(s_w, vw), (s_c, v_ctx)], sink)

    return _unblock(lax.map(one, (qb, jnp.arange(nblk))), b, l)


def _mix_project(x, shift, scale, g_mix, w_in):
    b, l = x.shape[:2]
    h = _rms_norm(x, g_mix) * (1 + scale) + shift
    q, k, v, a_in, bcx, gates = jnp.split(h @ w_in, SPLIT_IDX, axis=-1)
    q = q.reshape(b, l, N_HEADS, HEAD_DIM)
    k = k.reshape(b, l, N_KV_HEADS, HEAD_DIM)
    v = v.reshape(b, l, N_KV_HEADS, HEAD_DIM)
    return q, k, v, a_in, bcx, gates


def _mix_merge(x, gate, attn, a_in, bcx, gates, w_attn_o, conv_a_w, conv_a_b, g_conv_a, w_a_out,
               conv_b_w, w_b_out, w_out):
    a, a_g = jnp.split(a_in, 2, axis=-1)
    a = _dwconv(a * jax.nn.sigmoid(a_g), conv_a_w, CONV_A_WIDTH) + conv_a_b
    br_a = jax.nn.silu(_rms_norm(a, g_conv_a)) @ w_a_out
    bg, cg, xv = jnp.split(bcx, 3, axis=-1)
    br_b = (bg * _dwconv(cg * xv, conv_b_w, CONV_B_WIDTH)) @ w_b_out
    br_c = attn @ w_attn_o
    ga, gb, gc = jnp.split(jax.nn.sigmoid(gates), 3, axis=-1)
    return x + gate * ((ga * br_a + gb * br_b + gc * br_c) @ w_out)


def setup_inputs(seed: int = 0) -> dict:
    key = jax.random.key(seed)
    ks = jax.random.split(key, 26)

    def nrm(k, shape, s):
        return jax.random.normal(k, shape, jnp.float32) * s

    kv_shape = (DEC_BATCH, DEPTH, PAST_LEN, N_KV_HEADS, HEAD_DIM)
    return {
        "x_prompt": nrm(ks[0], (BATCH, SEQ, D_MODEL), 1.0),
        "x_sample": nrm(ks[1], (DEC_BATCH, DEC_SEQ, D_MODEL), 1.0),
        "cache_k": nrm(ks[2], kv_shape, 1.0),
        "cache_v": nrm(ks[3], kv_shape, 1.0),
        "c": nrm(ks[4], (DEC_BATCH, D_MODEL), 1.0),
        "c_ctx": nrm(ks[5], (D_MODEL,), 1.0),
        "w_ada": nrm(ks[6], (DEPTH, D_MODEL, N_MOD * D_MODEL), D_MODEL ** -0.5),
        "b_ada": nrm(ks[7], (DEPTH, N_MOD * D_MODEL), 0.01),
        "g_ff1": 1.0 + nrm(ks[8], (DEPTH, D_MODEL), 0.1),
        "w_ff1_in": nrm(ks[9], (DEPTH, D_MODEL, 2 * D_FF), D_MODEL ** -0.5),
        "w_ff1_out": nrm(ks[10], (DEPTH, D_FF, D_MODEL), D_FF ** -0.5),
        "g_mix": 1.0 + nrm(ks[11], (DEPTH, D_MODEL), 0.1),
        "w_in": nrm(ks[12], (DEPTH, D_MODEL, IN_COLS), D_MODEL ** -0.5),
        "attn_sink": nrm(ks[13], (DEPTH, N_HEADS), 1.0),
        "w_attn_o": nrm(ks[14], (DEPTH, Q_DIM, D_MODEL), Q_DIM ** -0.5),
        "conv_a_w": nrm(ks[15], (DEPTH, CONV_A_WIDTH, 1, D_CONV_A), CONV_A_WIDTH ** -0.5),
        "conv_a_b": nrm(ks[16], (DEPTH, D_CONV_A), 0.01),
        "g_conv_a": 1.0 + nrm(ks[17], (DEPTH, D_CONV_A), 0.1),
        "w_a_out": nrm(ks[18], (DEPTH, D_CONV_A, D_MODEL), D_CONV_A ** -0.5),
        "conv_b_w": nrm(ks[19], (DEPTH, CONV_B_WIDTH, 1, D_CONV_B), CONV_B_WIDTH ** -0.5),
        "w_b_out": nrm(ks[20], (DEPTH, D_CONV_B, D_MODEL), D_CONV_B ** -0.5),
        "w_out": nrm(ks[21], (DEPTH, D_MODEL, D_MODEL), D_MODEL ** -0.5),
        "g_ff2": 1.0 + nrm(ks[22], (DEPTH, D_MODEL), 0.1),
        "w_ff2_in": nrm(ks[23], (DEPTH, D_MODEL, 2 * D_FF), D_MODEL ** -0.5),
        "w_ff2_out": nrm(ks[24], (DEPTH, D_FF, D_MODEL), D_FF ** -0.5),
        "g_final": 1.0 + nrm(ks[25], (D_MODEL,), 0.1),
    }


def reference(x_prompt, x_sample, cache_k, cache_v, c, c_ctx, w_ada, b_ada, g_ff1, w_ff1_in,
              w_ff1_out, g_mix, w_in, attn_sink, w_attn_o, conv_a_w, conv_a_b, g_conv_a, w_a_out,
              conv_b_w, w_b_out, w_out, g_ff2, w_ff2_in, w_ff2_out, g_final):
    rows = x_sample.shape[1] // GRID_W
    xp = x_prompt
    xs = x_sample
    new_k = []
    new_v = []
    for l in range(DEPTH):
        mp = _ada(c_ctx[None, :], w_ada[l], b_ada[l])
        ms = _ada(c, w_ada[l], b_ada[l])
        merge_w = (w_attn_o[l], conv_a_w[l], conv_a_b[l], g_conv_a[l], w_a_out[l],
                   conv_b_w[l], w_b_out[l], w_out[l])
        xp = _ffn_half(xp, mp[0], mp[1], mp[2], g_ff1[l], w_ff1_in[l], w_ff1_out[l])
        q, k, v, a_in, bcx, gates = _mix_project(xp, mp[3], mp[4], g_mix[l], w_in[l])
        attn = _context_attention(q, k, v, attn_sink[l])
        xp = _mix_merge(xp, mp[5], attn, a_in, bcx, gates, *merge_w)
        xp = _ffn_half(xp, mp[6], mp[7], mp[8], g_ff2[l], w_ff2_in[l], w_ff2_out[l])
        new_k.append(k)
        new_v.append(v)
        xs = _ffn_half(xs, ms[0], ms[1], ms[2], g_ff1[l], w_ff1_in[l], w_ff1_out[l])
        q, k, v, a_in, bcx, gates = _mix_project(xs, ms[3], ms[4], g_mix[l], w_in[l])
        q = _rope_2d(q, rows)
        k = _rope_2d(k, rows)
        attn = _latent_attention(q, k, v, cache_k[:, l], cache_v[:, l], attn_sink[l])
        xs = _mix_merge(xs, ms[5], attn, a_in, bcx, gates, *merge_w)
        xs = _ffn_half(xs, ms[6], ms[7], ms[8], g_ff2[l], w_ff2_in[l], w_ff2_out[l])
    y_prompt = _rms_norm(xp, g_final)
    y_sample = _rms_norm(xs, g_final)
    new_cache_k = jnp.stack(new_k, axis=1)
    new_cache_v = jnp.stack(new_v, axis=1)
    return (y_prompt, y_sample, new_cache_k, new_cache_v)
```

```cpp
#include <hip/hip_runtime.h>
#include <cstdint>
#include <cstdio>

typedef unsigned short bf16;
typedef short bf16x8 __attribute__((ext_vector_type(8)));
typedef float f32x16 __attribute__((ext_vector_type(16)));
typedef float f32x4 __attribute__((ext_vector_type(4)));

constexpr int D = 2048, MC = 4096, ML = 8192, M = MC + ML, DFF = 5632, NMOD = 9 * D, INC = 14336;
constexpr int SEQC = 256, SEQL = 4096, PAST = 512, KVD = 512, DCA = 1024;
constexpr float EPS = 1e-6f;
constexpr size_t MiB = 1u << 20;
constexpr size_t WS_MOD = 1 * MiB, WS_CK = 3 * MiB, WS_CV = 5 * MiB, WS_X = 8 * MiB, WS_H = 104 * MiB;
constexpr size_t WS_ACT = 152 * MiB;
constexpr size_t WS_Q = 152 * MiB, WS_K = 200 * MiB, WS_V = 212 * MiB, WS_GLU = 224 * MiB, WS_BG = 248 * MiB, WS_CX = 272 * MiB, WS_GATES = 296 * MiB;
constexpr size_t WS_ATT = 440 * MiB, WS_CA = 488 * MiB, WS_CB = 512 * MiB, WS_MIX = 536 * MiB;
constexpr size_t WS_ZQKV = 440 * MiB;
constexpr size_t WS_TMP = 152 * MiB;

__device__ __forceinline__ unsigned f2bf(float f) { unsigned u = __builtin_bit_cast(unsigned, f); return (u + 0x7fffu + ((u >> 16) & 1u)) >> 16; }
__device__ __forceinline__ float bf2f(bf16 b) { return __builtin_bit_cast(float, (unsigned)b << 16); }
__device__ __forceinline__ int crow(int r, int hi) { return (r & 3) + 8 * (r >> 2) + 4 * hi; }
__device__ __forceinline__ float silu_f(float x) { return x / (1.f + expf(-x)); }
__device__ __forceinline__ float sigm_f(float x) { return 1.f / (1.f + expf(-x)); }
__device__ __forceinline__ int cond_of(int m) { return m < MC ? 0 : (m < MC + SEQL ? 1 : 2); }
__device__ __forceinline__ float wave_sum(float v) {
#pragma unroll
    for (int o = 1; o < 64; o <<= 1) v += __shfl_xor(v, o);
    return v;
}
__device__ __forceinline__ float wave_max(float v) {
#pragma unroll
    for (int o = 1; o < 64; o <<= 1) v = fmaxf(v, __shfl_xor(v, o));
    return v;
}

__global__ __launch_bounds__(256) void ng_ada(const float* c_ctx, const float* c, const float* w_ada, const float* b_ada, float* MOD) {
    __shared__ float sv[3][D];
    for (int i = threadIdx.x; i < D; i += 256) { sv[0][i] = silu_f(c_ctx[i]); sv[1][i] = silu_f(c[i]); sv[2][i] = silu_f(c[D + i]); }
    __syncthreads();
    const int idx = blockIdx.x * 256 + threadIdx.x, l = idx / NMOD, j = idx % NMOD;
    const float* w = w_ada + (size_t)l * D * NMOD + j;
    float a0 = 0.f, a1 = 0.f, a2 = 0.f;
#pragma unroll 8
    for (int k = 0; k < D; ++k) { const float x = w[(size_t)k * NMOD]; a0 += sv[0][k] * x; a1 += sv[1][k] * x; a2 += sv[2][k] * x; }
    const float b = b_ada[l * NMOD + j];
    MOD[(size_t)(l * 3 + 0) * NMOD + j] = a0 + b; MOD[(size_t)(l * 3 + 1) * NMOD + j] = a1 + b; MOD[(size_t)(l * 3 + 2) * NMOD + j] = a2 + b;
}
__global__ void ng_copy_x(const float* xp, const float* xs, float* X) {
    const size_t i = (size_t)blockIdx.x * 256 + threadIdx.x;
    const size_t n4c = (size_t)MC * D / 4;
    const f32x4 v = i < n4c ? ((const f32x4*)xp)[i] : ((const f32x4*)xs)[i - n4c];
    ((f32x4*)X)[i] = v;
}
__global__ void ng_cvt(const float* a, bf16* o, size_t n) {
    const size_t i = (size_t)blockIdx.x * 256 + threadIdx.x; if (i < n) o[i] = (bf16)f2bf(a[i]);
}
__global__ __launch_bounds__(256) void ng_norm_mod(const float* X, const float* g, const float* MODl  , int sub, bf16* H) {
    const int wave = threadIdx.x >> 6, lane = threadIdx.x & 63, m = blockIdx.x * 4 + wave;
    const float* x = X + (size_t)m * D; float ss = 0.f;
    for (int i = lane; i < D; i += 64) ss += x[i] * x[i];
    const float r = rsqrtf(wave_sum(ss) * (1.f / D) + EPS);
    const float* mod = MODl + (size_t)cond_of(m) * NMOD + (size_t)sub * 3 * D;
    for (int i = lane; i < D; i += 64) H[(size_t)m * D + i] = (bf16)f2bf(x[i] * r * g[i] * (1.f + mod[D + i]) + mod[i]);
}
__global__ __launch_bounds__(256) void ng_final_norm(const float* X, const float* g, float* out) {
    const int wave = threadIdx.x >> 6, lane = threadIdx.x & 63, m = blockIdx.x * 4 + wave;
    const float* x = X + (size_t)m * D; float ss = 0.f;
    for (int i = lane; i < D; i += 64) ss += x[i] * x[i];
    const float r = rsqrtf(wave_sum(ss) * (1.f / D) + EPS);
    for (int i = lane; i < D; i += 64) out[(size_t)m * D + i] = x[i] * r * g[i];
}
enum { OP_SWIGLU = 0, OP_RESID = 1, OP_F32 = 2, OP_GLU = 3, OP_MUL = 4, OP_BF16 = 5, OP_SIGMOID = 6, OP_GACC = 7 };
struct NG { const bf16* A; int lda; const float* W; int ldw; int colA, colB, K; void* out; int ldo, ocol; const float* gate; float coef; const bf16* G; int ldg, gcol, first; };
template <int OP> __global__ __launch_bounds__(256) void ng_gemm(NG p) {
    constexpr bool PAIR = (OP == OP_SWIGLU || OP == OP_GLU || OP == OP_MUL);
    const int wave = threadIdx.x >> 6, lane = threadIdx.x & 63, r32 = lane & 31, hi = lane >> 5;
    const int n0 = blockIdx.x * 32, m0 = blockIdx.y * 128 + wave * 32;
    f32x16 acc = {}, acc2 = {};
    const bf16* arow = p.A + (size_t)(m0 + r32) * p.lda + 8 * hi;
    const float* w1 = p.W + (size_t)(8 * hi) * p.ldw + p.colA + n0 + r32;
    const float* w2 = p.W + (size_t)(8 * hi) * p.ldw + p.colB + n0 + r32;
    for (int k0 = 0; k0 < p.K; k0 += 16) {
        const bf16x8 a = *(const bf16x8*)(arow + k0);
        bf16x8 b;
#pragma unroll
        for (int j = 0; j < 8; ++j) b[j] = (short)f2bf(w1[(size_t)(k0 + j) * p.ldw]);
        acc = __builtin_amdgcn_mfma_f32_32x32x16_bf16(a, b, acc, 0, 0, 0);
        if (PAIR) {
            bf16x8 b2;
#pragma unroll
            for (int j = 0; j < 8; ++j) b2[j] = (short)f2bf(w2[(size_t)(k0 + j) * p.ldw]);
            acc2 = __builtin_amdgcn_mfma_f32_32x32x16_bf16(a, b2, acc2, 0, 0, 0);
        }
    }
#pragma unroll
    for (int r = 0; r < 16; ++r) {
        const int row = m0 + crow(r, hi), col = n0 + r32; const float v = acc[r], v2 = acc2[r];
        const size_t oi = (size_t)row * p.ldo + p.ocol + col;
        if (OP == OP_SWIGLU) ((bf16*)p.out)[oi] = (bf16)f2bf(silu_f(v) * v2);
        else if (OP == OP_GLU) ((bf16*)p.out)[oi] = (bf16)f2bf(v * sigm_f(v2));
        else if (OP == OP_MUL) ((bf16*)p.out)[oi] = (bf16)f2bf(v * v2);
        else if (OP == OP_BF16) ((bf16*)p.out)[oi] = (bf16)f2bf(v);
        else if (OP == OP_SIGMOID) ((bf16*)p.out)[oi] = (bf16)f2bf(sigm_f(v));
        else if (OP == OP_F32) ((float*)p.out)[oi] = v;
        else if (OP == OP_RESID) ((float*)p.out)[oi] += p.coef * p.gate[(size_t)cond_of(row) * NMOD + col] * v;
        else if (OP == OP_GACC) { const float gt = bf2f(p.G[(size_t)row * p.ldg + p.gcol + col]); float* o = (float*)p.out + oi; *o = (p.first ? 0.f : *o) + gt * v; }
    }
}
__global__ __launch_bounds__(256) void ng_rope_split(const float* Z, bf16* Qb, bf16* Kb, bf16* Vb, float* nk, float* nv, int layer) {
    const size_t idx = (size_t)blockIdx.x * 256 + threadIdx.x; const int m = (int)(idx / 3072), col = (int)(idx % 3072);
    const float* z = Z + (size_t)m * 3072; float v = z[col];
    if (col < 2560 && m >= MC) {
        const int t = (m - MC) % SEQL, d = col & 127, part = d >> 6, i = d & 31, isx2 = (d >> 5) & 1;
        const float pos = (float)(part == 0 ? t / 64 : t % 64), inv = powf(10000.f, -(float)i / 32.f), ang = pos * inv;
        const float cs = cosf(ang), sn = sinf(ang);
        const float x1 = z[col - 32 * isx2], x2 = z[col + 32 * (1 - isx2)];
        v = isx2 ? (x2 * cs + x1 * sn) : (x1 * cs - x2 * sn);
    }
    if (col < 2048) Qb[(size_t)m * D + col] = (bf16)f2bf(v);
    else if (col < 2560) { Kb[(size_t)m * KVD + col - 2048] = (bf16)f2bf(v); if (m < MC) { const int b = m / SEQC, s = m % SEQC; nk[((size_t)(b * 2 + layer) * SEQC + s) * KVD + col - 2048] = v; } }
    else { Vb[(size_t)m * KVD + col - 2560] = (bf16)f2bf(v); if (m < MC) { const int b = m / SEQC, s = m % SEQC; nv[((size_t)(b * 2 + layer) * SEQC + s) * KVD + col - 2560] = v; } }
}
__global__ __launch_bounds__(256) void ng_attn(const bf16* Qb, const bf16* Kb, const bf16* Vb, const bf16* CK, const bf16* CV, const float* sink, bf16* ATT, int layer) {
    __shared__ float sc[4][1024]; __shared__ float qs[4][128];
    const int wave = threadIdx.x >> 6, lane = threadIdx.x & 63, gw = blockIdx.x * 4 + wave, m = gw >> 4, h = gw & 15, kvh = h >> 2;
    qs[wave][2 * lane] = bf2f(Qb[(size_t)m * D + h * 128 + 2 * lane]); qs[wave][2 * lane + 1] = bf2f(Qb[(size_t)m * D + h * 128 + 2 * lane + 1]);
    int nwin, win0, nctx; size_t cbase = 0;
    if (m < MC) { win0 = (m / SEQC) * SEQC; nwin = SEQC; nctx = 0; }
    else { const int b = (m - MC) / SEQL, t = (m - MC) % SEQL, lo = t - 128 < 0 ? 0 : t - 128, hi = t + 128 > SEQL - 1 ? SEQL - 1 : t + 128;
        nwin = hi - lo + 1; win0 = MC + b * SEQL + lo; nctx = PAST; cbase = (size_t)(b * 2 + layer) * PAST * KVD; }
    const int total = nwin + nctx;
    __syncthreads();
    float mx = -3e38f;
    for (int j = lane; j < total; j += 64) {
        const bf16* kr = j < nwin ? Kb + (size_t)(win0 + j) * KVD + kvh * 128 : CK + cbase + (size_t)(j - nwin) * KVD + kvh * 128;
        float s = 0.f;
        for (int d = 0; d < 128; ++d) s += qs[wave][d] * bf2f(kr[d]);
        s *= 0.08838834764831845f; sc[wave][j] = s; mx = fmaxf(mx, s);
    }
    const float sk = sink[h];
    mx = fmaxf(wave_max(mx), sk);
    float sum = 0.f;
    for (int j = lane; j < total; j += 64) { const float pj = expf(sc[wave][j] - mx); sc[wave][j] = pj; sum += pj; }
    sum = wave_sum(sum) + expf(sk - mx);
    __syncthreads();
    float o0 = 0.f, o1 = 0.f;
    for (int j = 0; j < total; ++j) {
        const bf16* vr = j < nwin ? Vb + (size_t)(win0 + j) * KVD + kvh * 128 : CV + cbase + (size_t)(j - nwin) * KVD + kvh * 128;
        const float pj = sc[wave][j]; o0 += pj * bf2f(vr[2 * lane]); o1 += pj * bf2f(vr[2 * lane + 1]);
    }
    const float rs = 1.f / sum;
    ATT[(size_t)m * D + h * 128 + 2 * lane] = (bf16)f2bf(o0 * rs); ATT[(size_t)m * D + h * 128 + 2 * lane + 1] = (bf16)f2bf(o1 * rs);
}
__global__ __launch_bounds__(256) void ng_conv_a(const bf16* GLU, const float* w, const float* bias, const float* g, bf16* CA) {
    __shared__ float red[4];
    const int m = blockIdx.x, s0 = m < MC ? (m / SEQC) * SEQC : MC + ((m - MC) / SEQL) * SEQL, L = m < MC ? SEQC : SEQL, pos = m - s0;
    float a[4]; float ss = 0.f;
#pragma unroll
    for (int i = 0; i < 4; ++i) { const int c = threadIdx.x + 256 * i; float acc = bias[c];
        for (int t = 0; t < 31; ++t) { const int p = pos + t - 15; if (p >= 0 && p < L) acc += bf2f(GLU[(size_t)(s0 + p) * DCA + c]) * w[t * DCA + c]; }
        a[i] = acc; ss += acc * acc; }
    ss = wave_sum(ss); if ((threadIdx.x & 63) == 0) red[threadIdx.x >> 6] = ss; __syncthreads();
    const float r = rsqrtf((red[0] + red[1] + red[2] + red[3]) * (1.f / DCA) + EPS);
#pragma unroll
    for (int i = 0; i < 4; ++i) { const int c = threadIdx.x + 256 * i; CA[(size_t)m * DCA + c] = (bf16)f2bf(silu_f(a[i] * r * g[c])); }
}
__global__ __launch_bounds__(256) void ng_conv_b(const bf16* BG, const bf16* CX, const float* w, bf16* CB) {
    const int m = blockIdx.x, s0 = m < MC ? (m / SEQC) * SEQC : MC + ((m - MC) / SEQL) * SEQL, L = m < MC ? SEQC : SEQL, pos = m - s0;
#pragma unroll
    for (int i = 0; i < 4; ++i) { const int c = threadIdx.x + 256 * i; float acc = 0.f;
        for (int t = 0; t < 3; ++t) { const int p = pos + t - 1; if (p >= 0 && p < L) acc += bf2f(CX[(size_t)(s0 + p) * DCA + c]) * w[t * DCA + c]; }
        CB[(size_t)m * DCA + c] = (bf16)f2bf(bf2f(BG[(size_t)m * DCA + c]) * acc); }
}

template <int OP> static void run_gemm(hipStream_t s, int Ncols, const bf16* A, int lda, const float* W, int ldw, int colA, int colB, int K, void* out, int ldo, int ocol,
                                       const float* gate = nullptr, float coef = 0.f, const bf16* G = nullptr, int ldg = 0, int gcol = 0, int first = 0) {
    NG p{}; p.A = A; p.lda = lda; p.W = W; p.ldw = ldw; p.colA = colA; p.colB = colB; p.K = K; p.out = out; p.ldo = ldo; p.ocol = ocol; p.gate = gate; p.coef = coef; p.G = G; p.ldg = ldg; p.gcol = gcol; p.first = first;
    hipLaunchKernelGGL(ng_gemm<OP>, dim3(Ncols / 32, M / 128), dim3(256), 0, s, p);
}
extern "C" void kernel_launch(void* const* d_in, const int* in_sizes, int n_in, void* d_out, int out_size, void* d_ws, size_t ws_size, hipStream_t stream) {
    const float* x_prompt = (const float*)d_in[0]; const float* x_sample = (const float*)d_in[1]; const float* cache_k = (const float*)d_in[2]; const float* cache_v = (const float*)d_in[3];
    const float* c = (const float*)d_in[4]; const float* c_ctx = (const float*)d_in[5]; const float* w_ada = (const float*)d_in[6]; const float* b_ada = (const float*)d_in[7];
    const float* g_ff1 = (const float*)d_in[8]; const float* w_ff1_in = (const float*)d_in[9]; const float* w_ff1_out = (const float*)d_in[10]; const float* g_mix = (const float*)d_in[11];
    const float* w_in = (const float*)d_in[12]; const float* attn_sink = (const float*)d_in[13]; const float* w_attn_o = (const float*)d_in[14]; const float* conv_a_w = (const float*)d_in[15];
    const float* conv_a_b = (const float*)d_in[16]; const float* g_conv_a = (const float*)d_in[17]; const float* w_a_out = (const float*)d_in[18]; const float* conv_b_w = (const float*)d_in[19];
    const float* w_b_out = (const float*)d_in[20]; const float* w_out = (const float*)d_in[21]; const float* g_ff2 = (const float*)d_in[22]; const float* w_ff2_in = (const float*)d_in[23];
    const float* w_ff2_out = (const float*)d_in[24]; const float* g_final = (const float*)d_in[25];
    char* ws = (char*)d_ws; float* out = (float*)d_out;
    float* MOD = (float*)(ws + WS_MOD); bf16* CK = (bf16*)(ws + WS_CK); bf16* CV = (bf16*)(ws + WS_CV); float* X = (float*)(ws + WS_X); bf16* H = (bf16*)(ws + WS_H);
    bf16* ACT = (bf16*)(ws + WS_ACT); bf16* Qb = (bf16*)(ws + WS_Q); bf16* Kb = (bf16*)(ws + WS_K); bf16* Vb = (bf16*)(ws + WS_V); bf16* GLU = (bf16*)(ws + WS_GLU);
    bf16* BG = (bf16*)(ws + WS_BG); bf16* CX = (bf16*)(ws + WS_CX); bf16* GATES = (bf16*)(ws + WS_GATES); bf16* ATT = (bf16*)(ws + WS_ATT); bf16* CA = (bf16*)(ws + WS_CA);
    bf16* CB = (bf16*)(ws + WS_CB); bf16* MIX = (bf16*)(ws + WS_MIX); float* ZQKV = (float*)(ws + WS_ZQKV); float* TMP = (float*)(ws + WS_TMP);
    float* y_prompt = out; float* new_k = out + (size_t)M * D; float* new_v = new_k + (size_t)16 * 2 * SEQC * KVD;
    (void)y_prompt;

    hipLaunchKernelGGL(ng_ada, dim3(2 * NMOD / 256), dim3(256), 0, stream, c_ctx, c, w_ada, b_ada, MOD);
    hipLaunchKernelGGL(ng_copy_x, dim3((size_t)M * D / 4 / 256), dim3(256), 0, stream, x_prompt, x_sample, X);
    { const size_t n = (size_t)2 * 2 * PAST * KVD; hipLaunchKernelGGL(ng_cvt, dim3((n + 255) / 256), dim3(256), 0, stream, cache_k, CK, n); hipLaunchKernelGGL(ng_cvt, dim3((n + 255) / 256), dim3(256), 0, stream, cache_v, CV, n); }
    for (int l = 0; l < 2; ++l) {
        const float* MODl = MOD + (size_t)l * 3 * NMOD;
        const float* W1i = w_ff1_in + (size_t)l * D * 2 * DFF; const float* W1o = w_ff1_out + (size_t)l * DFF * D;
        const float* W2i = w_ff2_in + (size_t)l * D * 2 * DFF; const float* W2o = w_ff2_out + (size_t)l * DFF * D;
        const float* Wi = w_in + (size_t)l * D * INC;
        hipLaunchKernelGGL(ng_norm_mod, dim3(M / 4), dim3(256), 0, stream, X, g_ff1 + l * D, MODl, 0, H);
        run_gemm<OP_SWIGLU>(stream, DFF, H, D, W1i, 2 * DFF, 0, DFF, D, ACT, DFF, 0);
        run_gemm<OP_RESID>(stream, D, ACT, DFF, W1o, D, 0, 0, DFF, X, D, 0, MODl + 2 * D, 0.5f);
        hipLaunchKernelGGL(ng_norm_mod, dim3(M / 4), dim3(256), 0, stream, X, g_mix + l * D, MODl, 1, H);
        run_gemm<OP_F32>(stream, 3072, H, D, Wi, INC, 0, 0, D, ZQKV, 3072, 0);
        hipLaunchKernelGGL(ng_rope_split, dim3((size_t)M * 3072 / 256), dim3(256), 0, stream, ZQKV, Qb, Kb, Vb, new_k, new_v, l);
        run_gemm<OP_GLU>(stream, 1024, H, D, Wi, INC, 3072, 4096, D, GLU, DCA, 0);
        run_gemm<OP_BF16>(stream, 1024, H, D, Wi, INC, 5120, 0, D, BG, DCA, 0);
        run_gemm<OP_MUL>(stream, 1024, H, D, Wi, INC, 6144, 7168, D, CX, DCA, 0);
        run_gemm<OP_SIGMOID>(stream, 6144, H, D, Wi, INC, 8192, 0, D, GATES, 6144, 0);
        hipLaunchKernelGGL(ng_attn, dim3(M * 16 / 4), dim3(256), 0, stream, Qb, Kb, Vb, CK, CV, attn_sink + l * 16, ATT, l);
        hipLaunchKernelGGL(ng_conv_a, dim3(M), dim3(256), 0, stream, GLU, conv_a_w + l * 31 * DCA, conv_a_b + l * DCA, g_conv_a + l * DCA, CA);
        hipLaunchKernelGGL(ng_conv_b, dim3(M), dim3(256), 0, stream, BG, CX, conv_b_w + l * 3 * DCA, CB);
        run_gemm<OP_GACC>(stream, D, CA, DCA, w_a_out + (size_t)l * DCA * D, D, 0, 0, DCA, TMP, D, 0, nullptr, 0.f, GATES, 6144, 0, 1);
        run_gemm<OP_GACC>(stream, D, CB, DCA, w_b_out + (size_t)l * DCA * D, D, 0, 0, DCA, TMP, D, 0, nullptr, 0.f, GATES, 6144, 2048, 0);
        run_gemm<OP_GACC>(stream, D, ATT, D, w_attn_o + (size_t)l * D * D, D, 0, 0, D, TMP, D, 0, nullptr, 0.f, GATES, 6144, 4096, 0);
        hipLaunchKernelGGL(ng_cvt, dim3((size_t)M * D / 256), dim3(256), 0, stream, TMP, MIX, (size_t)M * D);
        run_gemm<OP_RESID>(stream, D, MIX, D, w_out + (size_t)l * D * D, D, 0, 0, D, X, D, 0, MODl + 5 * D, 1.0f);
        hipLaunchKernelGGL(ng_norm_mod, dim3(M / 4), dim3(256), 0, stream, X, g_ff2 + l * D, MODl, 2, H);
        run_gemm<OP_SWIGLU>(stream, DFF, H, D, W2i, 2 * DFF, 0, DFF, D, ACT, DFF, 0);
        run_gemm<OP_RESID>(stream, D, ACT, DFF, W2o, D, 0, 0, DFF, X, D, 0, MODl + 8 * D, 0.5f);
    }
    hipLaunchKernelGGL(ng_final_norm, dim3(M / 4), dim3(256), 0, stream, X, g_final, out);
}
```

```cpp
#include <hip/hip_runtime.h>
#include <cstdio>
#include <cstdint>

#ifndef MK_PER_PHASE
#define MK_PER_PHASE 0
#endif
constexpr int D = 2048, MC = 4096, ML = 8192, M = MC + ML, DFF = 5632, NMOD = 9 * D, INC = 14336;
constexpr int SEQC = 256, SEQL = 4096, PAST = 512, KVD = 512, DCA = 1024;
constexpr float EPS = 1e-6f;
constexpr size_t MiB = 1u << 20;
constexpr size_t WS_CTL = 0, CTL_ZERO_BYTES = 1 * MiB;
constexpr size_t WS_MOD = 1 * MiB, WS_ROPE = 2 * MiB, WS_CK = 3 * MiB, WS_CV = 5 * MiB, WS_X = 8 * MiB, WS_H = 104 * MiB;
constexpr size_t WS_ACT = 152 * MiB;
constexpr size_t WS_Q = 152 * MiB, WS_K = 200 * MiB, WS_V = 212 * MiB, WS_GLU = 224 * MiB, WS_BG = 248 * MiB, WS_CX = 272 * MiB, WS_GATES = 296 * MiB;
constexpr size_t WS_ATT = 440 * MiB, WS_CA = 488 * MiB, WS_CB = 512 * MiB, WS_MIX = 536 * MiB;
constexpr size_t WS_TMP = 152 * MiB;
constexpr size_t WS_WT = 584 * MiB, WT_LAYER = 212 * MiB;
constexpr size_t WT_1I = 0, WT_1O = 44 * MiB, WT_IN = 66 * MiB, WT_AO = 122 * MiB, WT_A = 130 * MiB, WT_B = 134 * MiB, WT_OUT = 138 * MiB, WT_2I = 146 * MiB, WT_2O = 190 * MiB;
constexpr size_t WS_END = WS_WT + 2 * WT_LAYER;
constexpr int CW_BAR = 4096;

__device__ __forceinline__ int fresh_tid() { int t = threadIdx.x; asm volatile("" : "+v"(t)); return t; }

namespace pg8 {
#define PG8_LAS __attribute__((address_space(3)))
typedef unsigned short bf16_t;
typedef short bf16x8 __attribute__((ext_vector_type(8)));
typedef float f32x4 __attribute__((ext_vector_type(4)));
typedef unsigned u32x4 __attribute__((ext_vector_type(4)));
constexpr int BM = 256, BK = 64, HALF = 128, HTB = HALF * BK * 2  , STAGE_BYTES = 8 * HTB, NXCD = 8, WGM = 8;

__host__ __device__ __forceinline__ int lds_byte(int r, int c) { const int st = (r >> 4) * 2 + (c >> 5), rr = r & 15, cc = c & 31, ob = rr * 64 + cc * 2; return st * 1024 + (ob ^ (((ob >> 9) & 1) << 5)); }
__host__ __device__ __forceinline__ void stage_rc(int b, int& R, int& C) { const int st = b / 1024, sb = b % 1024, swz = sb ^ (((sb >> 9) & 1) << 5); R = (st >> 1) * 16 + swz / 64; C = (st & 1) * 32 + (swz % 64) / 2; }
__host__ __device__ __forceinline__ int perm32(int rho) { const int n = rho >> 4, i = rho & 15; return 8 * (i >> 2) + 4 * n + (i & 3); }

struct Unit { int pm, pn; };
struct Gemm { const bf16_t* A; const bf16_t* Bt; int M, N, K; };

struct StaticOrder {
    int nM, nN, nwg, G, c;
    __host__ __device__ void init(int M, int N, int G_, int c_) { nM = M / BM; nN = N / BM; nwg = nM * nN; G = G_; c = c_; }
    __host__ __device__ bool next(int i, Unit& u) const {
        const long L = (long)i * G + c; if (L >= nwg) return false;
        int wgid = (int)L; { const int q = nwg / NXCD, r = nwg % NXCD, xcd = wgid % NXCD, off = wgid / NXCD; wgid = (xcd < r ? xcd * (q + 1) : r * (q + 1) + (xcd - r) * q) + off; }
        const int nig = WGM * nN, gid = wgid / nig, fm = gid * WGM, gsz = (nM - fm) < WGM ? (nM - fm) : WGM;
        u.pm = fm + ((wgid % nig) % gsz); u.pn = (wgid % nig) / gsz; return true;
    }
    __device__ __forceinline__ void a_ready(const Unit&) const {}
    __device__ __forceinline__ void done(const Unit&) const {}
};

__device__ __forceinline__ unsigned cvt_pk_bf16(float lo, float hi) { unsigned r; asm volatile("v_cvt_pk_bf16_f32 %0, %1, %2" : "=v"(r) : "v"(lo), "v"(hi)); return r; }
typedef float f32x2 __attribute__((ext_vector_type(2)));
__device__ __forceinline__ f32x2 gelu_pk(f32x2 v) {
    const f32x2 av = __builtin_elementwise_abs(v), d = av * 0.2316418882f + 1.0f;
    f32x2 t; t.x = __builtin_amdgcn_rcpf(d.x); t.y = __builtin_amdgcn_rcpf(d.y);
    f32x2 q = t * 0.5307027145f + (-0.7265760135f); q = q * t + 0.7107068705f; q = q * t + (-0.142248368f); q = q * t + 0.127414796f; q = q * t;
    const f32x2 s = (v * v) * (-0.72134752044f);
    f32x2 e; e.x = __builtin_amdgcn_exp2f(s.x); e.y = __builtin_amdgcn_exp2f(s.y);
    const f32x2 m = v * (q * e), r = v - m;
    f32x2 o; o.x = v.x < 0.f ? m.x : r.x; o.y = v.y < 0.f ? m.y : r.y; return o;
}

__device__ __forceinline__ float fsigm(float x) { return __builtin_amdgcn_rcpf(1.f + __builtin_amdgcn_exp2f(-1.4426950408889634f * x)); }
__device__ __forceinline__ float fsilu(float x) { return x * fsigm(x); }
__device__ __forceinline__ u32x4 pack8(f32x4 a, f32x4 b) { u32x4 w; w.x = cvt_pk_bf16(a[0], a[1]); w.y = cvt_pk_bf16(a[2], a[3]); w.z = cvt_pk_bf16(b[0], b[1]); w.w = cvt_pk_bf16(b[2], b[3]); return w; }
__device__ __forceinline__ void unpack8(u32x4 w, f32x4& a, f32x4& b) {
    a[0] = __builtin_bit_cast(float, w.x << 16); a[1] = __builtin_bit_cast(float, w.x & 0xffff0000u); a[2] = __builtin_bit_cast(float, w.y << 16); a[3] = __builtin_bit_cast(float, w.y & 0xffff0000u);
    b[0] = __builtin_bit_cast(float, w.z << 16); b[1] = __builtin_bit_cast(float, w.z & 0xffff0000u); b[2] = __builtin_bit_cast(float, w.w << 16); b[3] = __builtin_bit_cast(float, w.w & 0xffff0000u);
}
enum { PO_SWIGLU = 0, PO_GLU = 1, PO_MUL = 2 };
template <int OP> __device__ __forceinline__ f32x4 pair_op(f32x4 a, f32x4 b) {
    f32x4 o;
#pragma unroll
    for (int e = 0; e < 4; ++e) o[e] = OP == PO_SWIGLU ? fsilu(a[e]) * b[e] : (OP == PO_GLU ? a[e] * fsigm(b[e]) : a[e] * b[e]);
    return o;
}
struct EpiSwiglu {
    static constexpr bool PERM = true, AFTER_DRAIN = false;
    bf16_t* O; int ldc;
    __device__ __forceinline__ void operator()(const f32x4 (&acc)[2][2][4][2], const Unit& u, int wr, int wc, int fr, int fq) const {
        const int row0 = u.pm * BM + wr * 64 + fr, col0 = u.pn * HALF + wc * 32 + 8 * fq;
#pragma unroll
        for (int ai = 0; ai < 2; ++ai)
#pragma unroll
            for (int m = 0; m < 4; ++m) {
                bf16_t* rowp = O + (size_t)(row0 + ai * HALF + m * 16) * ldc + col0;
                *(u32x4*)rowp = pack8(pair_op<PO_SWIGLU>(acc[ai][0][m][0], acc[ai][1][m][0]), pair_op<PO_SWIGLU>(acc[ai][0][m][1], acc[ai][1][m][1]));
            }
    }
};
struct EpiResid {
    static constexpr bool PERM = true, AFTER_DRAIN = false;
    float* X; const float* gate; float coef;
    __device__ __forceinline__ void operator()(const f32x4 (&acc)[2][2][4][2], const Unit& u, int wr, int wc, int fr, int fq) const {
        const int row0 = u.pm * BM + wr * 64 + fr, col0 = u.pn * BM + wc * 32 + 8 * fq;
        const int cond = u.pm < 16 ? 0 : (u.pm < 32 ? 1 : 2);
        const float* gp = gate + (size_t)cond * NMOD + col0;
        f32x4 g[2][2];
#pragma unroll
        for (int bj = 0; bj < 2; ++bj)
#pragma unroll
            for (int n = 0; n < 2; ++n) g[bj][n] = *(const f32x4*)(gp + bj * HALF + 4 * n) * coef;
#pragma unroll
        for (int ai = 0; ai < 2; ++ai)
#pragma unroll
            for (int m = 0; m < 4; ++m) {
                float* rowp = X + (size_t)(row0 + ai * HALF + m * 16) * D + col0;
#pragma unroll
                for (int bj = 0; bj < 2; ++bj)
#pragma unroll
                    for (int n = 0; n < 2; ++n) { f32x4* p = (f32x4*)(rowp + bj * HALF + 4 * n); *p = *p + g[bj][n] * acc[ai][bj][m][n]; }
            }
    }
};
struct EpiWin {
    static constexpr bool PERM = true, AFTER_DRAIN = false;
    bf16_t *Qb, *Kb, *Vb, *GLU, *BG, *CX, *GATES; float* nk; float* nv; const float* rope; int layer;
    __device__ __forceinline__ void operator()(const f32x4 (&acc)[2][2][4][2], const Unit& u, int wr, int wc, int fr, int fq) const {
        const int pn = u.pn, row0 = u.pm * BM + wr * 64 + fr, cw = wc * 32 + 8 * fq;
        const bool latent = u.pm >= 16;
        if (pn < 10) {
            const bool isq = pn < 8; const int hp = isq ? pn : pn - 8;
            const int ocol = (2 * hp + (wc >> 1)) * 128 + 64 * (wc & 1) + 8 * fq;
            bf16_t* base = isq ? Qb : Kb; const int ld = isq ? D : KVD;
#pragma unroll
            for (int ai = 0; ai < 2; ++ai)
#pragma unroll
                for (int m = 0; m < 4; ++m) {
                    const int row = row0 + ai * HALF + m * 16;
                    const f32x4 x1a = acc[ai][0][m][0], x1b = acc[ai][0][m][1], x2a = acc[ai][1][m][0], x2b = acc[ai][1][m][1];
                    f32x4 o1a = x1a, o1b = x1b, o2a = x2a, o2b = x2b;
                    if (latent) {
                        const int t = (row - MC) & (SEQL - 1), pos = (wc & 1) ? (t & 63) : (t >> 6);
                        const f32x4* rp = (const f32x4*)(rope + ((size_t)pos * 32 + 8 * fq) * 2);
                        const f32x4 r0 = rp[0], r1 = rp[1], r2 = rp[2], r3 = rp[3];
                        o1a[0] = x1a[0] * r0[0] - x2a[0] * r0[1]; o2a[0] = x2a[0] * r0[0] + x1a[0] * r0[1];
                        o1a[1] = x1a[1] * r0[2] - x2a[1] * r0[3]; o2a[1] = x2a[1] * r0[2] + x1a[1] * r0[3];
                        o1a[2] = x1a[2] * r1[0] - x2a[2] * r1[1]; o2a[2] = x2a[2] * r1[0] + x1a[2] * r1[1];
                        o1a[3] = x1a[3] * r1[2] - x2a[3] * r1[3]; o2a[3] = x2a[3] * r1[2] + x1a[3] * r1[3];
                        o1b[0] = x1b[0] * r2[0] - x2b[0] * r2[1]; o2b[0] = x2b[0] * r2[0] + x1b[0] * r2[1];
                        o1b[1] = x1b[1] * r2[2] - x2b[1] * r2[3]; o2b[1] = x2b[1] * r2[2] + x1b[1] * r2[3];
                        o1b[2] = x1b[2] * r3[0] - x2b[2] * r3[1]; o2b[2] = x2b[2] * r3[0] + x1b[2] * r3[1];
                        o1b[3] = x1b[3] * r3[2] - x2b[3] * r3[3]; o2b[3] = x2b[3] * r3[2] + x1b[3] * r3[3];
                    }
                    bf16_t* op = base + (size_t)row * ld + ocol;
                    *(u32x4*)op = pack8(o1a, o1b); *(u32x4*)(op + 32) = pack8(o2a, o2b);
                    if (!isq && !latent) { float* p = nk + ((size_t)((row >> 8) * 2 + layer) * SEQC + (row & 255)) * KVD + ocol;
                        *(f32x4*)p = x1a; *(f32x4*)(p + 4) = x1b; *(f32x4*)(p + 32) = x2a; *(f32x4*)(p + 36) = x2b; }
                }
        } else if (pn < 12) {
#pragma unroll
            for (int ai = 0; ai < 2; ++ai)
#pragma unroll
                for (int m = 0; m < 4; ++m) {
                    const int row = row0 + ai * HALF + m * 16;
#pragma unroll
                    for (int bj = 0; bj < 2; ++bj) { const int col = (pn - 10) * BM + bj * HALF + cw;
                        *(u32x4*)(Vb + (size_t)row * KVD + col) = pack8(acc[ai][bj][m][0], acc[ai][bj][m][1]);
                        if (!latent) { float* p = nv + ((size_t)((row >> 8) * 2 + layer) * SEQC + (row & 255)) * KVD + col; *(f32x4*)p = acc[ai][bj][m][0]; *(f32x4*)(p + 4) = acc[ai][bj][m][1]; } }
                }
        } else if (pn < 20 || (pn >= 24 && pn < 32)) {
            const bool glu = pn < 20; bf16_t* base = glu ? GLU : CX; const int col = (glu ? pn - 12 : pn - 24) * HALF + cw;
#pragma unroll
            for (int ai = 0; ai < 2; ++ai)
#pragma unroll
                for (int m = 0; m < 4; ++m) {
                    bf16_t* op = base + (size_t)(row0 + ai * HALF + m * 16) * DCA + col;
                    if (glu) *(u32x4*)op = pack8(pair_op<PO_GLU>(acc[ai][0][m][0], acc[ai][1][m][0]), pair_op<PO_GLU>(acc[ai][0][m][1], acc[ai][1][m][1]));
                    else     *(u32x4*)op = pack8(pair_op<PO_MUL>(acc[ai][0][m][0], acc[ai][1][m][0]), pair_op<PO_MUL>(acc[ai][0][m][1], acc[ai][1][m][1]));
                }
        } else if (pn < 24) {
#pragma unroll
            for (int ai = 0; ai < 2; ++ai)
#pragma unroll
                for (int m = 0; m < 4; ++m)
#pragma unroll
                    for (int bj = 0; bj < 2; ++bj)
                        *(u32x4*)(BG + (size_t)(row0 + ai * HALF + m * 16) * DCA + (pn - 20) * BM + bj * HALF + cw) = pack8(acc[ai][bj][m][0], acc[ai][bj][m][1]);
        } else {
#pragma unroll
            for (int ai = 0; ai < 2; ++ai)
#pragma unroll
                for (int m = 0; m < 4; ++m)
#pragma unroll
                    for (int bj = 0; bj < 2; ++bj) { f32x4 a = acc[ai][bj][m][0], b = acc[ai][bj][m][1];
#pragma unroll
                        for (int e = 0; e < 4; ++e) { a[e] = fsigm(a[e]); b[e] = fsigm(b[e]); }
                        *(u32x4*)(GATES + (size_t)(row0 + ai * HALF + m * 16) * (3 * D) + (pn - 32) * BM + bj * HALF + cw) = pack8(a, b); }
        }
    }
};
template <int STAGE> struct EpiMix {
    static constexpr bool PERM = true, AFTER_DRAIN = false;
    float* TMP; bf16_t* MIX; const bf16_t* GATES;
    __device__ __forceinline__ void operator()(const f32x4 (&acc)[2][2][4][2], const Unit& u, int wr, int wc, int fr, int fq) const {
        const int row0 = u.pm * BM + wr * 64 + fr, col0 = u.pn * BM + wc * 32 + 8 * fq;
#pragma unroll
        for (int ai = 0; ai < 2; ++ai)
#pragma unroll
            for (int m = 0; m < 4; ++m) {
                const size_t row = (size_t)(row0 + ai * HALF + m * 16);
#pragma unroll
                for (int bj = 0; bj < 2; ++bj) { const int col = col0 + bj * HALF;
                    f32x4 ga, gb; unpack8(*(const u32x4*)(GATES + row * (3 * D) + STAGE * D + col), ga, gb);
                    f32x4 va = ga * acc[ai][bj][m][0], vb = gb * acc[ai][bj][m][1];
                    float* tp = TMP + row * D + col;
                    if (STAGE > 0) { va = va + *(const f32x4*)tp; vb = vb + *(const f32x4*)(tp + 4); }
                    if (STAGE < 2) { *(f32x4*)tp = va; *(f32x4*)(tp + 4) = vb; }
                    else *(u32x4*)(MIX + row * D + col) = pack8(va, vb); }
            }
    }
};
template <class Epi, class Sched, bool ALIGN_EPI = false, bool SP2 = false>
__device__ __forceinline__ void gemm_phase(PG8_LAS unsigned char* lds, const Gemm g, const Sched& S, const Epi& E) {
    const int tid = fresh_tid(), wid = __builtin_amdgcn_readfirstlane(tid >> 6), lane = tid & 63, wr = wid >> 2, wc = wid & 3, fr = lane & 15, fq = lane >> 4;
    const int K = g.K, nt = K / BK;
    unsigned voffA[2], voffB[2];
#pragma unroll
    for (int i = 0; i < 2; ++i) { int R, C; stage_rc(tid * 16 + i * 8192, R, C); const int Rb = Epi::PERM ? ((R & ~31) + perm32(R & 31)) : R;
        voffA[i] = (unsigned)(R * K + C) * 2u; voffB[i] = (unsigned)(Rb * K + C) * 2u; }
    const size_t kstep = (size_t)(BK * 2);
    const size_t hstep = (size_t)HALF * K * 2;
    const size_t tstep = 2 * hstep;
    const unsigned ldsw = (unsigned)wid * 1024u;
    const int aoff = lds_byte(wr * 64 + fr, fq * 8), boff = lds_byte(wc * 32 + fr, fq * 8);
#define PG8_SA(b, h) (((b) * 2 + (h)) * HTB)
#define PG8_SB(b, h) ((4 + (b) * 2 + (h)) * HTB)
#define PG8_STAGE(bufoff, gbase, voff) do { _Pragma("unroll") for (int _i = 0; _i < 2; ++_i) \
        __builtin_amdgcn_global_load_lds((const unsigned*)((const char*)(gbase) + (voff)[_i]), (PG8_LAS unsigned*)(lds + (bufoff) + ldsw + _i * 8192), 16, 0, 0); } while (0)
#define PG8_LDA(dst, b, h) do { _Pragma("unroll") for (int m = 0; m < 4; ++m) _Pragma("unroll") for (int k = 0; k < 2; ++k) dst[m][k] = *(const PG8_LAS bf16x8*)(lds + PG8_SA(b, h) + aoff + m * 2048 + k * 1024); } while (0)
#define PG8_LDB(dst, b, h) do { _Pragma("unroll") for (int n = 0; n < 2; ++n) _Pragma("unroll") for (int k = 0; k < 2; ++k) dst[n][k] = *(const PG8_LAS bf16x8*)(lds + PG8_SB(b, h) + boff + n * 2048 + k * 1024); } while (0)
#define PG8_MMA(ai, bj, At, Bt) do { __builtin_amdgcn_s_setprio(1); _Pragma("unroll") for (int m = 0; m < 4; ++m) _Pragma("unroll") for (int n = 0; n < 2; ++n) _Pragma("unroll") for (int k = 0; k < 2; ++k) \
        acc[ai][bj][m][n] = __builtin_amdgcn_mfma_f32_16x16x32_bf16(Bt[n][k], At[m][k], acc[ai][bj][m][n], 0, 0, 0); __builtin_amdgcn_s_setprio(0); } while (0)
#define PG8_WAIT_V(n) asm volatile("s_waitcnt vmcnt(" #n ")" ::: "memory")
#define PG8_WAIT_L(n) asm volatile("s_waitcnt lgkmcnt(" #n ")" ::: "memory")
#define PG8_BAR __builtin_amdgcn_s_barrier()
#define PG8_SCHED __builtin_amdgcn_sched_barrier(0)
    Unit cur, nxt; int ui = 0;
    if (!S.next(0, cur)) return;
    f32x4 acc[2][2][4][2];
#pragma unroll
    for (int a = 0; a < 2; ++a)
#pragma unroll
        for (int b = 0; b < 2; ++b)
#pragma unroll
            for (int m = 0; m < 4; ++m)
#pragma unroll
                for (int n = 0; n < 2; ++n) acc[a][b][m][n] = (f32x4){0.f, 0.f, 0.f, 0.f};
    bf16x8 At[4][2], B0[2][2], B1[2][2];
    const char* cA = (const char*)g.A + (size_t)cur.pm * tstep; const char* cB = (const char*)g.Bt + (size_t)cur.pn * tstep;
    S.a_ready(cur);
    if constexpr (SP2) {
        PG8_STAGE(PG8_SB(0, 0), cB, voffB); PG8_STAGE(PG8_SB(0, 1), cB + hstep, voffB); PG8_STAGE(PG8_SA(0, 0), cA, voffA); PG8_STAGE(PG8_SA(0, 1), cA + hstep, voffA);
        if (wr == 1) PG8_BAR;
        PG8_WAIT_V(2); PG8_BAR;
        PG8_STAGE(PG8_SB(1, 0), cB + kstep, voffB); PG8_STAGE(PG8_SA(1, 0), cA + kstep, voffA); PG8_STAGE(PG8_SB(1, 1), cB + hstep + kstep, voffB);
        PG8_WAIT_V(6); PG8_BAR;
    } else {
        PG8_STAGE(PG8_SB(0, 0), cB, voffB); PG8_STAGE(PG8_SA(0, 0), cA, voffA); PG8_STAGE(PG8_SB(0, 1), cB + hstep, voffB); PG8_STAGE(PG8_SA(0, 1), cA + hstep, voffA);
        if (wr == 1) PG8_BAR;
        PG8_WAIT_V(4); PG8_BAR;
        PG8_STAGE(PG8_SB(1, 0), cB + kstep, voffB); PG8_STAGE(PG8_SA(1, 0), cA + kstep, voffA); PG8_STAGE(PG8_SB(1, 1), cB + hstep + kstep, voffB);
        PG8_WAIT_V(6); PG8_BAR;
    }
    for (;;) {
        const bool has_next = S.next(ui + 1, nxt);
        const char* nA = has_next ? (const char*)g.A + (size_t)nxt.pm * tstep : cA; const char* nB = has_next ? (const char*)g.Bt + (size_t)nxt.pn * tstep : cB;
        for (int t = 0; t < nt; t += 2) {
            const bool last = (t == nt - 2);
            const char* a1 = cA + (size_t)(t + 1) * kstep;
            const char* a2 = last ? nA : cA + (size_t)(t + 2) * kstep; const char* b2 = last ? nB : cB + (size_t)(t + 2) * kstep;
            const char* a3 = a2 + kstep; const char* b3 = b2 + kstep;
            if (last && has_next) S.a_ready(nxt);
            if constexpr (SP2) {
            PG8_LDB(B0, 0, 0); PG8_LDB(B1, 0, 1); PG8_SCHED; PG8_LDA(At, 0, 0); PG8_STAGE(PG8_SA(1, 1), a1 + hstep, voffA);
            PG8_WAIT_V(8); PG8_WAIT_L(0); PG8_BAR; PG8_MMA(0, 0, At, B0); PG8_MMA(0, 1, At, B1); PG8_BAR; PG8_SCHED;
            PG8_LDA(At, 0, 1); PG8_STAGE(PG8_SB(0, 0), b2, voffB); PG8_STAGE(PG8_SB(0, 1), b2 + hstep, voffB); PG8_STAGE(PG8_SA(0, 0), a2, voffA);
            PG8_WAIT_V(8); PG8_WAIT_L(0); PG8_BAR; PG8_MMA(1, 0, At, B0); PG8_MMA(1, 1, At, B1); PG8_BAR; PG8_SCHED;
            PG8_LDB(B0, 1, 0); PG8_LDB(B1, 1, 1); PG8_SCHED; PG8_LDA(At, 1, 0); PG8_STAGE(PG8_SA(0, 1), a2 + hstep, voffA);
            PG8_WAIT_V(8); PG8_WAIT_L(0); PG8_BAR; PG8_MMA(0, 0, At, B0); PG8_MMA(0, 1, At, B1); PG8_BAR; PG8_SCHED;
            PG8_LDA(At, 1, 1); PG8_STAGE(PG8_SB(1, 0), b3, voffB); PG8_STAGE(PG8_SB(1, 1), b3 + hstep, voffB); PG8_STAGE(PG8_SA(1, 0), a3, voffA);
            PG8_WAIT_V(8); PG8_WAIT_L(0); PG8_BAR; PG8_MMA(1, 0, At, B0); PG8_MMA(1, 1, At, B1); PG8_BAR; PG8_SCHED;
            } else {
            PG8_LDB(B0, 0, 0); PG8_SCHED; PG8_LDA(At, 0, 0); PG8_STAGE(PG8_SA(1, 1), a1 + hstep, voffA);
            PG8_WAIT_L(8); PG8_BAR; PG8_WAIT_L(0); PG8_MMA(0, 0, At, B0); PG8_BAR; PG8_SCHED;
            PG8_LDB(B1, 0, 1); PG8_STAGE(PG8_SB(0, 0), b2, voffB);
            PG8_BAR; PG8_WAIT_L(0); PG8_MMA(0, 1, At, B1); PG8_BAR;
            PG8_LDA(At, 0, 1); PG8_STAGE(PG8_SA(0, 0), a2, voffA);
            PG8_BAR; PG8_WAIT_L(0); PG8_MMA(1, 0, At, B0); PG8_BAR; PG8_SCHED;
            PG8_STAGE(PG8_SB(0, 1), b2 + hstep, voffB);
            PG8_WAIT_V(6); PG8_BAR; PG8_MMA(1, 1, At, B1); PG8_BAR;
            PG8_LDB(B0, 1, 0); PG8_SCHED; PG8_LDA(At, 1, 0); PG8_STAGE(PG8_SA(0, 1), a2 + hstep, voffA);
            PG8_WAIT_L(8); PG8_BAR; PG8_WAIT_L(0); PG8_MMA(0, 0, At, B0); PG8_BAR; PG8_SCHED;
            PG8_LDB(B1, 1, 1); PG8_STAGE(PG8_SB(1, 0), b3, voffB);
            PG8_BAR; PG8_WAIT_L(0); PG8_MMA(0, 1, At, B1); PG8_BAR;
            PG8_LDA(At, 1, 1); PG8_STAGE(PG8_SA(1, 0), a3, voffA);
            PG8_BAR; PG8_WAIT_L(0); PG8_MMA(1, 0, At, B0); PG8_BAR; PG8_SCHED;
            PG8_STAGE(PG8_SB(1, 1), b3 + hstep, voffB);
            PG8_WAIT_V(6); PG8_BAR; PG8_MMA(1, 1, At, B1); PG8_BAR;
            }
        }
        if constexpr (ALIGN_EPI) { if (wr == 0) PG8_BAR; }
        if constexpr (!Epi::AFTER_DRAIN) { E(acc, cur, wr, wc, fr, fq); S.done(cur); }
        if (!has_next) break;
#pragma unroll
        for (int a = 0; a < 2; ++a)
#pragma unroll
            for (int b = 0; b < 2; ++b)
#pragma unroll
                for (int m = 0; m < 4; ++m)
#pragma unroll
                    for (int n = 0; n < 2; ++n) acc[a][b][m][n] = (f32x4){0.f, 0.f, 0.f, 0.f};
        cur = nxt; cA = nA; cB = nB; ++ui;
        if constexpr (ALIGN_EPI) { if (wr == 1) PG8_BAR; }
    }
    PG8_WAIT_V(0);
    if constexpr (!ALIGN_EPI) { if (wr == 0) PG8_BAR; }
    PG8_BAR;
    if constexpr (Epi::AFTER_DRAIN) { E.fused(acc, cur, wr, wc, fr, fq, lds, wid, lane); S.done(cur); }
#undef PG8_SA
#undef PG8_SB
#undef PG8_STAGE
#undef PG8_LDA
#undef PG8_LDB
#undef PG8_MMA
#undef PG8_WAIT_V
#undef PG8_WAIT_L
#undef PG8_BAR
#undef PG8_SCHED
}
}

namespace att {
typedef unsigned short bf16;
typedef short bf16x8 __attribute__((ext_vector_type(8)));
typedef short s16x4 __attribute__((ext_vector_type(4)));
typedef float f32x16 __attribute__((ext_vector_type(16)));
typedef unsigned u32x4 __attribute__((ext_vector_type(4)));
constexpr float SCALE = 0.08838834764831845f, THR = 8.f;
constexpr int SHM_V = 16384, SHM_K = 16384, NW = 8;
constexpr int LDS_BYTES = 2 * SHM_V + 2 * SHM_K + NW * 64 * 4;
#define KSWZ(row, colB) ((row) * 256 + ((colB) ^ (((row) & 7) << 4)))
#define SBAR() __builtin_amdgcn_sched_barrier(0)
__device__ __forceinline__ int v_st(int k, int c) { const int kk = (k & ~0xC) | ((k & 4) << 1) | ((k & 8) >> 1); return ((kk >> 3) * 4 + (c >> 5)) * 512 + ((kk & 7) * 32 + (c & 31)) * 2; }
__device__ __forceinline__ int v_rd_base(int lane) { return ((lane & 3) << 3) | (((lane >> 2) & 3) << 6) | (((lane >> 4) & 1) << 5) | (((lane >> 5) & 1) << 8); }
constexpr int v_rd_off(int d0, int ks, int half) { return d0 * 512 + ks * 4096 + half * 2048; }
__device__ __forceinline__ int crow(int r, int hi) { return (r & 3) + 8 * (r >> 2) + 4 * hi; }
__device__ __forceinline__ unsigned cvtpk(float lo, float hi) { unsigned r; asm volatile("v_cvt_pk_bf16_f32 %0, %1, %2" : "=v"(r) : "v"(lo), "v"(hi)); return r; }
__device__ __forceinline__ void mask_tile(f32x16& p0, f32x16& p1, int d, int type) {
    const float NEG = -__builtin_inff();
#pragma unroll
    for (int r = 0; r < 16; ++r) {
        const int c = (r & 3) + 8 * (r >> 2);
        if (type == 1) { if (c < d) p0[r] = NEG; if (c + 32 < d) p1[r] = NEG; }
        else           { if (c > d) p0[r] = NEG; if (c + 32 > d) p1[r] = NEG; }
    }
}
__device__ __forceinline__ void partialSM(f32x16& p0, f32x16& p1, float& m_reg, float& mn, float& alpha) {
    float pmax = p0[0]; for (int r = 1; r < 16; ++r) pmax = fmaxf(pmax, p0[r]); for (int r = 0; r < 16; ++r) pmax = fmaxf(pmax, p1[r]);
    { auto rr = __builtin_amdgcn_permlane32_swap(__float_as_uint(pmax), __float_as_uint(pmax), false, false);
      pmax = fmaxf(__uint_as_float(rr[0]), __uint_as_float(rr[1])); }
    constexpr float C2 = 1.4426950408889634f * SCALE;
    if (__builtin_expect(__all((pmax - m_reg) * SCALE <= THR), 1)) { mn = m_reg; alpha = 1.f; }
    else { mn = fmaxf(m_reg, pmax); alpha = __builtin_amdgcn_exp2f((m_reg - mn) * C2); m_reg = mn; }
    const float mnL = -mn * C2;
    for (int r = 0; r < 16; ++r) p0[r] = fmaf(p0[r], C2, mnL); for (int r = 0; r < 16; ++r) p1[r] = fmaf(p1[r], C2, mnL);
    for (int r = 0; r < 16; ++r) p0[r] = __builtin_amdgcn_exp2f(p0[r]);
}
__device__ __forceinline__ void finishSM(f32x16& p0, f32x16& p1, float alpha, float& l_reg, bf16x8& pa0, bf16x8& pa1, bf16x8& pa2, bf16x8& pa3) {
    for (int r = 0; r < 16; ++r) p1[r] = __builtin_amdgcn_exp2f(p1[r]);
    float ps = 0; for (int r = 0; r < 16; ++r) ps += p0[r]; for (int r = 0; r < 16; ++r) ps += p1[r];
    { auto rr = __builtin_amdgcn_permlane32_swap(__float_as_uint(ps), __float_as_uint(ps), false, false);
      ps = __uint_as_float(rr[0]) + __uint_as_float(rr[1]); }
    l_reg = l_reg * alpha + ps;
#define PK4(P, B_, OUT) do { unsigned a0 = cvtpk(P[B_+0], P[B_+1]), a1 = cvtpk(P[B_+2], P[B_+3]);                          \
        unsigned b0 = cvtpk(P[B_+4], P[B_+5]), b1 = cvtpk(P[B_+6], P[B_+7]);                                             \
        auto r0 = __builtin_amdgcn_permlane32_swap(a0, b0, false, false); auto r1 = __builtin_amdgcn_permlane32_swap(a1, b1, false, false); \
        u32x4 w = {r0[0], r1[0], r0[1], r1[1]}; OUT = *reinterpret_cast<bf16x8*>(&w); } while (0)
    PK4(p0, 0, pa0); PK4(p0, 8, pa1); PK4(p1, 0, pa2); PK4(p1, 8, pa3);
#undef PK4
}
template <int KB>
__device__ __forceinline__ void qkt(f32x16& p0, f32x16& p1, const char* K_lds, int r32, int hi, const bf16x8* qr) {
    p0 = f32x16{}; p1 = f32x16{};
    const char* kb[4];
#pragma unroll
    for (int dd = 0; dd < 4; ++dd) kb[dd] = K_lds + KB * SHM_K + KSWZ(r32, (dd * 16 + hi * 8) * 2);
#pragma unroll
    for (int d0 = 0; d0 < 8; ++d0) { const char* a = kb[d0 & 3] + (d0 >> 2) * 128;
        bf16x8 b0 = *reinterpret_cast<const bf16x8*>(a);
        bf16x8 b1 = *reinterpret_cast<const bf16x8*>(a + 32 * 256);
        p0 = __builtin_amdgcn_mfma_f32_32x32x16_bf16(b0, qr[d0], p0, 0, 0, 0);
        p1 = __builtin_amdgcn_mfma_f32_32x32x16_bf16(b1, qr[d0], p1, 0, 0, 0); }
}
template <int VB>
__device__ __forceinline__ void pv_tile(f32x16* o, int vb0, bf16x8 pa0, bf16x8 pa1, bf16x8 pa2, bf16x8 pa3) {
#define TRRD(dst, off) asm volatile("ds_read_b64_tr_b16 %0, %1 offset:%2" : "=&v"(dst) : "v"(vb0), "i"(off) : "memory")
#define PV_D0(d0) do { s16x4 l0, l1, l2, l3, h0, h1, h2, h3; constexpr int b_ = VB * SHM_V + v_rd_off(d0, 0, 0); \
        TRRD(l0, b_); TRRD(h0, b_ + 2048); TRRD(l1, b_ + 4096); TRRD(h1, b_ + 6144); TRRD(l2, b_ + 8192); TRRD(h2, b_ + 10240); TRRD(l3, b_ + 12288); TRRD(h3, b_ + 14336); \
        asm volatile("s_waitcnt lgkmcnt(0)" ::: "memory"); SBAR();   \
        o[d0] = __builtin_amdgcn_mfma_f32_32x32x16_bf16(pa0, (bf16x8){l0[0], l0[1], l0[2], l0[3], h0[0], h0[1], h0[2], h0[3]}, o[d0], 0, 0, 0);   \
        o[d0] = __builtin_amdgcn_mfma_f32_32x32x16_bf16(pa1, (bf16x8){l1[0], l1[1], l1[2], l1[3], h1[0], h1[1], h1[2], h1[3]}, o[d0], 0, 0, 0);   \
        o[d0] = __builtin_amdgcn_mfma_f32_32x32x16_bf16(pa2, (bf16x8){l2[0], l2[1], l2[2], l2[3], h2[0], h2[1], h2[2], h2[3]}, o[d0], 0, 0, 0);   \
        o[d0] = __builtin_amdgcn_mfma_f32_32x32x16_bf16(pa3, (bf16x8){l3[0], l3[1], l3[2], l3[3], h3[0], h3[1], h3[2], h3[3]}, o[d0], 0, 0, 0); } while (0)
    PV_D0(0); PV_D0(1); PV_D0(2); PV_D0(3);
#undef PV_D0
#undef TRRD
}
__device__ __forceinline__ void attn_unit(const bf16* Qw, const bf16* cK, const bf16* cV, const bf16* wK, const bf16* wV, int nctx, int NT, int tm1, int tm2, const float* sinkp, bf16* Ow, char* lds) {
    const int tid = fresh_tid(), wid = __builtin_amdgcn_readfirstlane(tid >> 6), lane = tid & 63, r32 = lane & 31, hi = lane >> 5;
    char* V_lds = lds; char* K_lds = lds + 2 * SHM_V;
    float* wsf = (float*)(lds + 2 * SHM_V + 2 * SHM_K) + wid * 64; float* li_l = wsf, * al_l = wsf + 32;
    float m_reg = -1e30f, l_reg = 0; f32x16 o[4] = {};
    const int sr = tid >> 4, sc = (tid & 15) * 8, vst0 = v_st(sr, sc), vst1 = v_st(32 + sr, sc), kws = KSWZ(sr, sc * 2);
    const int vb0 = (int)(uintptr_t)V_lds + v_rd_base(lane);
    const int qrow = 32 * (wid & 1) + r32, hq = wid >> 1, dmask = qrow - 4 * hi;
    bf16x8 qr[8];
#pragma unroll
    for (int d0 = 0; d0 < 8; ++d0) qr[d0] = *(const bf16x8*)(Qw + (size_t)qrow * D + hq * 128 + d0 * 16 + hi * 8);
    bf16x8 st_v0, st_v1, st_k0, st_k1;
#define TILEP(t, kp, vp) const bf16* kp = (t) < nctx ? cK + (size_t)(t) * 64 * KVD : wK + (size_t)((t) - nctx) * 64 * KVD; const bf16* vp = (t) < nctx ? cV + (size_t)(t) * 64 * KVD : wV + (size_t)((t) - nctx) * 64 * KVD
#define SLOAD(t) do { TILEP(t, kp_, vp_); st_v0 = *(const bf16x8*)(vp_ + (size_t)sr * KVD + sc); st_v1 = *(const bf16x8*)(vp_ + (size_t)(32 + sr) * KVD + sc); \
                      st_k0 = *(const bf16x8*)(kp_ + (size_t)sr * KVD + sc); st_k1 = *(const bf16x8*)(kp_ + (size_t)(32 + sr) * KVD + sc); } while (0)
#define SWRITE(bf) do { *(bf16x8*)(V_lds + (bf) * SHM_V + vst0) = st_v0; *(bf16x8*)(V_lds + (bf) * SHM_V + vst1) = st_v1; \
                        *(bf16x8*)(K_lds + (bf) * SHM_K + kws) = st_k0; *(bf16x8*)(K_lds + (bf) * SHM_K + kws + 32 * 256) = st_k1; } while (0)
#define VMW() asm volatile("s_waitcnt vmcnt(0)" ::: "memory")
#define RESC(a) do { if (__any((a) < 1.f)) { if (hi == 0) al_l[r32] = (a); asm volatile("s_waitcnt lgkmcnt(0)" ::: "memory");              \
                     for (int d_ = 0; d_ < 4; ++d_) for (int r = 0; r < 16; ++r) o[d_][r] *= al_l[crow(r, hi)]; } } while (0)
    f32x16 p0, p1; float mn, al; bf16x8 pa0, pa1, pa2, pa3;
#define STEP(t, B) do { if ((t) + 1 < NT) SLOAD((t) + 1); SBAR();                                                   \
        qkt<B>(p0, p1, K_lds, r32, hi, qr);                                                                           \
        if ((t) == tm1) mask_tile(p0, p1, dmask, 1); else if ((t) == tm2) mask_tile(p0, p1, dmask, 2);                \
        partialSM(p0, p1, m_reg, mn, al); RESC(al); finishSM(p0, p1, al, l_reg, pa0, pa1, pa2, pa3); SBAR();          \
        pv_tile<B>(o, vb0, pa0, pa1, pa2, pa3);                                                                       \
        if ((t) + 1 < NT) { VMW(); SWRITE((B) ^ 1); }                                                                 \
        __syncthreads(); } while (0)
    SLOAD(0); VMW(); SWRITE(0); __syncthreads();
    for (int t = 0; t < NT; t += 2) { STEP(t, 0); if (t + 1 < NT) STEP(t + 1, 1); }
    { constexpr float C2 = 1.4426950408889634f * SCALE; const float sk = sinkp[hq];
      l_reg += __builtin_amdgcn_exp2f(sk * 1.4426950408889634f - m_reg * C2); }
    if (hi == 0) li_l[r32] = l_reg; asm volatile("s_waitcnt lgkmcnt(0)" ::: "memory");
    float rli[16];
#pragma unroll
    for (int r = 0; r < 16; ++r) rli[r] = __builtin_amdgcn_rcpf(li_l[crow(r, hi)]);
    bf16* Op = Ow + (size_t)(32 * (wid & 1)) * D + hq * 128;
#pragma unroll
    for (int r = 0; r < 16; ++r) { const int orow = crow(r, hi);
#pragma unroll
        for (int d0 = 0; d0 < 4; ++d0) { const float v = o[d0][r] * rli[r]; const float vn = __shfl_xor(v, 1);
            if ((r32 & 1) == 0) *(unsigned*)(Op + (size_t)orow * D + d0 * 32 + r32) = cvtpk(v, vn); } }
    __syncthreads();
#undef TILEP
#undef SLOAD
#undef SWRITE
#undef VMW
#undef RESC
#undef STEP
}
#undef KSWZ
#undef SBAR
}

#define GAS __attribute__((address_space(1)))
#define LAS __attribute__((address_space(3)))
typedef unsigned short bf16;
typedef unsigned v4u __attribute__((ext_vector_type(4)));
typedef float f32x4 __attribute__((ext_vector_type(4)));
typedef short bf16x8 __attribute__((ext_vector_type(8)));
typedef GAS unsigned gu32;
#define RLX_AGENT __ATOMIC_RELAXED, __HIP_MEMORY_SCOPE_AGENT
#define LDS_WAIT() asm volatile("s_waitcnt lgkmcnt(0)" ::: "memory")
#define VM_WAIT() asm volatile("s_waitcnt vmcnt(0)" ::: "memory")
__device__ __forceinline__ unsigned f2bf(float f) { unsigned u = __builtin_bit_cast(unsigned, f); return (u + 0x7fffu + ((u >> 16) & 1u)) >> 16; }
__device__ __forceinline__ unsigned pk2(float lo, float hi) { return f2bf(lo) | (f2bf(hi) << 16); }
__device__ __forceinline__ float bflo(unsigned w) { return __builtin_bit_cast(float, w << 16); }
__device__ __forceinline__ float bfhi(unsigned w) { return __builtin_bit_cast(float, w & 0xffff0000u); }
__device__ __forceinline__ float wave_sum(float v) {
#pragma unroll
    for (int o = 1; o < 64; o <<= 1) v += __shfl_xor(v, o);
    return v;
}
__device__ __forceinline__ float silu_acc(float x) { return x / (1.f + __expf(-x)); }
#define XB_TMO      128
#define XB_XCNT(j)  (256  + 64 * (j))
#define XB_XSUB(j)  (1280 + 64 * (j))
#define XB_XGEN(j)  (2304 + 64 * (j))
#define XB_TOP      3328
#define XB_TOPGEN   3392
#define XCD_BAR_WORDS 3456
#define XB_SPIN_CAP (1u << 18)

__device__ __forceinline__ unsigned xb_ld(unsigned* p)              { return __hip_atomic_load(p, __ATOMIC_RELAXED, __HIP_MEMORY_SCOPE_AGENT); }
__device__ __forceinline__ unsigned xb_add(unsigned* p, unsigned v) { return __hip_atomic_fetch_add(p, v, __ATOMIC_RELAXED, __HIP_MEMORY_SCOPE_AGENT); }
__device__ __forceinline__ unsigned xb_xcc_id() { return (unsigned)__builtin_amdgcn_s_getreg((3 << 11) | 20) & 0xFu; }
#define XB_SPIN(cond, bar) do { unsigned _sp = 0; while (cond) { __builtin_amdgcn_s_sleep(1); \
    if ((++_sp & 255u) == 0u) { if (xb_ld(&(bar)[XB_TMO])) break; if (_sp > XB_SPIN_CAP) { atomicAdd(&(bar)[XB_TMO], 1u); break; } } } } while (0)

struct XcdBarrier {
    unsigned* bar; unsigned x;
    volatile LAS unsigned* st;
};

__device__ __forceinline__ XcdBarrier xcd_barrier_post(unsigned* bar, volatile LAS unsigned* st) {
    XcdBarrier b; b.bar = bar; b.x = xb_xcc_id(); b.st = st;
    if (threadIdx.x == 0) (void)xb_add(&bar[XB_XCNT(b.x)], 1u);
    return b;
}
__device__ __forceinline__ void xcd_barrier_complete(unsigned* bar, unsigned x, unsigned& nloc, unsigned& nx) {
    const unsigned G = gridDim.x * gridDim.y * gridDim.z;
    unsigned sum, cnt, mine, sp = 0u;
    for (;;) {
        sum = 0u; cnt = 0u; mine = 0u;
#pragma unroll
        for (unsigned j = 0; j < 16; ++j) { const unsigned c = xb_ld(&bar[XB_XCNT(j)]); sum += c; cnt += (c > 0u) ? 1u : 0u; mine = (j == x) ? c : mine; }
        if (sum == G) break;
        __builtin_amdgcn_s_sleep(1);
        if ((++sp & 255u) == 0u) { if (xb_ld(&bar[XB_TMO])) break; if (sp > XB_SPIN_CAP) { atomicAdd(&bar[XB_TMO], 1u); break; } }
    }
    nloc = mine > 0u ? mine : 1u; nx = cnt > 0u ? cnt : 1u;
}

__device__ __forceinline__ void xcd_barrier(const XcdBarrier& b) {
    asm volatile("s_waitcnt vmcnt(0)" ::: "memory");
    __syncthreads();
    if (threadIdx.x == 0) {
        unsigned* bar = b.bar;
        __builtin_amdgcn_s_waitcnt(0);
        unsigned nloc = b.st[0], nx = b.st[1];
        if (nloc == 0u) { xcd_barrier_complete(bar, b.x, nloc, nx); b.st[0] = nloc; b.st[1] = nx; }
        const unsigned old = xb_add(&bar[XB_XSUB(b.x)], 1u);
        const unsigned gen = old / nloc;
        if (old + 1u == (gen + 1u) * nloc) {
            __builtin_amdgcn_fence(__ATOMIC_RELEASE, "agent");
            asm volatile("s_waitcnt vmcnt(0)" ::: "memory");
            const unsigned og = xb_add(&bar[XB_TOP], 1u);
            const unsigned tg = og / nx;
            if (og + 1u == (tg + 1u) * nx) xb_add(&bar[XB_TOPGEN], 1u);
            else XB_SPIN(xb_ld(&bar[XB_TOPGEN]) == tg, bar);
            __builtin_amdgcn_fence(__ATOMIC_ACQUIRE, "agent");
            xb_add(&bar[XB_XGEN(b.x)], 1u);
            asm volatile("s_waitcnt vmcnt(0)" ::: "memory");
        } else {
            XB_SPIN(xb_ld(&bar[XB_XGEN(b.x)]) == gen, bar);
            __builtin_amdgcn_fence(__ATOMIC_ACQUIRE, "agent");
            asm volatile("s_waitcnt vmcnt(0)" ::: "memory");
        }
    }
    __syncthreads();
}


constexpr int NWAVES = 8, NTHR = NWAVES * 64;
constexpr int RING_OFF = 0, RING_BYTES = 131072;
constexpr int LDSCTL_OFF = RING_BYTES, MISC_OFF = LDSCTL_OFF + 320;
constexpr int LDS_BYTES = 147456;
static_assert(att::LDS_BYTES <= RING_BYTES && MISC_OFF + 128 <= LDS_BYTES, "LDS map");
constexpr int N_PHASES = 24;

__device__ __forceinline__ int dest_row(int kind, int n0) {
    if (kind == 1) { const int uv = n0 / DFF, j = n0 % DFF; return 256 * (j >> 7) + 128 * uv + (j & 127); }
    if (kind == 2) {
        if (n0 < 2560) { const int isk = n0 >= 2048, nn = isk ? n0 - 2048 : n0, head = nn >> 7, d = nn & 127, part = d >> 6, x = (d >> 5) & 1;
                         return 256 * ((isk ? 8 : 0) + (head >> 1)) + 128 * x + 64 * (head & 1) + 32 * part; }
        if (n0 < 3072) return n0;
        if (n0 < 5120) { const int nn = n0 - 3072, ag = nn >> 10, j = nn & 1023; return 256 * (12 + (j >> 7)) + 128 * ag + (j & 127); }
        if (n0 < 6144) return n0;
        if (n0 < 8192) { const int nn = n0 - 6144, xv = nn >> 10, j = nn & 1023; return 256 * (24 + (j >> 7)) + 128 * xv + (j & 127); }
        return n0;
    }
    return n0;
}
__device__ __forceinline__ void p0_transpose_item(const float* W, int K, int N, bf16* WT, int kind, LAS float* scr, int item, int lane) {
    const int nblk = N / 32, kb = item / nblk, nb = item % nblk, k0 = 64 * kb, n0 = 32 * nb, drow = dest_row(kind, n0);
#pragma unroll 8
    for (int i = 0; i < 32; ++i) { const int kk = 2 * i + (lane >> 5); scr[kk * 33 + (lane & 31)] = W[(size_t)(k0 + kk) * N + n0 + (lane & 31)]; }
    LDS_WAIT(); asm volatile("" ::: "memory");
    const int c = lane & 7;
#pragma unroll
    for (int j = 0; j < 4; ++j) { const int n = (lane >> 3) + 8 * j; const LAS float* s = scr + (8 * c) * 33 + n;
        v4u o; o.x = pk2(s[0 * 33], s[1 * 33]); o.y = pk2(s[2 * 33], s[3 * 33]); o.z = pk2(s[4 * 33], s[5 * 33]); o.w = pk2(s[6 * 33], s[7 * 33]);
        *(GAS v4u*)(WT + (size_t)(drow + n) * K + k0 + 8 * c) = o; }
    LDS_WAIT(); asm volatile("" ::: "memory");
}
constexpr int I_FI = (D / 64) * (2 * DFF / 32), I_FO = (DFF / 64) * (D / 32), I_IN = (D / 64) * (INC / 32), I_DD = (D / 64) * (D / 32), I_HD = (DCA / 64) * (D / 32);
constexpr int I_LAYER = 2 * I_FI + 2 * I_FO + I_IN + 2 * I_DD + 2 * I_HD;

struct Args { const float* in[26]; float* out; unsigned char* ws; int ph_lo, ph_hi; };

__device__ __forceinline__ void prologue(const Args& a, unsigned char* lds, int vcu, int G) {
    const int tid = fresh_tid(), lane = tid & 63, wave = __builtin_amdgcn_readfirstlane(tid >> 6);
    unsigned char* ws = a.ws;
    const float* c = a.in[4]; const float* c_ctx = a.in[5]; const float* w_ada = a.in[6]; const float* b_ada = a.in[7];
    {
        float* sv = (float*)lds;
        float* part = (float*)(lds + 24576);
        for (int i = tid; i < D; i += NTHR) { sv[i] = silu_acc(c_ctx[i]); sv[D + i] = silu_acc(c[i]); sv[2 * D + i] = silu_acc(c[D + i]); }
        __syncthreads();
        float* MOD = (float*)(ws + WS_MOD);
        for (int item = vcu; item < 2 * (NMOD / 64); item += G) {
            const int l = item / (NMOD / 64), j0 = (item % (NMOD / 64)) * 64;
            const float* w = w_ada + ((size_t)l * D + wave * 256) * NMOD + j0 + lane;
            const float* s0 = sv + wave * 256;
            float a0 = 0.f, a1 = 0.f, a2 = 0.f;
#pragma unroll 16
            for (int k = 0; k < 256; ++k) { const float x = w[(size_t)k * NMOD]; a0 += s0[k] * x; a1 += s0[D + k] * x; a2 += s0[2 * D + k] * x; }
            part[(wave * 3 + 0) * 64 + lane] = a0; part[(wave * 3 + 1) * 64 + lane] = a1; part[(wave * 3 + 2) * 64 + lane] = a2;
            __syncthreads();
            if (tid < 192) { const int cc = tid >> 6, j = tid & 63; float s = b_ada[l * NMOD + j0 + j];
#pragma unroll
                for (int wv = 0; wv < 8; ++wv) s += part[(wv * 3 + cc) * 64 + j];
                MOD[(size_t)(l * 3 + cc) * NMOD + j0 + j] = s; }
            __syncthreads();
        }
    }
    {
        LAS float* scr = (LAS float*)((LAS unsigned char*)lds + wave * 16384);
        const int gw = vcu * NWAVES + wave, NGW = G * NWAVES;
        for (int it = gw; it < 2 * I_LAYER; it += NGW) {
            const int l = it / I_LAYER; int r = it % I_LAYER;
            unsigned char* wl = ws + WS_WT + (size_t)l * WT_LAYER;
            if (r < I_FI) { p0_transpose_item(a.in[9] + (size_t)l * D * 2 * DFF, D, 2 * DFF, (bf16*)(wl + WT_1I), 1, scr, r, lane); continue; } r -= I_FI;
            if (r < I_FO) { p0_transpose_item(a.in[10] + (size_t)l * DFF * D, DFF, D, (bf16*)(wl + WT_1O), 0, scr, r, lane); continue; } r -= I_FO;
            if (r < I_IN) { p0_transpose_item(a.in[12] + (size_t)l * D * INC, D, INC, (bf16*)(wl + WT_IN), 2, scr, r, lane); continue; } r -= I_IN;
            if (r < I_DD) { p0_transpose_item(a.in[14] + (size_t)l * D * D, D, D, (bf16*)(wl + WT_AO), 0, scr, r, lane); continue; } r -= I_DD;
            if (r < I_HD) { p0_transpose_item(a.in[18] + (size_t)l * DCA * D, DCA, D, (bf16*)(wl + WT_A), 0, scr, r, lane); continue; } r -= I_HD;
            if (r < I_HD) { p0_transpose_item(a.in[20] + (size_t)l * DCA * D, DCA, D, (bf16*)(wl + WT_B), 0, scr, r, lane); continue; } r -= I_HD;
            if (r < I_DD) { p0_transpose_item(a.in[21] + (size_t)l * D * D, D, D, (bf16*)(wl + WT_OUT), 0, scr, r, lane); continue; } r -= I_DD;
            if (r < I_FI) { p0_transpose_item(a.in[23] + (size_t)l * D * 2 * DFF, D, 2 * DFF, (bf16*)(wl + WT_2I), 1, scr, r, lane); continue; } r -= I_FI;
            p0_transpose_item(a.in[24] + (size_t)l * DFF * D, DFF, D, (bf16*)(wl + WT_2O), 0, scr, r, lane);
        }
    }
    {
        const int gt = vcu * NTHR + tid, NT = G * NTHR;
        const int n8 = 2 * 2 * PAST * KVD / 8;
        for (int i = gt; i < 2 * n8; i += NT) { const bool isk = i < n8; const int j = isk ? i : i - n8;
            const f32x4* s = (const f32x4*)((isk ? a.in[2] : a.in[3]) + (size_t)j * 8); const f32x4 x = s[0], y = s[1];
            v4u o; o.x = pk2(x[0], x[1]); o.y = pk2(x[2], x[3]); o.z = pk2(y[0], y[1]); o.w = pk2(y[2], y[3]);
            *(v4u*)(ws + (isk ? WS_CK : WS_CV) + (size_t)j * 16) = o; }
        if (gt < 64 * 32) { const int pos = gt >> 5, i = gt & 31; const float inv = powf(10000.f, -(float)i / 32.f), ang = (float)pos * inv;
            float* rp = (float*)(ws + WS_ROPE) + (size_t)gt * 2; rp[0] = cosf(ang); rp[1] = sinf(ang); }
        const size_t n4c = (size_t)MC * D / 4, n4 = (size_t)M * D / 4;
        const f32x4* xp = (const f32x4*)a.in[0]; const f32x4* xs = (const f32x4*)a.in[1]; f32x4* X = (f32x4*)(ws + WS_X);
        for (size_t i = gt; i < n4; i += NT) X[i] = i < n4c ? xp[i] : xs[i - n4c];
    }
}
template <bool FINAL>
__device__ __forceinline__ void norm_phase(const float* X, const float* g, const float* MODl, int sub, bf16* H, float* out, int vcu, int G) {
    const int tid = fresh_tid(), lane = tid & 63, gw = vcu * NWAVES + __builtin_amdgcn_readfirstlane(tid >> 6), NGW = G * NWAVES;
    for (int m = gw; m < M; m += NGW) {
        const f32x4* xr = (const f32x4*)(X + (size_t)m * D) + lane; f32x4 v[8]; float ss = 0.f;
#pragma unroll
        for (int j = 0; j < 8; ++j) { v[j] = xr[64 * j]; ss += (v[j][0] * v[j][0] + v[j][1] * v[j][1]) + (v[j][2] * v[j][2] + v[j][3] * v[j][3]); }
        const float r = rsqrtf(wave_sum(ss) * (1.f / D) + EPS);
        const f32x4* gr = (const f32x4*)g + lane;
        if (FINAL) { f32x4* o = (f32x4*)(out + (size_t)m * D) + lane;
#pragma unroll
            for (int j = 0; j < 8; ++j) o[64 * j] = v[j] * r * gr[64 * j];
        } else {
            const int cond = m < MC ? 0 : (m < MC + SEQL ? 1 : 2);
            const float* mod = MODl + (size_t)cond * NMOD + (size_t)sub * 3 * D;
            const f32x4* sh = (const f32x4*)mod + lane; const f32x4* sc = (const f32x4*)(mod + D) + lane;
            unsigned long long* o8 = (unsigned long long*)(H + (size_t)m * D) + lane;
#pragma unroll
            for (int j = 0; j < 8; ++j) { const f32x4 h = v[j] * r * gr[64 * j] * (sc[64 * j] + 1.f) + sh[64 * j];
                o8[64 * j] = (unsigned long long)pk2(h[0], h[1]) | ((unsigned long long)pk2(h[2], h[3]) << 32); }
        }
    }
}
__device__ __forceinline__ void conv_a_phase(const bf16* GLU, const float* w, const float* bias, const float* g, bf16* CA, int vcu, int G, unsigned char* lds) {
    const int tid = fresh_tid(), wid = tid >> 6, lane = tid & 63;
    float* part = (float*)lds;
    float* rs = (float*)(lds + 16384);
    float wv0[31], wv1[31];
#pragma unroll
    for (int t = 0; t < 31; ++t) { wv0[t] = w[t * DCA + 2 * tid]; wv1[t] = w[t * DCA + 2 * tid + 1]; }
    const float b0 = bias[2 * tid], b1 = bias[2 * tid + 1], g0 = g[2 * tid], g1 = g[2 * tid + 1];
    for (int u = vcu; u < M / 16; u += G) {
        const int row0 = u * 16, s0 = row0 < MC ? (row0 & ~(SEQC - 1)) : MC + ((row0 - MC) & ~(SEQL - 1)), L = row0 < MC ? SEQC : SEQL;
#pragma unroll 1
        for (int grp = 0; grp < 2; ++grp) {
            const int p0 = row0 - s0 + 8 * grp;
            float x0[38], x1[38];
#pragma unroll
            for (int q = 0; q < 38; ++q) { const int p = p0 - 15 + q; unsigned xw = 0u; if (p >= 0 && p < L) xw = *(const unsigned*)(GLU + (size_t)(s0 + p) * DCA + 2 * tid); x0[q] = bflo(xw); x1[q] = bfhi(xw); }
            float a0[8], a1[8];
#pragma unroll
            for (int r = 0; r < 8; ++r) { float s_0 = b0, s_1 = b1;
#pragma unroll
                for (int t = 0; t < 31; ++t) { s_0 += x0[r + t] * wv0[t]; s_1 += x1[r + t] * wv1[t]; }
                a0[r] = s_0; a1[r] = s_1; part[r * 512 + tid] = s_0 * s_0 + s_1 * s_1; }
            __syncthreads();
            { float v = 0.f;
#pragma unroll
              for (int k = 0; k < 8; ++k) v += part[wid * 512 + lane + 64 * k];
              v = wave_sum(v); if (lane == 0) rs[wid] = rsqrtf(v * (1.f / DCA) + EPS); }
            __syncthreads();
#pragma unroll
            for (int r = 0; r < 8; ++r) { const float rr = rs[r];
                *(unsigned*)(CA + (size_t)(row0 + 8 * grp + r) * DCA + 2 * tid) = pk2(silu_acc(a0[r] * rr * g0), silu_acc(a1[r] * rr * g1)); }
        }
    }
    __syncthreads();
}
__device__ __forceinline__ void conv_b_phase(const bf16* BG, const bf16* CX, const float* w, bf16* CB, int vcu, int G) {
    const int gt = vcu * NTHR + fresh_tid(), NT = G * NTHR;
    for (int idx = gt; idx < M * (DCA / 8); idx += NT) {
        const int m = idx >> 7, c8 = (idx & 127) * 8;
        const int s0 = m < MC ? (m & ~(SEQC - 1)) : MC + ((m - MC) & ~(SEQL - 1)), L = m < MC ? SEQC : SEQL, pos = m - s0;
        f32x4 aa = {0.f, 0.f, 0.f, 0.f}, ab = {0.f, 0.f, 0.f, 0.f};
#pragma unroll
        for (int t = 0; t < 3; ++t) { const int p = pos + t - 1;
            if (p >= 0 && p < L) { const v4u xw = *(const v4u*)(CX + (size_t)(s0 + p) * DCA + c8); const f32x4 wa = *(const f32x4*)(w + t * DCA + c8), wb = *(const f32x4*)(w + t * DCA + c8 + 4);
                aa[0] += bflo(xw.x) * wa[0]; aa[1] += bfhi(xw.x) * wa[1]; aa[2] += bflo(xw.y) * wa[2]; aa[3] += bfhi(xw.y) * wa[3];
                ab[0] += bflo(xw.z) * wb[0]; ab[1] += bfhi(xw.z) * wb[1]; ab[2] += bflo(xw.w) * wb[2]; ab[3] += bfhi(xw.w) * wb[3]; } }
        const v4u bw = *(const v4u*)(BG + (size_t)m * DCA + c8);
        v4u o; o.x = pk2(bflo(bw.x) * aa[0], bfhi(bw.x) * aa[1]); o.y = pk2(bflo(bw.y) * aa[2], bfhi(bw.y) * aa[3]); o.z = pk2(bflo(bw.z) * ab[0], bfhi(bw.z) * ab[1]); o.w = pk2(bflo(bw.w) * ab[2], bfhi(bw.w) * ab[3]);
        *(v4u*)(CB + (size_t)m * DCA + c8) = o;
    }
}
__device__ __forceinline__ void attn_phase(const bf16* Qb, const bf16* Kb, const bf16* Vb, const bf16* CK, const bf16* CV, const float* sink, bf16* ATT, int layer, int vcu, int G, unsigned char* lds) {
    for (int u = vcu; u < 512; u += G) {
        const int b = u >> 8, kvh = (u >> 6) & 3, tb = u & 63;
        const int lo = tb < 2 ? -tb : -2, hi = tb > 61 ? 63 - tb : 2, NT = 8 + (hi - lo + 1);
        const size_t seq0 = (size_t)MC + (size_t)b * SEQL, q0 = seq0 + 64 * tb, c0 = (size_t)(b * 2 + layer) * PAST;
        att::attn_unit(Qb + q0 * D + kvh * 512, CK + c0 * KVD + kvh * 128, CV + c0 * KVD + kvh * 128,
                       Kb + (seq0 + 64 * (tb + lo)) * KVD + kvh * 128, Vb + (seq0 + 64 * (tb + lo)) * KVD + kvh * 128,
                       8, NT, lo == -2 ? 8 : -1, hi == 2 ? NT - 1 : -1, sink + kvh * 4, ATT + q0 * D + kvh * 512, (char*)lds);
    }
    for (int u = vcu; u < 256; u += G) {
        const int b = u >> 4, kvh = (u >> 2) & 3, qb = u & 3;
        const size_t seq0 = (size_t)b * SEQC, q0 = seq0 + 64 * qb;
        att::attn_unit(Qb + q0 * D + kvh * 512, Kb, Vb, Kb + seq0 * KVD + kvh * 128, Vb + seq0 * KVD + kvh * 128, 0, 4, -1, -1, sink + kvh * 4, ATT + q0 * D + kvh * 512, (char*)lds);
    }
}

__global__ void __launch_bounds__(NTHR, 2) fwd(Args args) {
    extern __shared__ __attribute__((aligned(16))) unsigned char lds[];
    const int tid = threadIdx.x;
    const int G = gridDim.x, bx = blockIdx.x, vcu = (G % 8 == 0) ? (bx % 8) * (G / 8) + bx / 8 : bx;
    unsigned char* ws = args.ws;
    LAS unsigned char* ldsl = (LAS unsigned char*)lds;
    volatile LAS unsigned* MISC = (volatile LAS unsigned*)(ldsl + MISC_OFF);
    for (int u = tid; u < (LDS_BYTES - LDSCTL_OFF) / 4; u += NTHR) ((LAS unsigned*)(ldsl + LDSCTL_OFF))[u] = 0u;
    __syncthreads();
    unsigned* barw = (unsigned*)(ws + WS_CTL) + CW_BAR;
    XcdBarrier bar; bar.bar = barw; bar.x = 0; bar.st = nullptr;
    if (!MK_PER_PHASE) bar = xcd_barrier_post(barw, MISC + 8);
    const int lo = args.ph_lo, hi = args.ph_hi;
#define IN(k) (lo <= (k) && (k) < hi)
#define SEAM(k) do { if (!MK_PER_PHASE && IN(k) && IN((k) + 1)) xcd_barrier(bar); } while (0)
    float* MOD = (float*)(ws + WS_MOD); const float* ROPE = (const float*)(ws + WS_ROPE); bf16* CK = (bf16*)(ws + WS_CK); bf16* CV = (bf16*)(ws + WS_CV);
    float* X = (float*)(ws + WS_X); bf16* H = (bf16*)(ws + WS_H); bf16* ACT = (bf16*)(ws + WS_ACT);
    bf16* Qb = (bf16*)(ws + WS_Q); bf16* Kb = (bf16*)(ws + WS_K); bf16* Vb = (bf16*)(ws + WS_V); bf16* GLU = (bf16*)(ws + WS_GLU); bf16* BG = (bf16*)(ws + WS_BG); bf16* CX = (bf16*)(ws + WS_CX);
    bf16* GATES = (bf16*)(ws + WS_GATES); bf16* ATT = (bf16*)(ws + WS_ATT); bf16* CA = (bf16*)(ws + WS_CA); bf16* CB = (bf16*)(ws + WS_CB); bf16* MIX = (bf16*)(ws + WS_MIX); float* TMP = (float*)(ws + WS_TMP);
    float* out = args.out; float* new_k = out + (size_t)M * D; float* new_v = new_k + (size_t)16 * 2 * SEQC * KVD;

    if (IN(0)) { prologue(args, lds, vcu, G); } SEAM(0);

    for (int l = 0; l < 2; ++l) {
        const int pb = 1 + 11 * l;
        const float* MODl = MOD + (size_t)l * 3 * NMOD;
        unsigned char* wl = ws + WS_WT + (size_t)l * WT_LAYER;
        if (IN(pb + 0)) norm_phase<false>(X, args.in[8] + l * D, MODl, 0, H, nullptr, vcu, G);
        SEAM(pb + 0);
        if (IN(pb + 1)) { pg8::Gemm g{H, (const bf16*)(wl + WT_1I), M, 2 * DFF, D}; pg8::StaticOrder S; S.init(M, 2 * DFF, G, bx); pg8::EpiSwiglu E{ACT, DFF};
            pg8::gemm_phase<pg8::EpiSwiglu, pg8::StaticOrder, true, true>(ldsl + RING_OFF, g, S, E); }
        SEAM(pb + 1);
        if (IN(pb + 2)) { pg8::Gemm g{ACT, (const bf16*)(wl + WT_1O), M, D, DFF}; pg8::StaticOrder S; S.init(M, D, G, bx); pg8::EpiResid E{X, MODl + 2 * D, 0.5f};
            pg8::gemm_phase<pg8::EpiResid, pg8::StaticOrder, true, true>(ldsl + RING_OFF, g, S, E); }
        SEAM(pb + 2);
        if (IN(pb + 3)) norm_phase<false>(X, args.in[11] + l * D, MODl, 1, H, nullptr, vcu, G);
        SEAM(pb + 3);
        if (IN(pb + 4)) { pg8::Gemm g{H, (const bf16*)(wl + WT_IN), M, INC, D}; pg8::StaticOrder S; S.init(M, INC, G, bx); pg8::EpiWin E{Qb, Kb, Vb, GLU, BG, CX, GATES, new_k, new_v, ROPE, l};
            pg8::gemm_phase<pg8::EpiWin, pg8::StaticOrder, true, true>(ldsl + RING_OFF, g, S, E); }
        SEAM(pb + 4);
        if (IN(pb + 5)) {
            attn_phase(Qb, Kb, Vb, CK, CV, args.in[13] + l * 16, ATT, l, vcu, G, lds);
            conv_a_phase(GLU, args.in[15] + (size_t)l * 31 * DCA, args.in[16] + l * DCA, args.in[17] + l * DCA, CA, vcu, G, lds);
            conv_b_phase(BG, CX, args.in[19] + (size_t)l * 3 * DCA, CB, vcu, G);
        }
        SEAM(pb + 5);
        if (IN(pb + 6)) {
            { pg8::Gemm g{CA, (const bf16*)(wl + WT_A), M, D, DCA}; pg8::StaticOrder S; S.init(M, D, G, bx); pg8::EpiMix<0> E{TMP, MIX, GATES};
              pg8::gemm_phase<pg8::EpiMix<0>, pg8::StaticOrder, true, true>(ldsl + RING_OFF, g, S, E); }
            { pg8::Gemm g{CB, (const bf16*)(wl + WT_B), M, D, DCA}; pg8::StaticOrder S; S.init(M, D, G, bx); pg8::EpiMix<1> E{TMP, MIX, GATES};
              pg8::gemm_phase<pg8::EpiMix<1>, pg8::StaticOrder, true, true>(ldsl + RING_OFF, g, S, E); }
            { pg8::Gemm g{ATT, (const bf16*)(wl + WT_AO), M, D, D}; pg8::StaticOrder S; S.init(M, D, G, bx); pg8::EpiMix<2> E{TMP, MIX, GATES};
              pg8::gemm_phase<pg8::EpiMix<2>, pg8::StaticOrder, true, true>(ldsl + RING_OFF, g, S, E); }
        }
        SEAM(pb + 6);
        if (IN(pb + 7)) { pg8::Gemm g{MIX, (const bf16*)(wl + WT_OUT), M, D, D}; pg8::StaticOrder S; S.init(M, D, G, bx); pg8::EpiResid E{X, MODl + 5 * D, 1.0f};
            pg8::gemm_phase<pg8::EpiResid, pg8::StaticOrder, true, true>(ldsl + RING_OFF, g, S, E); }
        SEAM(pb + 7);
        if (IN(pb + 8)) norm_phase<false>(X, args.in[22] + l * D, MODl, 2, H, nullptr, vcu, G);
        SEAM(pb + 8);
        if (IN(pb + 9)) { pg8::Gemm g{H, (const bf16*)(wl + WT_2I), M, 2 * DFF, D}; pg8::StaticOrder S; S.init(M, 2 * DFF, G, bx); pg8::EpiSwiglu E{ACT, DFF};
            pg8::gemm_phase<pg8::EpiSwiglu, pg8::StaticOrder, true, true>(ldsl + RING_OFF, g, S, E); }
        SEAM(pb + 9);
        if (IN(pb + 10)) { pg8::Gemm g{ACT, (const bf16*)(wl + WT_2O), M, D, DFF}; pg8::StaticOrder S; S.init(M, D, G, bx); pg8::EpiResid E{X, MODl + 8 * D, 0.5f};
            pg8::gemm_phase<pg8::EpiResid, pg8::StaticOrder, true, true>(ldsl + RING_OFF, g, S, E); }
        SEAM(pb + 10);
    }
    if (IN(23)) norm_phase<true>(X, args.in[25], nullptr, 0, nullptr, out, vcu, G);
#undef IN
#undef SEAM
}

extern "C" void kernel_launch(void* const* d_in, const int* in_sizes, int n_in, void* d_out, int out_size, void* d_ws, size_t ws_size, hipStream_t stream) {
    static int grid = 0;
    if (grid == 0) {
        if (n_in != 26 || ws_size < WS_END) { fprintf(stderr, "kernel_launch: built for 26 inputs and >= %zu bytes of workspace; got n_in %d, ws %zu; nothing launched\n", (size_t)WS_END, n_in, ws_size); grid = -1; return; }
        int dev = 0, cus = 0, per_cu = 0;
        if (hipGetDevice(&dev) != hipSuccess || hipDeviceGetAttribute(&cus, hipDeviceAttributeMultiprocessorCount, dev) != hipSuccess) { fprintf(stderr, "kernel_launch: device query failed\n"); grid = -1; return; }
        if (hipFuncSetAttribute((const void*)fwd, hipFuncAttributeMaxDynamicSharedMemorySize, LDS_BYTES) != hipSuccess) { fprintf(stderr, "kernel_launch: hipFuncSetAttribute failed\n"); grid = -1; return; }
        if (hipOccupancyMaxActiveBlocksPerMultiprocessor(&per_cu, (const void*)fwd, NTHR, LDS_BYTES) != hipSuccess || per_cu < 1)
            fprintf(stderr, "kernel_launch: note: occupancy query reports %d workgroups per CU\n", per_cu);
        (void)hipGetLastError();
        grid = cus;
    }
    if (grid < 0) return;
    if (hipMemsetAsync((char*)d_ws + WS_CTL, 0, CTL_ZERO_BYTES, stream) != hipSuccess) { fprintf(stderr, "kernel_launch: hipMemsetAsync failed\n"); return; }
    Args a{};
    for (int i = 0; i < 26; ++i) a.in[i] = (const float*)d_in[i];
    a.out = (float*)d_out; a.ws = (unsigned char*)d_ws;
#if MK_PER_PHASE
    for (int p = 0; p < N_PHASES; ++p) { a.ph_lo = p; a.ph_hi = p + 1; hipLaunchKernelGGL(fwd, dim3(grid), dim3(NTHR), LDS_BYTES, stream, a); }
#else
    a.ph_lo = 0; a.ph_hi = N_PHASES; hipLaunchKernelGGL(fwd, dim3(grid), dim3(NTHR), LDS_BYTES, stream, a);
#endif
    const hipError_t le = hipPeekAtLastError();
    if (le != hipSuccess) fprintf(stderr, "kernel_launch: launch failed: %s\n", hipGetErrorName(le));
}
```

```cpp
#include <hip/hip_runtime.h>
#include <cstdio>
#include <cstdint>

#ifndef MK_PER_PHASE
#define MK_PER_PHASE 0
#endif
constexpr int D = 2048, MC = 4096, ML = 8192, M = MC + ML, DFF = 5632, NMOD = 9 * D, INC = 14336;
constexpr int SEQC = 256, SEQL = 4096, PAST = 512, KVD = 512, DCA = 1024;
constexpr float EPS = 1e-6f;
constexpr size_t MiB = 1u << 20;
#ifndef ROW_PAD
#define ROW_PAD 64
#endif
constexpr int PADE = ROW_PAD;
constexpr int H_LD = D + PADE, ACT_LD = DFF + PADE, MIX_LD = D + PADE, ABR_K = 4096, ABR_LD = ABR_K + PADE, ABR_CA = 0, ABR_CB = 1024, ABR_ATT = 2048;
constexpr int WK_D = D + PADE, WK_FF = DFF + PADE, WK_MIX = ABR_K + PADE;
constexpr size_t WS_CTL = 0, CTL_ZERO_BYTES = 1 * MiB;
constexpr size_t WS_MOD = 1 * MiB, WS_ROPE = 2 * MiB, WS_CK = 3 * MiB, WS_CV = 5 * MiB, WS_X = 8 * MiB, WS_H = 104 * MiB;
constexpr size_t WS_ACT = 154 * MiB;
constexpr size_t WS_Q = 154 * MiB, WS_K = 202 * MiB, WS_V = 214 * MiB, WS_GLU = 226 * MiB, WS_BG = 250 * MiB, WS_CX = 274 * MiB, WS_GATES = 298 * MiB;
constexpr size_t WS_ABR = 442 * MiB, WS_MIX = 540 * MiB;
constexpr size_t WS_WT = 590 * MiB, WT_LAYER = 222 * MiB;
constexpr size_t WT_1I = 0, WT_1O = 46 * MiB, WT_IN = 69 * MiB, WT_MIXB = 127 * MiB  , WT_OUT = 144 * MiB, WT_2I = 153 * MiB, WT_2O = 199 * MiB;
constexpr size_t WS_END = WS_WT + 2 * WT_LAYER;
static_assert((size_t)M * H_LD * 2 <= 50 * MiB && (size_t)M * ACT_LD * 2 <= 134 * MiB && (size_t)M * ABR_LD * 2 <= 98 * MiB && (size_t)M * MIX_LD * 2 <= 50 * MiB, "activation map");
static_assert((size_t)2 * DFF * WK_D * 2 <= 46 * MiB && (size_t)D * WK_FF * 2 <= 23 * MiB && (size_t)INC * WK_D * 2 <= 58 * MiB && (size_t)D * WK_MIX * 2 <= 17 * MiB && (size_t)D * WK_D * 2 <= 9 * MiB, "weight map");
constexpr int CW_BAR = 4096;

__device__ __forceinline__ int fresh_tid() { int t = threadIdx.x; asm volatile("" : "+v"(t)); return t; }

__device__ __forceinline__ int fresh_i(int v) { asm volatile("" : "+s"(v)); return v; }
struct Args { const float* in[26]; float* out; unsigned char* ws; int ph_lo, ph_hi; };
__device__ __forceinline__ const Args* fresh_args() { auto p = __builtin_amdgcn_kernarg_segment_ptr(); asm volatile("" : "+s"(p)); return (const Args*)p; }

namespace pg8 {
#define PG8_LAS __attribute__((address_space(3)))
typedef unsigned short bf16_t;
typedef short bf16x8 __attribute__((ext_vector_type(8)));
typedef float f32x4 __attribute__((ext_vector_type(4)));
typedef unsigned u32x4 __attribute__((ext_vector_type(4)));
constexpr int BM = 256, BK = 64, HALF = 128, HTB = HALF * BK * 2  , STAGE_BYTES = 8 * HTB, NXCD = 8, WGM = 8;

__host__ __device__ __forceinline__ int lds_byte(int r, int c) { const int st = (r >> 4) * 2 + (c >> 5), rr = r & 15, cc = c & 31, ob = rr * 64 + cc * 2; return st * 1024 + (ob ^ (((ob >> 9) & 1) << 5)); }
__host__ __device__ __forceinline__ void stage_rc(int b, int& R, int& C) { const int st = b / 1024, sb = b % 1024, swz = sb ^ (((sb >> 9) & 1) << 5); R = (st >> 1) * 16 + swz / 64; C = (st & 1) * 32 + (swz % 64) / 2; }
__host__ __device__ __forceinline__ int perm32(int rho) { const int n = rho >> 4, i = rho & 15; return 8 * (i >> 2) + 4 * n + (i & 3); }

struct Unit { int pm, pn; };
struct Gemm { const bf16_t* A; const bf16_t* Bt; int M, N, K; };

struct StaticOrder {
    int nM, nN, nwg, G, c;
    __host__ __device__ void init(int M, int N, int G_, int c_) { nM = M / BM; nN = N / BM; nwg = nM * nN; G = G_; c = c_; }
    __host__ __device__ bool next(int i, Unit& u) const {
        const long L = (long)i * G + c; if (L >= nwg) return false;
        int wgid = (int)L; { const int q = nwg / NXCD, r = nwg % NXCD, xcd = wgid % NXCD, off = wgid / NXCD; wgid = (xcd < r ? xcd * (q + 1) : r * (q + 1) + (xcd - r) * q) + off; }
        const int nig = WGM * nN, gid = wgid / nig, fm = gid * WGM, gsz = (nM - fm) < WGM ? (nM - fm) : WGM;
        u.pm = fm + ((wgid % nig) % gsz); u.pn = (wgid % nig) / gsz; return true;
    }
    __device__ __forceinline__ void a_ready(const Unit&) const {}
    __device__ __forceinline__ void done(const Unit&) const {}
};

__device__ __forceinline__ unsigned cvt_pk_bf16(float lo, float hi) { unsigned r; asm volatile("v_cvt_pk_bf16_f32 %0, %1, %2" : "=v"(r) : "v"(lo), "v"(hi)); return r; }
typedef float f32x2 __attribute__((ext_vector_type(2)));
__device__ __forceinline__ f32x2 gelu_pk(f32x2 v) {
    const f32x2 av = __builtin_elementwise_abs(v), d = av * 0.2316418882f + 1.0f;
    f32x2 t; t.x = __builtin_amdgcn_rcpf(d.x); t.y = __builtin_amdgcn_rcpf(d.y);
    f32x2 q = t * 0.5307027145f + (-0.7265760135f); q = q * t + 0.7107068705f; q = q * t + (-0.142248368f); q = q * t + 0.127414796f; q = q * t;
    const f32x2 s = (v * v) * (-0.72134752044f);
    f32x2 e; e.x = __builtin_amdgcn_exp2f(s.x); e.y = __builtin_amdgcn_exp2f(s.y);
    const f32x2 m = v * (q * e), r = v - m;
    f32x2 o; o.x = v.x < 0.f ? m.x : r.x; o.y = v.y < 0.f ? m.y : r.y; return o;
}

struct UnitK : Unit { int half, rofs; };
__device__ __forceinline__ float fsigm(float x) { return __builtin_amdgcn_rcpf(1.f + __builtin_amdgcn_exp2f(-1.4426950408889634f * x)); }
__device__ __forceinline__ float fsilu(float x) { return x * fsigm(x); }
__device__ __forceinline__ u32x4 pack8(f32x4 a, f32x4 b) { u32x4 w; w.x = cvt_pk_bf16(a[0], a[1]); w.y = cvt_pk_bf16(a[2], a[3]); w.z = cvt_pk_bf16(b[0], b[1]); w.w = cvt_pk_bf16(b[2], b[3]); return w; }
__device__ __forceinline__ void unpack8(u32x4 w, f32x4& a, f32x4& b) {
    a[0] = __builtin_bit_cast(float, w.x << 16); a[1] = __builtin_bit_cast(float, w.x & 0xffff0000u); a[2] = __builtin_bit_cast(float, w.y << 16); a[3] = __builtin_bit_cast(float, w.y & 0xffff0000u);
    b[0] = __builtin_bit_cast(float, w.z << 16); b[1] = __builtin_bit_cast(float, w.z & 0xffff0000u); b[2] = __builtin_bit_cast(float, w.w << 16); b[3] = __builtin_bit_cast(float, w.w & 0xffff0000u);
}
enum { PO_SWIGLU = 0, PO_GLU = 1, PO_MUL = 2 };
template <int OP> __device__ __forceinline__ f32x4 pair_op(f32x4 a, f32x4 b) {
    f32x4 o;
#pragma unroll
    for (int e = 0; e < 4; ++e) o[e] = OP == PO_SWIGLU ? fsilu(a[e]) * b[e] : (OP == PO_GLU ? a[e] * fsigm(b[e]) : a[e] * b[e]);
    return o;
}
struct EpiSwiglu {
    static constexpr bool PERM = true, AFTER_DRAIN = false, RESCALE = false;
    bf16_t* O; int ldc;
    __device__ __forceinline__ void operator()(const f32x4 (&acc)[2][2][4][2], const UnitK& u, int wr, int wc, int fr, int fq) const {
        const int row0 = u.pm * BM + u.rofs + wr * 64 + fr, col0 = u.pn * HALF + wc * 32 + 8 * fq;
#pragma unroll
        for (int ai = 0; ai < 2; ++ai) { if (ai == 1 && u.half) break;
#pragma unroll
            for (int m = 0; m < 4; ++m) {
                bf16_t* rowp = O + (size_t)(row0 + ai * HALF + m * 16) * ldc + col0;
                *(u32x4*)rowp = pack8(pair_op<PO_SWIGLU>(acc[ai][0][m][0], acc[ai][1][m][0]), pair_op<PO_SWIGLU>(acc[ai][0][m][1], acc[ai][1][m][1]));
            } }
    }
};
struct EpiResid {
    static constexpr bool PERM = true, AFTER_DRAIN = false, RESCALE = false;
    float* X; const float* gate; float coef;
    __device__ __forceinline__ void operator()(const f32x4 (&acc)[2][2][4][2], const UnitK& u, int wr, int wc, int fr, int fq) const {
        const int row0 = u.pm * BM + u.rofs + wr * 64 + fr, col0 = u.pn * BM + wc * 32 + 8 * fq;
        const int cond = u.pm < 16 ? 0 : (u.pm < 32 ? 1 : 2);
        const float* gp = gate + (size_t)cond * NMOD + col0;
        f32x4 g[2][2];
#pragma unroll
        for (int bj = 0; bj < 2; ++bj)
#pragma unroll
            for (int n = 0; n < 2; ++n) g[bj][n] = *(const f32x4*)(gp + bj * HALF + 4 * n) * coef;
#pragma unroll
        for (int ai = 0; ai < 2; ++ai) { if (ai == 1 && u.half) break;
#pragma unroll
            for (int m = 0; m < 4; ++m) {
                float* rowp = X + (size_t)(row0 + ai * HALF + m * 16) * D + col0;
#pragma unroll
                for (int bj = 0; bj < 2; ++bj)
#pragma unroll
                    for (int n = 0; n < 2; ++n) { f32x4* p = (f32x4*)(rowp + bj * HALF + 4 * n); *p = *p + g[bj][n] * acc[ai][bj][m][n]; }
            } }
    }
};
struct EpiWin {
    static constexpr bool PERM = true, AFTER_DRAIN = false, RESCALE = false;
    unsigned char* ws; float* out; int layer;
    __device__ __forceinline__ void operator()(const f32x4 (&acc)[2][2][4][2], const UnitK& u, int wr, int wc, int fr, int fq) const {
        bf16_t* const Qb = (bf16_t*)(ws + WS_Q); bf16_t* const Kb = (bf16_t*)(ws + WS_K); bf16_t* const Vb = (bf16_t*)(ws + WS_V); bf16_t* const GLU = (bf16_t*)(ws + WS_GLU); bf16_t* const BG = (bf16_t*)(ws + WS_BG);
        bf16_t* const CX = (bf16_t*)(ws + WS_CX); bf16_t* const GATES = (bf16_t*)(ws + WS_GATES); const float* const rope = (const float*)(ws + WS_ROPE);
        float* const nk = out + (size_t)M * D; float* const nv = nk + (size_t)16 * 2 * SEQC * KVD;
        const int pn = u.pn, row0 = u.pm * BM + u.rofs + wr * 64 + fr, cw = wc * 32 + 8 * fq;
        const bool latent = u.pm >= 16;
        if (pn < 10) {
            const bool isq = pn < 8; const int hp = isq ? pn : pn - 8;
            const int ocol = (2 * hp + (wc >> 1)) * 128 + 64 * (wc & 1) + 8 * fq;
            bf16_t* base = isq ? Qb : Kb; const int ld = isq ? D : KVD;
#pragma unroll
            for (int ai = 0; ai < 2; ++ai) { if (ai == 1 && u.half) break;
#pragma unroll
                for (int m = 0; m < 4; ++m) {
                    const int row = row0 + ai * HALF + m * 16;
                    const f32x4 x1a = acc[ai][0][m][0], x1b = acc[ai][0][m][1], x2a = acc[ai][1][m][0], x2b = acc[ai][1][m][1];
                    f32x4 o1a = x1a, o1b = x1b, o2a = x2a, o2b = x2b;
                    if (latent) {
                        const int t = (row - MC) & (SEQL - 1), pos = (wc & 1) ? (t & 63) : (t >> 6);
                        const f32x4* rp = (const f32x4*)(rope + ((size_t)pos * 32 + 8 * fq) * 2);
                        const f32x4 r0 = rp[0], r1 = rp[1], r2 = rp[2], r3 = rp[3];
                        o1a[0] = x1a[0] * r0[0] - x2a[0] * r0[1]; o2a[0] = x2a[0] * r0[0] + x1a[0] * r0[1];
                        o1a[1] = x1a[1] * r0[2] - x2a[1] * r0[3]; o2a[1] = x2a[1] * r0[2] + x1a[1] * r0[3];
                        o1a[2] = x1a[2] * r1[0] - x2a[2] * r1[1]; o2a[2] = x2a[2] * r1[0] + x1a[2] * r1[1];
                        o1a[3] = x1a[3] * r1[2] - x2a[3] * r1[3]; o2a[3] = x2a[3] * r1[2] + x1a[3] * r1[3];
                        o1b[0] = x1b[0] * r2[0] - x2b[0] * r2[1]; o2b[0] = x2b[0] * r2[0] + x1b[0] * r2[1];
                        o1b[1] = x1b[1] * r2[2] - x2b[1] * r2[3]; o2b[1] = x2b[1] * r2[2] + x1b[1] * r2[3];
                        o1b[2] = x1b[2] * r3[0] - x2b[2] * r3[1]; o2b[2] = x2b[2] * r3[0] + x1b[2] * r3[1];
                        o1b[3] = x1b[3] * r3[2] - x2b[3] * r3[3]; o2b[3] = x2b[3] * r3[2] + x1b[3] * r3[3];
                    }
                    bf16_t* op = base + (size_t)row * ld + ocol;
                    *(u32x4*)op = pack8(o1a, o1b); *(u32x4*)(op + 32) = pack8(o2a, o2b);
                    if (!isq && !latent) { float* p = nk + ((size_t)((row >> 8) * 2 + layer) * SEQC + (row & 255)) * KVD + ocol;
                        *(f32x4*)p = x1a; *(f32x4*)(p + 4) = x1b; *(f32x4*)(p + 32) = x2a; *(f32x4*)(p + 36) = x2b; }
                } }
        } else if (pn < 12) {
#pragma unroll
            for (int ai = 0; ai < 2; ++ai) { if (ai == 1 && u.half) break;
#pragma unroll
                for (int m = 0; m < 4; ++m) {
                    const int row = row0 + ai * HALF + m * 16;
#pragma unroll
                    for (int bj = 0; bj < 2; ++bj) { const int col = (pn - 10) * BM + bj * HALF + cw;
                        *(u32x4*)(Vb + (size_t)row * KVD + col) = pack8(acc[ai][bj][m][0], acc[ai][bj][m][1]);
                        if (!latent) { float* p = nv + ((size_t)((row >> 8) * 2 + layer) * SEQC + (row & 255)) * KVD + col; *(f32x4*)p = acc[ai][bj][m][0]; *(f32x4*)(p + 4) = acc[ai][bj][m][1]; } }
                } }
        } else if (pn < 20 || (pn >= 24 && pn < 32)) {
            const bool glu = pn < 20; bf16_t* base = glu ? GLU : CX; const int col = (glu ? pn - 12 : pn - 24) * HALF + cw;
#pragma unroll
            for (int ai = 0; ai < 2; ++ai) { if (ai == 1 && u.half) break;
#pragma unroll
                for (int m = 0; m < 4; ++m) {
                    bf16_t* op = base + (size_t)(row0 + ai * HALF + m * 16) * DCA + col;
                    if (glu) *(u32x4*)op = pack8(pair_op<PO_GLU>(acc[ai][0][m][0], acc[ai][1][m][0]), pair_op<PO_GLU>(acc[ai][0][m][1], acc[ai][1][m][1]));
                    else     *(u32x4*)op = pack8(pair_op<PO_MUL>(acc[ai][0][m][0], acc[ai][1][m][0]), pair_op<PO_MUL>(acc[ai][0][m][1], acc[ai][1][m][1]));
                } }
        } else if (pn < 24) {
#pragma unroll
            for (int ai = 0; ai < 2; ++ai) { if (ai == 1 && u.half) break;
#pragma unroll
                for (int m = 0; m < 4; ++m)
#pragma unroll
                    for (int bj = 0; bj < 2; ++bj)
                        *(u32x4*)(BG + (size_t)(row0 + ai * HALF + m * 16) * DCA + (pn - 20) * BM + bj * HALF + cw) = pack8(acc[ai][bj][m][0], acc[ai][bj][m][1]); }
        } else {
#pragma unroll
            for (int ai = 0; ai < 2; ++ai) { if (ai == 1 && u.half) break;
#pragma unroll
                for (int m = 0; m < 4; ++m)
#pragma unroll
                    for (int bj = 0; bj < 2; ++bj) { f32x4 a = acc[ai][bj][m][0], b = acc[ai][bj][m][1];
#pragma unroll
                        for (int e = 0; e < 4; ++e) { a[e] = fmaxf(fsigm(a[e]), 1e-20f); b[e] = fmaxf(fsigm(b[e]), 1e-20f); }
                        *(u32x4*)(GATES + (size_t)(row0 + ai * HALF + m * 16) * (3 * D) + (pn - 32) * BM + bj * HALF + cw) = pack8(a, b); } }
        }
    }
};
struct EpiMixK {
    static constexpr bool PERM = true, AFTER_DRAIN = false, RESCALE = true;
    bf16_t* MIX; const bf16_t* GATES;
    __device__ __forceinline__ void rescale(f32x4 (&acc)[2][2][4][2], const UnitK& u, int stage, int wr, int wc, int fr, int fq) const {
        const int row0 = u.pm * BM + u.rofs + wr * 64 + fr, col0 = u.pn * BM + wc * 32 + 8 * fq;
#pragma unroll
        for (int ai = 0; ai < 2; ++ai) { if (ai == 1 && u.half) break;
#pragma unroll
            for (int m = 0; m < 4; ++m) {
                const bf16_t* gp = GATES + (size_t)(row0 + ai * HALF + m * 16) * (3 * D) + (size_t)stage * D + col0;
#pragma unroll
                for (int bj = 0; bj < 2; ++bj) { f32x4 na, nb, da, db; unpack8(*(const u32x4*)(gp + bj * HALF), na, nb); unpack8(*(const u32x4*)(gp + D + bj * HALF), da, db);
#pragma unroll
                    for (int e_ = 0; e_ < 4; ++e_) { acc[ai][bj][m][0][e_] *= na[e_] * __builtin_amdgcn_rcpf(da[e_]); acc[ai][bj][m][1][e_] *= nb[e_] * __builtin_amdgcn_rcpf(db[e_]); } }
            } }
    }
    __device__ __forceinline__ void operator()(const f32x4 (&acc)[2][2][4][2], const UnitK& u, int wr, int wc, int fr, int fq) const {
        const int row0 = u.pm * BM + u.rofs + wr * 64 + fr, col0 = u.pn * BM + wc * 32 + 8 * fq;
#pragma unroll
        for (int ai = 0; ai < 2; ++ai) { if (ai == 1 && u.half) break;
#pragma unroll
            for (int m = 0; m < 4; ++m) {
                const size_t row = (size_t)(row0 + ai * HALF + m * 16);
#pragma unroll
                for (int bj = 0; bj < 2; ++bj) { const int col = col0 + bj * HALF;
                    f32x4 ga, gb; unpack8(*(const u32x4*)(GATES + row * (3 * D) + 2 * D + col), ga, gb);
                    *(u32x4*)(MIX + row * MIX_LD + col) = pack8(ga * acc[ai][bj][m][0], gb * acc[ai][bj][m][1]); }
            } }
    }
};

template <int MM, int NN, int KK, bool HT> struct TailOrder {
    static constexpr int nM = MM / BM, nN = NN / BM, nwg = nM * nN;
    int G, c;
    __device__ __forceinline__ void init(int G_, int c_) { G = G_; c = c_; }
    __device__ __forceinline__ void map(int L, UnitK& u) const {
        int wgid = L; { constexpr int q = nwg / NXCD, r = nwg % NXCD; const int xcd = wgid % NXCD, off = wgid / NXCD; wgid = (xcd < r ? xcd * (q + 1) : r * (q + 1) + (xcd - r) * q) + off; }
        constexpr int nig = WGM * nN; const int gid = wgid / nig, fm = gid * WGM, gsz = (nM - fm) < WGM ? (nM - fm) : WGM;
        u.pm = fm + ((wgid % nig) % gsz); u.pn = (wgid % nig) / gsz; }
    __device__ __forceinline__ bool next(int i, UnitK& u) const {
        const int F = nwg / G, Rem = nwg - F * G;
        const int s0 = Rem > 0 ? G / Rem : 1; const int s = (HT && Rem > 0 && (G % 8 == 0) && (G % Rem == 0) && ((G / 8) % s0 == 0) && s0 >= 2) ? s0 : 1;
        const bool ht = s > 1; const int x = c & 7, y = c >> 3, q = ht ? y % s : 0;
        const bool tail = i == F;
        const bool has = i < F || (tail && (ht ? q < 2 : c < Rem));
        if (i > F || !has) return false;
        const int L = (tail && ht) ? F * G + x + 8 * (y / s) : i * G + c;
        map(L, u); u.half = (tail && ht) ? 1 : 0; u.rofs = (tail && ht) ? 128 * q : 0;
        return true; }
    __device__ __forceinline__ void a_ready(const Unit&) const {}
    __device__ __forceinline__ void done(const Unit&) const {}
};

template <int NN, int PM0, int NML, int R, int KA, int KB> struct DealOrder {
    static constexpr int nN = NN / BM, U = NML * nN, Q = U / 8;
    static_assert(NML % 8 == 0 && R * KA + (32 - R) * KB == Q, "DealOrder: the per-rank counts must cover the XCD chunk exactly");
    int G, c;
    __device__ __forceinline__ void init(int G_, int c_) { G = G_; c = c_; }
    __device__ __forceinline__ bool next(int i, UnitK& u) const {
        const bool grid_ok = G == 256; const int x = c & 7, r = c >> 3;
        const int cnt = grid_ok ? (r < R ? KA : KB) : (U - c + G - 1) / G;
        if (i >= cnt) return false;
        constexpr int lo = KA < KB ? KA : KB;
        const int idx = i < lo ? i * 32 + r : (KA > KB ? lo * 32 + (i - lo) * R + r : lo * 32 + (i - lo) * (32 - R) + (r - R));
        const int L = grid_ok ? x * Q + idx : i * G + c;
        constexpr int nig = 8 * nN; const int gid = L / nig, rem = L % nig;
        u.pm = PM0 + gid * 8 + (rem & 7); u.pn = rem >> 3; u.half = 0; u.rofs = 0;
        return true; }
    __device__ __forceinline__ void a_ready(const Unit&) const {}
    __device__ __forceinline__ void done(const Unit&) const {}
};
template <class Epi, class Sched, int KK, int LDA, int LDB>
__device__ __forceinline__ void gemm_phase_ht(PG8_LAS unsigned char* lds, const Gemm g, const Sched& S, const Epi& E) {
    constexpr bool ALIGN_EPI = true, SP2 = true;
    const int tid = fresh_tid(), wid = __builtin_amdgcn_readfirstlane(tid >> 6), lane = tid & 63, wr = wid >> 2, wc = wid & 3, fr = lane & 15, fq = lane >> 4;
    constexpr int K = KK, nt = K / BK;
    unsigned voffA[2], voffB[2];
#pragma unroll
    for (int i = 0; i < 2; ++i) { int R, C; stage_rc(tid * 16 + i * 8192, R, C); const int Rb = Epi::PERM ? ((R & ~31) + perm32(R & 31)) : R;
        voffA[i] = (unsigned)(R * LDA + C) * 2u; voffB[i] = (unsigned)(Rb * LDB + C) * 2u; }
    constexpr size_t kstep = (size_t)(BK * 2);
    constexpr size_t hstepA = (size_t)HALF * LDA * 2, hstepB = (size_t)HALF * LDB * 2;
    constexpr size_t tstepA = 2 * hstepA, tstepB = 2 * hstepB;
    const unsigned ldsw = (unsigned)wid * 1024u;
    const int aoff = lds_byte(wr * 64 + fr, fq * 8), boff = lds_byte(wc * 32 + fr, fq * 8);
#define PG8_SA(b, h) (((b) * 2 + (h)) * HTB)
#define PG8_SB(b, h) ((4 + (b) * 2 + (h)) * HTB)
#define PG8_STAGE(bufoff, gbase, voff) do { _Pragma("unroll") for (int _i = 0; _i < 2; ++_i) \
        __builtin_amdgcn_global_load_lds((const unsigned*)((const char*)(gbase) + (voff)[_i]), (PG8_LAS unsigned*)(lds + (bufoff) + ldsw + _i * 8192), 16, 0, 0); } while (0)
#define PG8_LDA(dst, b, h) do { _Pragma("unroll") for (int m = 0; m < 4; ++m) _Pragma("unroll") for (int k = 0; k < 2; ++k) dst[m][k] = *(const PG8_LAS bf16x8*)(lds + PG8_SA(b, h) + aoff + m * 2048 + k * 1024); } while (0)
#define PG8_LDB(dst, b, h) do { _Pragma("unroll") for (int n = 0; n < 2; ++n) _Pragma("unroll") for (int k = 0; k < 2; ++k) dst[n][k] = *(const PG8_LAS bf16x8*)(lds + PG8_SB(b, h) + boff + n * 2048 + k * 1024); } while (0)
#define PG8_MMA(ai, bj, At, Bt) do { __builtin_amdgcn_s_setprio(1); _Pragma("unroll") for (int m = 0; m < 4; ++m) _Pragma("unroll") for (int n = 0; n < 2; ++n) _Pragma("unroll") for (int k = 0; k < 2; ++k) \
        acc[ai][bj][m][n] = __builtin_amdgcn_mfma_f32_16x16x32_bf16(Bt[n][k], At[m][k], acc[ai][bj][m][n], 0, 0, 0); __builtin_amdgcn_s_setprio(0); } while (0)
#define PG8_WAIT_V(n) asm volatile("s_waitcnt vmcnt(" #n ")" ::: "memory")
#define PG8_WAIT_L(n) asm volatile("s_waitcnt lgkmcnt(" #n ")" ::: "memory")
#define PG8_BAR __builtin_amdgcn_s_barrier()
#define PG8_SCHED __builtin_amdgcn_sched_barrier(0)
    UnitK cur, nxt; int ui = 0;
    if (!S.next(0, cur)) return;
    f32x4 acc[2][2][4][2];
#pragma unroll
    for (int a = 0; a < 2; ++a)
#pragma unroll
        for (int b = 0; b < 2; ++b)
#pragma unroll
            for (int m = 0; m < 4; ++m)
#pragma unroll
                for (int n = 0; n < 2; ++n) acc[a][b][m][n] = (f32x4){0.f, 0.f, 0.f, 0.f};
    bf16x8 At[4][2], B0[2][2], B1[2][2];
    const char* cA = (const char*)g.A + (size_t)cur.pm * tstepA + (size_t)cur.rofs * (LDA * 2); const char* cB = (const char*)g.Bt + (size_t)cur.pn * tstepB;
    S.a_ready(cur);
    if constexpr (SP2) {
        PG8_STAGE(PG8_SB(0, 0), cB, voffB); PG8_STAGE(PG8_SB(0, 1), cB + hstepB, voffB); PG8_STAGE(PG8_SA(0, 0), cA, voffA); PG8_STAGE(PG8_SA(0, 1), cA + hstepA, voffA);
        if (wr == 1) PG8_BAR;
        PG8_WAIT_V(2); PG8_BAR;
        PG8_STAGE(PG8_SB(1, 0), cB + kstep, voffB); PG8_STAGE(PG8_SA(1, 0), cA + kstep, voffA); PG8_STAGE(PG8_SB(1, 1), cB + hstepB + kstep, voffB);
        PG8_WAIT_V(6); PG8_BAR;
    } else {
        PG8_STAGE(PG8_SB(0, 0), cB, voffB); PG8_STAGE(PG8_SA(0, 0), cA, voffA); PG8_STAGE(PG8_SB(0, 1), cB + hstepB, voffB); PG8_STAGE(PG8_SA(0, 1), cA + hstepA, voffA);
        if (wr == 1) PG8_BAR;
        PG8_WAIT_V(4); PG8_BAR;
        PG8_STAGE(PG8_SB(1, 0), cB + kstep, voffB); PG8_STAGE(PG8_SA(1, 0), cA + kstep, voffA); PG8_STAGE(PG8_SB(1, 1), cB + hstepB + kstep, voffB);
        PG8_WAIT_V(6); PG8_BAR;
    }
    for (;;) {
        const bool has_next = S.next(ui + 1, nxt);
        const char* nA = has_next ? (const char*)g.A + (size_t)nxt.pm * tstepA + (size_t)nxt.rofs * (LDA * 2) : cA; const char* nB = has_next ? (const char*)g.Bt + (size_t)nxt.pn * tstepB : cB;
        for (int t = 0; t < nt; t += 2) {
            if constexpr (Epi::RESCALE) { if (t == 16 || t == 32) { const int tid_r = fresh_tid(); E.rescale(acc, cur, t == 16 ? 0 : 1, wr, wc, tid_r & 15, (tid_r & 63) >> 4); } }
            const bool last = (t == nt - 2);
            const char* a1 = cA + (size_t)(t + 1) * kstep;
            const char* a2 = last ? nA : cA + (size_t)(t + 2) * kstep; const char* b2 = last ? nB : cB + (size_t)(t + 2) * kstep;
            const char* a3 = a2 + kstep; const char* b3 = b2 + kstep;
            if (last && has_next) S.a_ready(nxt);
            if constexpr (SP2) {
            PG8_LDB(B0, 0, 0); PG8_LDB(B1, 0, 1); PG8_SCHED; PG8_LDA(At, 0, 0); PG8_STAGE(PG8_SA(1, 1), a1 + hstepA, voffA);
            PG8_WAIT_V(8); PG8_WAIT_L(0); PG8_BAR; PG8_MMA(0, 0, At, B0); PG8_MMA(0, 1, At, B1); PG8_BAR; PG8_SCHED;
            PG8_LDA(At, 0, 1); PG8_STAGE(PG8_SB(0, 0), b2, voffB); PG8_STAGE(PG8_SB(0, 1), b2 + hstepB, voffB); PG8_STAGE(PG8_SA(0, 0), a2, voffA);
            PG8_WAIT_V(8); PG8_WAIT_L(0); PG8_BAR; if (!cur.half) { PG8_MMA(1, 0, At, B0); PG8_MMA(1, 1, At, B1); } PG8_BAR; PG8_SCHED;
            PG8_LDB(B0, 1, 0); PG8_LDB(B1, 1, 1); PG8_SCHED; PG8_LDA(At, 1, 0); PG8_STAGE(PG8_SA(0, 1), a2 + hstepA, voffA);
            PG8_WAIT_V(8); PG8_WAIT_L(0); PG8_BAR; PG8_MMA(0, 0, At, B0); PG8_MMA(0, 1, At, B1); PG8_BAR; PG8_SCHED;
            PG8_LDA(At, 1, 1); PG8_STAGE(PG8_SB(1, 0), b3, voffB); PG8_STAGE(PG8_SB(1, 1), b3 + hstepB, voffB); PG8_STAGE(PG8_SA(1, 0), a3, voffA);
            PG8_WAIT_V(8); PG8_WAIT_L(0); PG8_BAR; if (!cur.half) { PG8_MMA(1, 0, At, B0); PG8_MMA(1, 1, At, B1); } PG8_BAR; PG8_SCHED;
            } else {
            PG8_LDB(B0, 0, 0); PG8_SCHED; PG8_LDA(At, 0, 0); PG8_STAGE(PG8_SA(1, 1), a1 + hstepA, voffA);
            PG8_WAIT_L(8); PG8_BAR; PG8_WAIT_L(0); PG8_MMA(0, 0, At, B0); PG8_BAR; PG8_SCHED;
            PG8_LDB(B1, 0, 1); PG8_STAGE(PG8_SB(0, 0), b2, voffB);
            PG8_BAR; PG8_WAIT_L(0); PG8_MMA(0, 1, At, B1); PG8_BAR;
            PG8_LDA(At, 0, 1); PG8_STAGE(PG8_SA(0, 0), a2, voffA);
            PG8_BAR; PG8_WAIT_L(0); PG8_MMA(1, 0, At, B0); PG8_BAR; PG8_SCHED;
            PG8_STAGE(PG8_SB(0, 1), b2 + hstepB, voffB);
            PG8_WAIT_V(6); PG8_BAR; PG8_MMA(1, 1, At, B1); PG8_BAR;
            PG8_LDB(B0, 1, 0); PG8_SCHED; PG8_LDA(At, 1, 0); PG8_STAGE(PG8_SA(0, 1), a2 + hstepA, voffA);
            PG8_WAIT_L(8); PG8_BAR; PG8_WAIT_L(0); PG8_MMA(0, 0, At, B0); PG8_BAR; PG8_SCHED;
            PG8_LDB(B1, 1, 1); PG8_STAGE(PG8_SB(1, 0), b3, voffB);
            PG8_BAR; PG8_WAIT_L(0); PG8_MMA(0, 1, At, B1); PG8_BAR;
            PG8_LDA(At, 1, 1); PG8_STAGE(PG8_SA(1, 0), a3, voffA);
            PG8_BAR; PG8_WAIT_L(0); PG8_MMA(1, 0, At, B0); PG8_BAR; PG8_SCHED;
            PG8_STAGE(PG8_SB(1, 1), b3 + hstepB, voffB);
            PG8_WAIT_V(6); PG8_BAR; PG8_MMA(1, 1, At, B1); PG8_BAR;
            }
        }
        if constexpr (ALIGN_EPI) { if (wr == 0) PG8_BAR; }
        { const int tid_e = fresh_tid(); E(acc, cur, wr, wc, tid_e & 15, (tid_e & 63) >> 4); }
        if (!has_next) break;
#pragma unroll
        for (int a = 0; a < 2; ++a)
#pragma unroll
            for (int b = 0; b < 2; ++b)
#pragma unroll
                for (int m = 0; m < 4; ++m)
#pragma unroll
                    for (int n = 0; n < 2; ++n) acc[a][b][m][n] = (f32x4){0.f, 0.f, 0.f, 0.f};
        cur = nxt; cA = nA; cB = nB; ++ui;
        if constexpr (ALIGN_EPI) { if (wr == 1) PG8_BAR; }
    }
    PG8_WAIT_V(0);
    if constexpr (!ALIGN_EPI) { if (wr == 0) PG8_BAR; }
    PG8_BAR;
#undef PG8_SA
#undef PG8_SB
#undef PG8_STAGE
#undef PG8_LDA
#undef PG8_LDB
#undef PG8_MMA
#undef PG8_WAIT_V
#undef PG8_WAIT_L
#undef PG8_BAR
#undef PG8_SCHED
}
}

namespace att {
typedef unsigned short bf16;
typedef short bf16x8 __attribute__((ext_vector_type(8)));
typedef short s16x4 __attribute__((ext_vector_type(4)));
typedef float f32x16 __attribute__((ext_vector_type(16)));
typedef unsigned u32x4 __attribute__((ext_vector_type(4)));
constexpr float SCALE = 0.08838834764831845f, THR = 8.f;
constexpr int SHM_V = 16384, SHM_K = 16384, NW = 8;
constexpr int LDS_BYTES = 2 * SHM_V + 2 * SHM_K + NW * 64 * 4;
#define KSWZ(row, colB) ((row) * 256 + ((colB) ^ (((row) & 7) << 4)))
#define SBAR() __builtin_amdgcn_sched_barrier(0)
__device__ __forceinline__ int v_st(int k, int c) { const int kk = (k & ~0xC) | ((k & 4) << 1) | ((k & 8) >> 1); return ((kk >> 3) * 4 + (c >> 5)) * 512 + ((kk & 7) * 32 + (c & 31)) * 2; }
__device__ __forceinline__ int v_rd_base(int lane) { return ((lane & 3) << 3) | (((lane >> 2) & 3) << 6) | (((lane >> 4) & 1) << 5) | (((lane >> 5) & 1) << 8); }
constexpr int v_rd_off(int d0, int ks, int half) { return d0 * 512 + ks * 4096 + half * 2048; }
__device__ __forceinline__ int crow(int r, int hi) { return (r & 3) + 8 * (r >> 2) + 4 * hi; }
__device__ __forceinline__ unsigned cvtpk(float lo, float hi) { unsigned r; asm volatile("v_cvt_pk_bf16_f32 %0, %1, %2" : "=v"(r) : "v"(lo), "v"(hi)); return r; }
__device__ __forceinline__ void mask_tile(f32x16& p0, f32x16& p1, int d, int type) {
    const float NEG = -__builtin_inff();
#pragma unroll
    for (int r = 0; r < 16; ++r) {
        const int c = (r & 3) + 8 * (r >> 2);
        if (type == 1) { if (c < d) p0[r] = NEG; if (c + 32 < d) p1[r] = NEG; }
        else           { if (c > d) p0[r] = NEG; if (c + 32 > d) p1[r] = NEG; }
    }
}
__device__ __forceinline__ void partialSM(f32x16& p0, f32x16& p1, float& m_reg, float& mn, float& alpha) {
    float pmax = p0[0]; for (int r = 1; r < 16; ++r) pmax = fmaxf(pmax, p0[r]); for (int r = 0; r < 16; ++r) pmax = fmaxf(pmax, p1[r]);
    { auto rr = __builtin_amdgcn_permlane32_swap(__float_as_uint(pmax), __float_as_uint(pmax), false, false);
      pmax = fmaxf(__uint_as_float(rr[0]), __uint_as_float(rr[1])); }
    constexpr float C2 = 1.4426950408889634f * SCALE;
    if (__builtin_expect(__all((pmax - m_reg) * SCALE <= THR), 1)) { mn = m_reg; alpha = 1.f; }
    else { mn = fmaxf(m_reg, pmax); alpha = __builtin_amdgcn_exp2f((m_reg - mn) * C2); m_reg = mn; }
    const float mnL = -mn * C2;
    for (int r = 0; r < 16; ++r) p0[r] = fmaf(p0[r], C2, mnL); for (int r = 0; r < 16; ++r) p1[r] = fmaf(p1[r], C2, mnL);
    for (int r = 0; r < 16; ++r) p0[r] = __builtin_amdgcn_exp2f(p0[r]);
}
__device__ __forceinline__ void finishSM(f32x16& p0, f32x16& p1, float alpha, float& l_reg, bf16x8& pa0, bf16x8& pa1, bf16x8& pa2, bf16x8& pa3) {
    for (int r = 0; r < 16; ++r) p1[r] = __builtin_amdgcn_exp2f(p1[r]);
    float ps = 0; for (int r = 0; r < 16; ++r) ps += p0[r]; for (int r = 0; r < 16; ++r) ps += p1[r];
    { auto rr = __builtin_amdgcn_permlane32_swap(__float_as_uint(ps), __float_as_uint(ps), false, false);
      ps = __uint_as_float(rr[0]) + __uint_as_float(rr[1]); }
    l_reg = l_reg * alpha + ps;
#define PK4(P, B_, OUT) do { unsigned a0 = cvtpk(P[B_+0], P[B_+1]), a1 = cvtpk(P[B_+2], P[B_+3]);                          \
        unsigned b0 = cvtpk(P[B_+4], P[B_+5]), b1 = cvtpk(P[B_+6], P[B_+7]);                                             \
        auto r0 = __builtin_amdgcn_permlane32_swap(a0, b0, false, false); auto r1 = __builtin_amdgcn_permlane32_swap(a1, b1, false, false); \
        u32x4 w = {r0[0], r1[0], r0[1], r1[1]}; OUT = *reinterpret_cast<bf16x8*>(&w); } while (0)
    PK4(p0, 0, pa0); PK4(p0, 8, pa1); PK4(p1, 0, pa2); PK4(p1, 8, pa3);
#undef PK4
}
template <int KB>
__device__ __forceinline__ void qkt(f32x16& p0, f32x16& p1, const char* K_lds, int r32, int hi, const bf16x8* qr) {
    p0 = f32x16{}; p1 = f32x16{};
    const char* kb[4];
#pragma unroll
    for (int dd = 0; dd < 4; ++dd) kb[dd] = K_lds + KB * SHM_K + KSWZ(r32, (dd * 16 + hi * 8) * 2);
#pragma unroll
    for (int d0 = 0; d0 < 8; ++d0) { const char* a = kb[d0 & 3] + (d0 >> 2) * 128;
        bf16x8 b0 = *reinterpret_cast<const bf16x8*>(a);
        bf16x8 b1 = *reinterpret_cast<const bf16x8*>(a + 32 * 256);
        p0 = __builtin_amdgcn_mfma_f32_32x32x16_bf16(b0, qr[d0], p0, 0, 0, 0);
        p1 = __builtin_amdgcn_mfma_f32_32x32x16_bf16(b1, qr[d0], p1, 0, 0, 0); }
}
template <int VB>
__device__ __forceinline__ void pv_tile(f32x16* o, int vb0, bf16x8 pa0, bf16x8 pa1, bf16x8 pa2, bf16x8 pa3) {
#define TRRD(dst, off) asm volatile("ds_read_b64_tr_b16 %0, %1 offset:%2" : "=&v"(dst) : "v"(vb0), "i"(off) : "memory")
#define PV_D0(d0) do { s16x4 l0, l1, l2, l3, h0, h1, h2, h3; constexpr int b_ = VB * SHM_V + v_rd_off(d0, 0, 0); \
        TRRD(l0, b_); TRRD(h0, b_ + 2048); TRRD(l1, b_ + 4096); TRRD(h1, b_ + 6144); TRRD(l2, b_ + 8192); TRRD(h2, b_ + 10240); TRRD(l3, b_ + 12288); TRRD(h3, b_ + 14336); \
        asm volatile("s_waitcnt lgkmcnt(0)" ::: "memory"); SBAR();   \
        o[d0] = __builtin_amdgcn_mfma_f32_32x32x16_bf16(pa0, (bf16x8){l0[0], l0[1], l0[2], l0[3], h0[0], h0[1], h0[2], h0[3]}, o[d0], 0, 0, 0);   \
        o[d0] = __builtin_amdgcn_mfma_f32_32x32x16_bf16(pa1, (bf16x8){l1[0], l1[1], l1[2], l1[3], h1[0], h1[1], h1[2], h1[3]}, o[d0], 0, 0, 0);   \
        o[d0] = __builtin_amdgcn_mfma_f32_32x32x16_bf16(pa2, (bf16x8){l2[0], l2[1], l2[2], l2[3], h2[0], h2[1], h2[2], h2[3]}, o[d0], 0, 0, 0);   \
        o[d0] = __builtin_amdgcn_mfma_f32_32x32x16_bf16(pa3, (bf16x8){l3[0], l3[1], l3[2], l3[3], h3[0], h3[1], h3[2], h3[3]}, o[d0], 0, 0, 0); } while (0)
    PV_D0(0); PV_D0(1); PV_D0(2); PV_D0(3);
#undef PV_D0
#undef TRRD
}
__device__ __forceinline__ void attn_unit(const bf16* Qw, const bf16* cK, const bf16* cV, const bf16* wK, const bf16* wV, int nctx, int NT, int tm1, int tm2, const float* sinkp, bf16* Ow, int ldo, char* lds) {
    const int tid = fresh_tid(), wid = __builtin_amdgcn_readfirstlane(tid >> 6), lane = tid & 63, r32 = lane & 31, hi = lane >> 5;
    char* V_lds = lds; char* K_lds = lds + 2 * SHM_V;
    float* wsf = (float*)(lds + 2 * SHM_V + 2 * SHM_K) + wid * 64; float* li_l = wsf, * al_l = wsf + 32;
    float m_reg = -1e30f, l_reg = 0; f32x16 o[4] = {};
    const int sr = tid >> 4, sc = (tid & 15) * 8, vst0 = v_st(sr, sc), vst1 = v_st(32 + sr, sc), kws = KSWZ(sr, sc * 2);
    const int vb0 = (int)(uintptr_t)V_lds + v_rd_base(lane);
    const int qrow = 32 * (wid & 1) + r32, hq = wid >> 1, dmask = qrow - 4 * hi;
    bf16x8 qr[8];
#pragma unroll
    for (int d0 = 0; d0 < 8; ++d0) qr[d0] = *(const bf16x8*)(Qw + (size_t)qrow * D + hq * 128 + d0 * 16 + hi * 8);
    bf16x8 st_v0, st_v1, st_k0, st_k1;
#define TILEP(t, kp, vp) const bf16* kp = (t) < nctx ? cK + (size_t)(t) * 64 * KVD : wK + (size_t)((t) - nctx) * 64 * KVD; const bf16* vp = (t) < nctx ? cV + (size_t)(t) * 64 * KVD : wV + (size_t)((t) - nctx) * 64 * KVD
#define SLOAD(t) do { TILEP(t, kp_, vp_); st_v0 = *(const bf16x8*)(vp_ + (size_t)sr * KVD + sc); st_v1 = *(const bf16x8*)(vp_ + (size_t)(32 + sr) * KVD + sc); \
                      st_k0 = *(const bf16x8*)(kp_ + (size_t)sr * KVD + sc); st_k1 = *(const bf16x8*)(kp_ + (size_t)(32 + sr) * KVD + sc); } while (0)
#define SWRITE(bf) do { *(bf16x8*)(V_lds + (bf) * SHM_V + vst0) = st_v0; *(bf16x8*)(V_lds + (bf) * SHM_V + vst1) = st_v1; \
                        *(bf16x8*)(K_lds + (bf) * SHM_K + kws) = st_k0; *(bf16x8*)(K_lds + (bf) * SHM_K + kws + 32 * 256) = st_k1; } while (0)
#define VMW() asm volatile("s_waitcnt vmcnt(0)" ::: "memory")
#define RESC(a) do { if (__any((a) < 1.f)) { if (hi == 0) al_l[r32] = (a); asm volatile("s_waitcnt lgkmcnt(0)" ::: "memory");              \
                     for (int d_ = 0; d_ < 4; ++d_) for (int r = 0; r < 16; ++r) o[d_][r] *= al_l[crow(r, hi)]; } } while (0)
    f32x16 p0, p1; float mn, al; bf16x8 pa0, pa1, pa2, pa3;
#define STEP(t, B) do { if ((t) + 1 < NT) SLOAD((t) + 1); SBAR();                                                   \
        qkt<B>(p0, p1, K_lds, r32, hi, qr);                                                                           \
        if ((t) == tm1) mask_tile(p0, p1, dmask, 1); else if ((t) == tm2) mask_tile(p0, p1, dmask, 2);                \
        partialSM(p0, p1, m_reg, mn, al); RESC(al); finishSM(p0, p1, al, l_reg, pa0, pa1, pa2, pa3); SBAR();          \
        pv_tile<B>(o, vb0, pa0, pa1, pa2, pa3);                                                                       \
        if ((t) + 1 < NT) { VMW(); SWRITE((B) ^ 1); }                                                                 \
        __syncthreads(); } while (0)
    SLOAD(0); VMW(); SWRITE(0); __syncthreads();
    for (int t = 0; t < NT; t += 2) { STEP(t, 0); if (t + 1 < NT) STEP(t + 1, 1); }
    { constexpr float C2 = 1.4426950408889634f * SCALE; const float sk = sinkp[hq];
      l_reg += __builtin_amdgcn_exp2f(sk * 1.4426950408889634f - m_reg * C2); }
    if (hi == 0) li_l[r32] = l_reg; asm volatile("s_waitcnt lgkmcnt(0)" ::: "memory");
    float rli[16];
#pragma unroll
    for (int r = 0; r < 16; ++r) rli[r] = __builtin_amdgcn_rcpf(li_l[crow(r, hi)]);
    bf16* Op = Ow + (size_t)(32 * (wid & 1)) * ldo + hq * 128;
#pragma unroll
    for (int r = 0; r < 16; ++r) { const int orow = crow(r, hi);
#pragma unroll
        for (int d0 = 0; d0 < 4; ++d0) { const float v = o[d0][r] * rli[r]; const float vn = __shfl_xor(v, 1);
            if ((r32 & 1) == 0) *(unsigned*)(Op + (size_t)orow * ldo + d0 * 32 + r32) = cvtpk(v, vn); } }
    __syncthreads();
#undef TILEP
#undef SLOAD
#undef SWRITE
#undef VMW
#undef RESC
#undef STEP
}
#undef KSWZ
#undef SBAR
}

#define GAS __attribute__((address_space(1)))
#define LAS __attribute__((address_space(3)))
typedef unsigned short bf16;
typedef unsigned v4u __attribute__((ext_vector_type(4)));
typedef float f32x4 __attribute__((ext_vector_type(4)));
typedef short bf16x8 __attribute__((ext_vector_type(8)));
typedef GAS unsigned gu32;
#define RLX_AGENT __ATOMIC_RELAXED, __HIP_MEMORY_SCOPE_AGENT
#define LDS_WAIT() asm volatile("s_waitcnt lgkmcnt(0)" ::: "memory")
#define VM_WAIT() asm volatile("s_waitcnt vmcnt(0)" ::: "memory")
__device__ __forceinline__ unsigned f2bf(float f) { unsigned u = __builtin_bit_cast(unsigned, f); return (u + 0x7fffu + ((u >> 16) & 1u)) >> 16; }
__device__ __forceinline__ unsigned pk2(float lo, float hi) { return f2bf(lo) | (f2bf(hi) << 16); }
__device__ __forceinline__ float bflo(unsigned w) { return __builtin_bit_cast(float, w << 16); }
__device__ __forceinline__ float bfhi(unsigned w) { return __builtin_bit_cast(float, w & 0xffff0000u); }
__device__ __forceinline__ float wave_sum(float v) {
#pragma unroll
    for (int o = 1; o < 64; o <<= 1) v += __shfl_xor(v, o);
    return v;
}
__device__ __forceinline__ float silu_acc(float x) { return x / (1.f + __expf(-x)); }
#define XB_TMO      128
#define XB_XCNT(j)  (256  + 64 * (j))
#define XB_XSUB(j)  (1280 + 64 * (j))
#define XB_XGEN(j)  (2304 + 64 * (j))
#define XB_TOP      3328
#define XB_TOPGEN   3392
#define XCD_BAR_WORDS 3456
#define XB_SPIN_CAP (1u << 18)

__device__ __forceinline__ unsigned xb_ld(unsigned* p)              { return __hip_atomic_load(p, __ATOMIC_RELAXED, __HIP_MEMORY_SCOPE_AGENT); }
__device__ __forceinline__ unsigned xb_add(unsigned* p, unsigned v) { return __hip_atomic_fetch_add(p, v, __ATOMIC_RELAXED, __HIP_MEMORY_SCOPE_AGENT); }
__device__ __forceinline__ unsigned xb_xcc_id() { return (unsigned)__builtin_amdgcn_s_getreg((3 << 11) | 20) & 0xFu; }
#define XB_SPIN(cond, bar) do { unsigned _sp = 0; while (cond) { __builtin_amdgcn_s_sleep(1); \
    if ((++_sp & 255u) == 0u) { if (xb_ld(&(bar)[XB_TMO])) break; if (_sp > XB_SPIN_CAP) { atomicAdd(&(bar)[XB_TMO], 1u); break; } } } } while (0)

struct XcdBarrier {
    unsigned* bar; unsigned x;
    volatile LAS unsigned* st;
};

__device__ __forceinline__ XcdBarrier xcd_barrier_post(unsigned* bar, volatile LAS unsigned* st) {
    XcdBarrier b; b.bar = bar; b.x = xb_xcc_id(); b.st = st;
    if (threadIdx.x == 0) (void)xb_add(&bar[XB_XCNT(b.x)], 1u);
    return b;
}
__device__ __forceinline__ void xcd_barrier_complete(unsigned* bar, unsigned x, unsigned& nloc, unsigned& nx) {
    const unsigned G = gridDim.x * gridDim.y * gridDim.z;
    unsigned sum, cnt, mine, sp = 0u;
    for (;;) {
        sum = 0u; cnt = 0u; mine = 0u;
#pragma unroll
        for (unsigned j = 0; j < 16; ++j) { const unsigned c = xb_ld(&bar[XB_XCNT(j)]); sum += c; cnt += (c > 0u) ? 1u : 0u; mine = (j == x) ? c : mine; }
        if (sum == G) break;
        __builtin_amdgcn_s_sleep(1);
        if ((++sp & 255u) == 0u) { if (xb_ld(&bar[XB_TMO])) break; if (sp > XB_SPIN_CAP) { atomicAdd(&bar[XB_TMO], 1u); break; } }
    }
    nloc = mine > 0u ? mine : 1u; nx = cnt > 0u ? cnt : 1u;
}

__device__ __forceinline__ void xcd_barrier(const XcdBarrier& b) {
    asm volatile("s_waitcnt vmcnt(0)" ::: "memory");
    __syncthreads();
    if (threadIdx.x == 0) {
        unsigned* bar = b.bar;
        __builtin_amdgcn_s_waitcnt(0);
        unsigned nloc = b.st[0], nx = b.st[1];
        if (nloc == 0u) { xcd_barrier_complete(bar, b.x, nloc, nx); b.st[0] = nloc; b.st[1] = nx; }
        const unsigned old = xb_add(&bar[XB_XSUB(b.x)], 1u);
        const unsigned gen = old / nloc;
        if (old + 1u == (gen + 1u) * nloc) {
            __builtin_amdgcn_fence(__ATOMIC_RELEASE, "agent");
            asm volatile("s_waitcnt vmcnt(0)" ::: "memory");
            const unsigned og = xb_add(&bar[XB_TOP], 1u);
            const unsigned tg = og / nx;
            if (og + 1u == (tg + 1u) * nx) xb_add(&bar[XB_TOPGEN], 1u);
            else XB_SPIN(xb_ld(&bar[XB_TOPGEN]) == tg, bar);
            __builtin_amdgcn_fence(__ATOMIC_ACQUIRE, "agent");
            xb_add(&bar[XB_XGEN(b.x)], 1u);
            asm volatile("s_waitcnt vmcnt(0)" ::: "memory");
        } else {
            XB_SPIN(xb_ld(&bar[XB_XGEN(b.x)]) == gen, bar);
            __builtin_amdgcn_fence(__ATOMIC_ACQUIRE, "agent");
            asm volatile("s_waitcnt vmcnt(0)" ::: "memory");
        }
    }
    __syncthreads();
}


constexpr int NWAVES = 8, NTHR = NWAVES * 64;
constexpr int RING_OFF = 0, RING_BYTES = 131072;
constexpr int LDSCTL_OFF = RING_BYTES, MISC_OFF = LDSCTL_OFF + 320;
constexpr int LDS_BYTES = 147456;
static_assert(att::LDS_BYTES <= RING_BYTES && MISC_OFF + 128 <= LDS_BYTES, "LDS map");
constexpr int N_PHASES = 27;

__device__ __forceinline__ int dest_row(int kind, int n0) {
    if (kind == 1) { const int uv = n0 / DFF, j = n0 % DFF; return 256 * (j >> 7) + 128 * uv + (j & 127); }
    if (kind == 2) {
        if (n0 < 2560) { const int isk = n0 >= 2048, nn = isk ? n0 - 2048 : n0, head = nn >> 7, d = nn & 127, part = d >> 6, x = (d >> 5) & 1;
                         return 256 * ((isk ? 8 : 0) + (head >> 1)) + 128 * x + 64 * (head & 1) + 32 * part; }
        if (n0 < 3072) return n0;
        if (n0 < 5120) { const int nn = n0 - 3072, ag = nn >> 10, j = nn & 1023; return 256 * (12 + (j >> 7)) + 128 * ag + (j & 127); }
        if (n0 < 6144) return n0;
        if (n0 < 8192) { const int nn = n0 - 6144, xv = nn >> 10, j = nn & 1023; return 256 * (24 + (j >> 7)) + 128 * xv + (j & 127); }
        return n0;
    }
    return n0;
}
__device__ __forceinline__ void p0_transpose_item(const float* W, int K, int N, bf16* WT, int kind, LAS float* scr, int item, int lane, int ldk = 0, int koff = 0) {
    if (ldk == 0) ldk = K;
    const int nblk = N / 32, kb = item / nblk, nb = item % nblk, k0 = 64 * kb, n0 = 32 * nb, drow = dest_row(kind, n0);
#pragma unroll 8
    for (int i = 0; i < 32; ++i) { const int kk = 2 * i + (lane >> 5); scr[kk * 33 + (lane & 31)] = W[(size_t)(k0 + kk) * N + n0 + (lane & 31)]; }
    LDS_WAIT(); asm volatile("" ::: "memory");
    const int c = lane & 7;
#pragma unroll
    for (int j = 0; j < 4; ++j) { const int n = (lane >> 3) + 8 * j; const LAS float* s = scr + (8 * c) * 33 + n;
        v4u o; o.x = pk2(s[0 * 33], s[1 * 33]); o.y = pk2(s[2 * 33], s[3 * 33]); o.z = pk2(s[4 * 33], s[5 * 33]); o.w = pk2(s[6 * 33], s[7 * 33]);
        *(GAS v4u*)(WT + (size_t)(drow + n) * ldk + koff + k0 + 8 * c) = o; }
    LDS_WAIT(); asm volatile("" ::: "memory");
}
constexpr int I_FI = (D / 64) * (2 * DFF / 32), I_FO = (DFF / 64) * (D / 32), I_IN = (D / 64) * (INC / 32), I_DD = (D / 64) * (D / 32), I_HD = (DCA / 64) * (D / 32);
constexpr int I_LAYER = 2 * I_FI + 2 * I_FO + I_IN + 2 * I_DD + 2 * I_HD;

constexpr int R_1I = 0, R_1O = I_FI, R_IN = R_1O + I_FO, R_AO = R_IN + I_IN, R_OUT = R_AO + I_DD + 2 * I_HD, R_2I = R_OUT + I_DD, R_2O = R_2I + I_FI, R_END = R_2O + I_FO;
static_assert(R_END == I_LAYER, "item map");
__device__ __forceinline__ void convert_range(const Args& a, unsigned char* lds, int l, int r_lo, int r_hi, int wi, int nw) {
    const int tid = fresh_tid(), lane = tid & 63, wave = __builtin_amdgcn_readfirstlane(tid >> 6);
    LAS float* scr = (LAS float*)((LAS unsigned char*)lds + wave * 16384);
    unsigned char* wl = a.ws + WS_WT + (size_t)l * WT_LAYER;
    for (int it = r_lo + wi; it < r_hi; it += nw) {
        int r = it;
        if (r < I_FI) { p0_transpose_item(a.in[9] + (size_t)l * D * 2 * DFF, D, 2 * DFF, (bf16*)(wl + WT_1I), 1, scr, r, lane, WK_D, 0); continue; } r -= I_FI;
        if (r < I_FO) { p0_transpose_item(a.in[10] + (size_t)l * DFF * D, DFF, D, (bf16*)(wl + WT_1O), 0, scr, r, lane, WK_FF, 0); continue; } r -= I_FO;
        if (r < I_IN) { p0_transpose_item(a.in[12] + (size_t)l * D * INC, D, INC, (bf16*)(wl + WT_IN), 2, scr, r, lane, WK_D, 0); continue; } r -= I_IN;
        if (r < I_DD) { p0_transpose_item(a.in[14] + (size_t)l * D * D, D, D, (bf16*)(wl + WT_MIXB), 0, scr, r, lane, WK_MIX, 2048); continue; } r -= I_DD;
        if (r < I_HD) { p0_transpose_item(a.in[18] + (size_t)l * DCA * D, DCA, D, (bf16*)(wl + WT_MIXB), 0, scr, r, lane, WK_MIX, 0); continue; } r -= I_HD;
        if (r < I_HD) { p0_transpose_item(a.in[20] + (size_t)l * DCA * D, DCA, D, (bf16*)(wl + WT_MIXB), 0, scr, r, lane, WK_MIX, 1024); continue; } r -= I_HD;
        if (r < I_DD) { p0_transpose_item(a.in[21] + (size_t)l * D * D, D, D, (bf16*)(wl + WT_OUT), 0, scr, r, lane, WK_D, 0); continue; } r -= I_DD;
        if (r < I_FI) { p0_transpose_item(a.in[23] + (size_t)l * D * 2 * DFF, D, 2 * DFF, (bf16*)(wl + WT_2I), 1, scr, r, lane, WK_D, 0); continue; } r -= I_FI;
        p0_transpose_item(a.in[24] + (size_t)l * DFF * D, DFF, D, (bf16*)(wl + WT_2O), 0, scr, r, lane, WK_FF, 0);
    }
}
__device__ __forceinline__ void ada_layer(const Args& a, unsigned char* lds, int l, int bi, int nb, int item_lo = 0, int item_hi = NMOD / 64) {
    const int tid = fresh_tid(), lane = tid & 63, wave = __builtin_amdgcn_readfirstlane(tid >> 6);
    const float* c = a.in[4]; const float* c_ctx = a.in[5]; const float* w_ada = a.in[6]; const float* b_ada = a.in[7];
    float* sv = (float*)lds;
    float* part = (float*)(lds + 24576);
    __syncthreads();
    for (int i = tid; i < D; i += NTHR) { sv[i] = silu_acc(c_ctx[i]); sv[D + i] = silu_acc(c[i]); sv[2 * D + i] = silu_acc(c[D + i]); }
    __syncthreads();
    float* MOD = (float*)(a.ws + WS_MOD);
    for (int item = item_lo + bi; item < item_hi; item += nb) {
        const int j0 = item * 64;
        const float* w = w_ada + ((size_t)l * D + wave * 256) * NMOD + j0 + lane;
        const float* s0 = sv + wave * 256;
        float a0 = 0.f, a1 = 0.f, a2 = 0.f;
#pragma unroll 16
        for (int k = 0; k < 256; ++k) { const float x = w[(size_t)k * NMOD]; a0 += s0[k] * x; a1 += s0[D + k] * x; a2 += s0[2 * D + k] * x; }
        part[(wave * 3 + 0) * 64 + lane] = a0; part[(wave * 3 + 1) * 64 + lane] = a1; part[(wave * 3 + 2) * 64 + lane] = a2;
        __syncthreads();
        if (tid < 192) { const int cc = tid >> 6, j = tid & 63; float s = b_ada[l * NMOD + j0 + j];
#pragma unroll
            for (int wv = 0; wv < 8; ++wv) s += part[(wv * 3 + cc) * 64 + j];
            MOD[(size_t)(l * 3 + cc) * NMOD + j0 + j] = s; }
        __syncthreads();
    }
}
#ifndef FILL_MASK
#define FILL_MASK 0
#endif
__device__ __forceinline__ void filler(const Args& a, unsigned char* lds, int job, int idle, int nidle) {
    const int wave = __builtin_amdgcn_readfirstlane(fresh_tid() >> 6), wi = idle * NWAVES + wave, nw = nidle * NWAVES;
    if (job == 1) convert_range(a, lds, 0, R_IN, R_AO, wi, nw);
    else if (job == 2) convert_range(a, lds, 0, R_AO, R_END, wi, nw);
    else if (job == 3) ada_layer(a, lds, 1, idle, nidle, 0, NMOD / 128);
    else if (job == 7) ada_layer(a, lds, 1, idle, nidle, NMOD / 128, NMOD / 64);
    else if (job == 4) convert_range(a, lds, 1, R_1I, R_IN, wi, nw);
    else if (job == 5) convert_range(a, lds, 1, R_IN, R_AO, wi, nw);
    else if (job == 6) convert_range(a, lds, 1, R_AO, R_END, wi, nw);
}
__device__ __forceinline__ void prologue(const Args& a, unsigned char* lds, int vcu, int G) {
    const int tid = fresh_tid(), wave = __builtin_amdgcn_readfirstlane(tid >> 6);
    unsigned char* ws = a.ws;
    ada_layer(a, lds, 0, vcu, G);
    convert_range(a, lds, 0, R_1I, R_IN, vcu * NWAVES + wave, G * NWAVES);
#pragma unroll
    for (int j = 1; j <= 7; ++j) if (!(((FILL_MASK) >> j) & 1)) filler(a, lds, j, vcu, G);
    {
        const int gt = vcu * NTHR + tid, NT = G * NTHR;
        const int n8 = 2 * 2 * PAST * KVD / 8;
        for (int i = gt; i < 2 * n8; i += NT) { const bool isk = i < n8; const int j = isk ? i : i - n8;
            const f32x4* s = (const f32x4*)((isk ? a.in[2] : a.in[3]) + (size_t)j * 8); const f32x4 x = s[0], y = s[1];
            v4u o; o.x = pk2(x[0], x[1]); o.y = pk2(x[2], x[3]); o.z = pk2(y[0], y[1]); o.w = pk2(y[2], y[3]);
            *(v4u*)(ws + (isk ? WS_CK : WS_CV) + (size_t)j * 16) = o; }
        if (gt < 64 * 32) { const int pos = gt >> 5, i = gt & 31; const float inv = powf(10000.f, -(float)i / 32.f), ang = (float)pos * inv;
            float* rp = (float*)(ws + WS_ROPE) + (size_t)gt * 2; rp[0] = cosf(ang); rp[1] = sinf(ang); }
        const size_t n4c = (size_t)MC * D / 4, n4 = (size_t)M * D / 4;
        const f32x4* xp = (const f32x4*)a.in[0]; const f32x4* xs = (const f32x4*)a.in[1]; f32x4* X = (f32x4*)(ws + WS_X);
        for (size_t i = gt; i < n4; i += NT) X[i] = i < n4c ? xp[i] : xs[i - n4c];
    }
}
template <bool FINAL>
__device__ __forceinline__ void norm_phase(const float* X, const float* g, const float* MODl, int sub, bf16* H, float* out, int vcu, int G, int row_lo, int row_hi) {
    const int tid = fresh_tid(), lane = tid & 63, gw = vcu * NWAVES + __builtin_amdgcn_readfirstlane(tid >> 6), NGW = G * NWAVES;
    for (int m = row_lo + gw; m < row_hi; m += NGW) {
        const f32x4* xr = (const f32x4*)(X + (size_t)m * D) + lane; f32x4 v[8]; float ss = 0.f;
#pragma unroll
        for (int j = 0; j < 8; ++j) { v[j] = xr[64 * j]; ss += (v[j][0] * v[j][0] + v[j][1] * v[j][1]) + (v[j][2] * v[j][2] + v[j][3] * v[j][3]); }
        const float r = rsqrtf(wave_sum(ss) * (1.f / D) + EPS);
        const f32x4* gr = (const f32x4*)g + lane;
        if (FINAL) { f32x4* o = (f32x4*)(out + (size_t)m * D) + lane;
#pragma unroll
            for (int j = 0; j < 8; ++j) o[64 * j] = v[j] * r * gr[64 * j];
        } else {
            const int cond = m < MC ? 0 : (m < MC + SEQL ? 1 : 2);
            const float* mod = MODl + (size_t)cond * NMOD + (size_t)sub * 3 * D;
            const f32x4* sh = (const f32x4*)mod + lane; const f32x4* sc = (const f32x4*)(mod + D) + lane;
            unsigned long long* o8 = (unsigned long long*)(H + (size_t)m * H_LD) + lane;
#pragma unroll
            for (int j = 0; j < 8; ++j) { const f32x4 h = v[j] * r * gr[64 * j] * (sc[64 * j] + 1.f) + sh[64 * j];
                o8[64 * j] = (unsigned long long)pk2(h[0], h[1]) | ((unsigned long long)pk2(h[2], h[3]) << 32); }
        }
    }
}
__device__ __forceinline__ void conv_a_phase(const bf16* GLU, const float* w, const float* bias, const float* g, bf16* CA, int vcu, int G, unsigned char* lds, int u_lo, int u_hi) {
    const int tid = fresh_tid(), wid = tid >> 6, lane = tid & 63;
    float* part = (float*)lds;
    float* rs = (float*)(lds + 16384);
    float wv0[31], wv1[31];
#pragma unroll
    for (int t = 0; t < 31; ++t) { wv0[t] = w[t * DCA + 2 * tid]; wv1[t] = w[t * DCA + 2 * tid + 1]; }
    const float b0 = bias[2 * tid], b1 = bias[2 * tid + 1], g0 = g[2 * tid], g1 = g[2 * tid + 1];
    for (int u = u_lo + vcu; u < u_hi; u += G) {
        const int row0 = u * 16, s0 = row0 < MC ? (row0 & ~(SEQC - 1)) : MC + ((row0 - MC) & ~(SEQL - 1)), L = row0 < MC ? SEQC : SEQL;
#pragma unroll 1
        for (int grp = 0; grp < 2; ++grp) {
            const int p0 = row0 - s0 + 8 * grp;
            float x0[38], x1[38];
#pragma unroll
            for (int q = 0; q < 38; ++q) { const int p = p0 - 15 + q; unsigned xw = 0u; if (p >= 0 && p < L) xw = *(const unsigned*)(GLU + (size_t)(s0 + p) * DCA + 2 * tid); x0[q] = bflo(xw); x1[q] = bfhi(xw); }
            float a0[8], a1[8];
#pragma unroll
            for (int r = 0; r < 8; ++r) { float s_0 = b0, s_1 = b1;
#pragma unroll
                for (int t = 0; t < 31; ++t) { s_0 += x0[r + t] * wv0[t]; s_1 += x1[r + t] * wv1[t]; }
                a0[r] = s_0; a1[r] = s_1; part[r * 512 + tid] = s_0 * s_0 + s_1 * s_1; }
            __syncthreads();
            { float v = 0.f;
#pragma unroll
              for (int k = 0; k < 8; ++k) v += part[wid * 512 + lane + 64 * k];
              v = wave_sum(v); if (lane == 0) rs[wid] = rsqrtf(v * (1.f / DCA) + EPS); }
            __syncthreads();
#pragma unroll
            for (int r = 0; r < 8; ++r) { const float rr = rs[r];
                *(unsigned*)(CA + (size_t)(row0 + 8 * grp + r) * ABR_LD + 2 * tid) = pk2(silu_acc(a0[r] * rr * g0), silu_acc(a1[r] * rr * g1)); }
        }
    }
    __syncthreads();
}
__device__ __forceinline__ void conv_b_phase(const bf16* BG, const bf16* CX, const float* w, bf16* CB, int vcu, int G, int row_lo, int row_hi) {
    const int gt = vcu * NTHR + fresh_tid(), NT = G * NTHR;
    for (int idx = row_lo * (DCA / 8) + gt; idx < row_hi * (DCA / 8); idx += NT) {
        const int m = idx >> 7, c8 = (idx & 127) * 8;
        const int s0 = m < MC ? (m & ~(SEQC - 1)) : MC + ((m - MC) & ~(SEQL - 1)), L = m < MC ? SEQC : SEQL, pos = m - s0;
        f32x4 aa = {0.f, 0.f, 0.f, 0.f}, ab = {0.f, 0.f, 0.f, 0.f};
#pragma unroll
        for (int t = 0; t < 3; ++t) { const int p = pos + t - 1;
            if (p >= 0 && p < L) { const v4u xw = *(const v4u*)(CX + (size_t)(s0 + p) * DCA + c8); const f32x4 wa = *(const f32x4*)(w + t * DCA + c8), wb = *(const f32x4*)(w + t * DCA + c8 + 4);
                aa[0] += bflo(xw.x) * wa[0]; aa[1] += bfhi(xw.x) * wa[1]; aa[2] += bflo(xw.y) * wa[2]; aa[3] += bfhi(xw.y) * wa[3];
                ab[0] += bflo(xw.z) * wb[0]; ab[1] += bfhi(xw.z) * wb[1]; ab[2] += bflo(xw.w) * wb[2]; ab[3] += bfhi(xw.w) * wb[3]; } }
        const v4u bw = *(const v4u*)(BG + (size_t)m * DCA + c8);
        v4u o; o.x = pk2(bflo(bw.x) * aa[0], bfhi(bw.x) * aa[1]); o.y = pk2(bflo(bw.y) * aa[2], bfhi(bw.y) * aa[3]); o.z = pk2(bflo(bw.z) * ab[0], bfhi(bw.z) * ab[1]); o.w = pk2(bflo(bw.w) * ab[2], bfhi(bw.w) * ab[3]);
        *(v4u*)(CB + (size_t)m * ABR_LD + c8) = o;
    }
}
__device__ __forceinline__ void attn_lat_phase(const bf16* Qb, const bf16* Kb, const bf16* Vb, const bf16* CK, const bf16* CV, const float* sink, bf16* ATT, int layer, int vcu, int G, unsigned char* lds) {
    for (int u = vcu; u < 512; u += G) {
        const int b = u >> 8, kvh = (u >> 6) & 3, tb = u & 63;
        const int lo = tb < 2 ? -tb : -2, hi = tb > 61 ? 63 - tb : 2, NT = 8 + (hi - lo + 1);
        const size_t seq0 = (size_t)MC + (size_t)b * SEQL, q0 = seq0 + 64 * tb, c0 = (size_t)(b * 2 + layer) * PAST;
        att::attn_unit(Qb + q0 * D + kvh * 512, CK + c0 * KVD + kvh * 128, CV + c0 * KVD + kvh * 128,
                       Kb + (seq0 + 64 * (tb + lo)) * KVD + kvh * 128, Vb + (seq0 + 64 * (tb + lo)) * KVD + kvh * 128,
                       8, NT, lo == -2 ? 8 : -1, hi == 2 ? NT - 1 : -1, sink + kvh * 4, ATT + q0 * ABR_LD + kvh * 512, ABR_LD, (char*)lds);
    }
}
__device__ __forceinline__ void attn_ctx_phase(const bf16* Qb, const bf16* Kb, const bf16* Vb, const float* sink, bf16* ATT, int vcu, int G, unsigned char* lds) {
    for (int u = vcu; u < 256; u += G) {
        const int b = u >> 4, kvh = (u >> 2) & 3, qb = u & 3;
        const size_t seq0 = (size_t)b * SEQC, q0 = seq0 + 64 * qb;
        att::attn_unit(Qb + q0 * D + kvh * 512, Kb, Vb, Kb + seq0 * KVD + kvh * 128, Vb + seq0 * KVD + kvh * 128, 0, 4, -1, -1, sink + kvh * 4, ATT + q0 * ABR_LD + kvh * 512, ABR_LD, (char*)lds);
    }
}

#define P_MOD   ((float*)(ws + WS_MOD))
#define P_CK    ((bf16*)(ws + WS_CK))
#define P_CV    ((bf16*)(ws + WS_CV))
#define P_X     ((float*)(ws + WS_X))
#define P_H     ((bf16*)(ws + WS_H))
#define P_ACT   ((bf16*)(ws + WS_ACT))
#define P_Q     ((bf16*)(ws + WS_Q))
#define P_K     ((bf16*)(ws + WS_K))
#define P_V     ((bf16*)(ws + WS_V))
#define P_GLU   ((bf16*)(ws + WS_GLU))
#define P_BG    ((bf16*)(ws + WS_BG))
#define P_CX    ((bf16*)(ws + WS_CX))
#define P_GATES ((bf16*)(ws + WS_GATES))
#define P_ABR   ((bf16*)(ws + WS_ABR))
#define P_ATT   (P_ABR + ABR_ATT)
#define P_CA    (P_ABR + ABR_CA)
#define P_CB    (P_ABR + ABR_CB)
#define P_MIX   ((bf16*)(ws + WS_MIX))
#define P_MODL  (P_MOD + (size_t)l * 3 * NMOD)
#define P_WL(off) ((const bf16*)(ws + WS_WT + (size_t)l * WT_LAYER + (off)))
__global__ void __launch_bounds__(NTHR, 2) fwd(Args args) {
    extern __shared__ __attribute__((aligned(16))) unsigned char lds[];
    const int tid = threadIdx.x;
    const int G0 = gridDim.x, bx = blockIdx.x, vcu0 = (G0 % 8 == 0) ? (bx % 8) * (G0 / 8) + bx / 8 : bx;
    LAS unsigned char* ldsl = (LAS unsigned char*)lds;
    volatile LAS unsigned* MISC = (volatile LAS unsigned*)(ldsl + MISC_OFF);
    for (int u = tid; u < (LDS_BYTES - LDSCTL_OFF) / 4; u += NTHR) ((LAS unsigned*)(ldsl + LDSCTL_OFF))[u] = 0u;
    __syncthreads();
    unsigned* barw = (unsigned*)(args.ws + WS_CTL) + CW_BAR;
    XcdBarrier bar; bar.bar = barw; bar.x = 0; bar.st = nullptr;
    if (!MK_PER_PHASE) bar = xcd_barrier_post(barw, MISC + 8);
#if MK_PER_PHASE
    const int lo = args.ph_lo, hi = args.ph_hi;
#define IN(k) (lo <= (k) && (k) < hi)
#else
#define IN(k) true
#endif
#ifndef DUP_PHASE
#define DUP_PHASE (-1)
#endif
#define PH_BEGIN const Args* A_ = fresh_args(); unsigned char* ws = A_->ws; (void)ws; const int vcu = fresh_i(vcu0), G = fresh_i(G0); (void)vcu; (void)G
#define FILL_JOB(j) ((l == 0 && (((FILL_MASK) >> (j)) & 1)) ? (j) : 0)
#define RUN_GEMM(EpiT, Eobj, Aptr, Bptr, N_, K_, LDA_, LDB_, kind_, job_) do { pg8::Gemm g{Aptr, Bptr, M, N_, K_}; typedef pg8::TailOrder<M, N_, K_, (((HT_MASK) >> (kind_)) & 1) != 0> SO_; SO_ S; S.init(fresh_i(G), fresh_i(bx)); \
        pg8::gemm_phase_ht<EpiT, SO_, K_, LDA_, LDB_>(ldsl + RING_OFF, g, S, Eobj); \
        { const int job__ = (job_); if (job__ > 0) { constexpr int nwg__ = (M / 256) * ((N_) / 256); const int G__ = fresh_i(G), bx__ = fresh_i(bx), Rem__ = nwg__ - (nwg__ / G__) * G__; \
            if (bx__ >= Rem__) filler(*fresh_args(), lds, job__, bx__ - Rem__, G__ - Rem__); } } } while (0)
#ifdef XTRA_BAR
#define XTRA_BAR_STMT xcd_barrier(bb_);
#else
#define XTRA_BAR_STMT
#endif
#ifndef HT_MASK
#define HT_MASK 0
#endif
#define REP(k) for (int rep_ = 0; rep_ < ((DUP_PHASE == (k)) ? 2 : 1); ++rep_)
#define SEAM(k) do { if (!MK_PER_PHASE && IN(k) && IN((k) + 1)) { XcdBarrier bb_ = bar; bb_.x = (unsigned)fresh_i((int)bar.x); bb_.bar = (unsigned*)(fresh_args()->ws + WS_CTL) + CW_BAR; xcd_barrier(bb_); XTRA_BAR_STMT } } while (0)

#define RUN_GEMM_D(EpiT, Eobj, Aptr, Bptr, N_, K_, LDA_, LDB_, PM0_, NML_, R_, KA_, KB_) do { pg8::Gemm g{Aptr, Bptr, M, N_, K_}; typedef pg8::DealOrder<N_, PM0_, NML_, R_, KA_, KB_> SO_; SO_ S; S.init(fresh_i(G), fresh_i(bx)); \
        pg8::gemm_phase_ht<EpiT, SO_, K_, LDA_, LDB_>(ldsl + RING_OFF, g, S, Eobj); } while (0)
#define NORM_C(sub_, gin_, lc) { PH_BEGIN; norm_phase<false>(P_X, A_->in[gin_] + (lc) * D, P_MOD + (size_t)(lc) * 3 * NMOD, sub_, P_H, nullptr, vcu, G, 0, MC); }
#define NORM_L(sub_, gin_, ll) { PH_BEGIN; norm_phase<false>(P_X, A_->in[gin_] + (ll) * D, P_MOD + (size_t)(ll) * 3 * NMOD, sub_, P_H, nullptr, vcu, G, MC, M); }
#define WLY(lx, off) ((const bf16*)(ws + WS_WT + (size_t)(lx) * WT_LAYER + (off)))
#define MODLY(lx) (P_MOD + (size_t)(lx) * 3 * NMOD)
    if (IN(0)) REP(0) { prologue(*fresh_args(), lds, vcu0, G0); } SEAM(0);
    if (IN(1)) NORM_C(0, 8, 0)
    SEAM(1);
    for (int l = 0; l < 2; ++l) {
        const int pb = 2 + 12 * l;
        if (IN(pb + 0)) { NORM_L(0, 8, l)
            { PH_BEGIN; pg8::EpiSwiglu E{P_ACT, ACT_LD}; RUN_GEMM_D(pg8::EpiSwiglu, E, P_H, WLY(l, WT_1I), 2 * DFF, D, H_LD, WK_D, 0, 16, 24, 3, 2); } }
        SEAM(pb + 0);
        if (IN(pb + 1)) {
            { PH_BEGIN; pg8::EpiResid E{P_X, MODLY(l) + 2 * D, 0.5f}; RUN_GEMM_D(pg8::EpiResid, E, P_ACT, WLY(l, WT_1O), D, DFF, ACT_LD, WK_FF, 0, 16, 16, 1, 0); }
            { PH_BEGIN; pg8::EpiSwiglu E{P_ACT, ACT_LD}; RUN_GEMM_D(pg8::EpiSwiglu, E, P_H, WLY(l, WT_1I), 2 * DFF, D, H_LD, WK_D, 16, 32, 16, 4, 7); } }
        SEAM(pb + 1);
        if (IN(pb + 2)) { NORM_C(1, 11, l)
            { PH_BEGIN; pg8::EpiResid E{P_X, MODLY(l) + 2 * D, 0.5f}; RUN_GEMM_D(pg8::EpiResid, E, P_ACT, WLY(l, WT_1O), D, DFF, ACT_LD, WK_FF, 16, 32, 16, 1, 1); } }
        SEAM(pb + 2);
        if (IN(pb + 3)) { NORM_L(1, 11, l)
            { PH_BEGIN; pg8::EpiWin E{ws, A_->out, l}; RUN_GEMM_D(pg8::EpiWin, E, P_H, WLY(l, WT_IN), INC, D, H_LD, WK_D, 0, 16, 16, 4, 3); } }
        SEAM(pb + 3);
        if (IN(pb + 4)) {
            { PH_BEGIN; attn_ctx_phase(P_Q, P_K, P_V, A_->in[13] + l * 16, P_ATT, vcu, G, lds); }
            { PH_BEGIN; conv_a_phase(P_GLU, A_->in[15] + (size_t)l * 31 * DCA, A_->in[16] + l * DCA, A_->in[17] + l * DCA, P_CA, vcu, G, lds, 0, MC / 16); }
            { PH_BEGIN; conv_b_phase(P_BG, P_CX, A_->in[19] + (size_t)l * 3 * DCA, P_CB, vcu, G, 0, MC); } }
        SEAM(pb + 4);
        if (IN(pb + 5)) {
            { PH_BEGIN; pg8::EpiMixK E{P_MIX, P_GATES}; RUN_GEMM_D(pg8::EpiMixK, E, P_ABR, WLY(l, WT_MIXB), D, ABR_K, ABR_LD, WK_MIX, 0, 16, 16, 1, 0); }
            { PH_BEGIN; pg8::EpiWin E{ws, A_->out, l}; RUN_GEMM_D(pg8::EpiWin, E, P_H, WLY(l, WT_IN), INC, D, H_LD, WK_D, 16, 32, 16, 6, 8); } }
        SEAM(pb + 5);
        if (IN(pb + 6)) {
            { PH_BEGIN; pg8::EpiResid E{P_X, MODLY(l) + 5 * D, 1.0f}; RUN_GEMM_D(pg8::EpiResid, E, P_MIX, WLY(l, WT_OUT), D, D, MIX_LD, WK_D, 0, 16, 16, 1, 0); }
            { PH_BEGIN; attn_lat_phase(P_Q, P_K, P_V, P_CK, P_CV, A_->in[13] + l * 16, P_ATT, l, vcu, G, lds); }
            { PH_BEGIN; conv_a_phase(P_GLU, A_->in[15] + (size_t)l * 31 * DCA, A_->in[16] + l * DCA, A_->in[17] + l * DCA, P_CA, vcu, G, lds, MC / 16, M / 16); }
            { PH_BEGIN; conv_b_phase(P_BG, P_CX, A_->in[19] + (size_t)l * 3 * DCA, P_CB, vcu, G, MC, M); } }
        SEAM(pb + 6);
        if (IN(pb + 7)) { PH_BEGIN; pg8::EpiMixK E{P_MIX, P_GATES}; RUN_GEMM_D(pg8::EpiMixK, E, P_ABR, WLY(l, WT_MIXB), D, ABR_K, ABR_LD, WK_MIX, 16, 32, 16, 1, 1); }
        SEAM(pb + 7);
        if (IN(pb + 8)) { NORM_C(2, 22, l)
            { PH_BEGIN; pg8::EpiResid E{P_X, MODLY(l) + 5 * D, 1.0f}; RUN_GEMM_D(pg8::EpiResid, E, P_MIX, WLY(l, WT_OUT), D, D, MIX_LD, WK_D, 16, 32, 16, 1, 1); } }
        SEAM(pb + 8);
        if (IN(pb + 9)) { NORM_L(2, 22, l)
            { PH_BEGIN; pg8::EpiSwiglu E{P_ACT, ACT_LD}; RUN_GEMM_D(pg8::EpiSwiglu, E, P_H, WLY(l, WT_2I), 2 * DFF, D, H_LD, WK_D, 0, 16, 24, 3, 2); } }
        SEAM(pb + 9);
        if (IN(pb + 10)) {
            { PH_BEGIN; pg8::EpiResid E{P_X, MODLY(l) + 8 * D, 0.5f}; RUN_GEMM_D(pg8::EpiResid, E, P_ACT, WLY(l, WT_2O), D, DFF, ACT_LD, WK_FF, 0, 16, 16, 1, 0); }
            { PH_BEGIN; pg8::EpiSwiglu E{P_ACT, ACT_LD}; RUN_GEMM_D(pg8::EpiSwiglu, E, P_H, WLY(l, WT_2I), 2 * DFF, D, H_LD, WK_D, 16, 32, 16, 4, 7); } }
        SEAM(pb + 10);
        if (IN(pb + 11)) {
            if (l == 0) NORM_C(0, 8, 1)
            else { PH_BEGIN; norm_phase<true>(P_X, A_->in[25], nullptr, 0, nullptr, A_->out, vcu, G, 0, MC); }
            { PH_BEGIN; pg8::EpiResid E{P_X, MODLY(l) + 8 * D, 0.5f}; RUN_GEMM_D(pg8::EpiResid, E, P_ACT, WLY(l, WT_2O), D, DFF, ACT_LD, WK_FF, 16, 32, 16, 1, 1); } }
        SEAM(pb + 11);
    }
    if (IN(26)) { PH_BEGIN; norm_phase<true>(P_X, A_->in[25], nullptr, 0, nullptr, A_->out, vcu, G, MC, M); }
#undef IN
#undef SEAM
}

extern "C" void kernel_launch(void* const* d_in, const int* in_sizes, int n_in, void* d_out, int out_size, void* d_ws, size_t ws_size, hipStream_t stream) {
    static int grid = 0;
    if (grid == 0) {
        if (n_in != 26 || ws_size < WS_END) { fprintf(stderr, "kernel_launch: built for 26 inputs and >= %zu bytes of workspace; got n_in %d, ws %zu; nothing launched\n", (size_t)WS_END, n_in, ws_size); grid = -1; return; }
        int dev = 0, cus = 0, per_cu = 0;
        if (hipGetDevice(&dev) != hipSuccess || hipDeviceGetAttribute(&cus, hipDeviceAttributeMultiprocessorCount, dev) != hipSuccess) { fprintf(stderr, "kernel_launch: device query failed\n"); grid = -1; return; }
        if (hipFuncSetAttribute((const void*)fwd, hipFuncAttributeMaxDynamicSharedMemorySize, LDS_BYTES) != hipSuccess) { fprintf(stderr, "kernel_launch: hipFuncSetAttribute failed\n"); grid = -1; return; }
        if (hipOccupancyMaxActiveBlocksPerMultiprocessor(&per_cu, (const void*)fwd, NTHR, LDS_BYTES) != hipSuccess || per_cu < 1)
            fprintf(stderr, "kernel_launch: note: occupancy query reports %d workgroups per CU\n", per_cu);
        (void)hipGetLastError();
        grid = cus;
    }
    if (grid < 0) return;
    if (hipMemsetAsync((char*)d_ws + WS_CTL, 0, CTL_ZERO_BYTES, stream) != hipSuccess) { fprintf(stderr, "kernel_launch: hipMemsetAsync failed\n"); return; }
    Args a{};
    for (int i = 0; i < 26; ++i) a.in[i] = (const float*)d_in[i];
    a.out = (float*)d_out; a.ws = (unsigned char*)d_ws;
#if MK_PER_PHASE
    for (int p = 0; p < N_PHASES; ++p) { a.ph_lo = p; a.ph_hi = p + 1; hipLaunchKernelGGL(fwd, dim3(grid), dim3(NTHR), LDS_BYTES, stream, a); }
#else
    a.ph_lo = 0; a.ph_hi = N_PHASES; hipLaunchKernelGGL(fwd, dim3(grid), dim3(NTHR), LDS_BYTES, stream, a);
#endif
    const hipError_t le = hipPeekAtLastError();
    if (le != hipSuccess) fprintf(stderr, "kernel_launch: launch failed: %s\n", hipGetErrorName(le));
}
```

```cpp
#include <hip/hip_runtime.h>
#include <cstdio>
#include <cstdint>

#ifndef MK_PER_PHASE
#define MK_PER_PHASE 0
#endif
constexpr int D = 2048, MC = 4096, ML = 8192, M = MC + ML, DFF = 5632, NMOD = 9 * D, INC = 14336;
constexpr int SEQC = 256, SEQL = 4096, PAST = 512, KVD = 512, DCA = 1024;
constexpr float EPS = 1e-6f;
constexpr size_t MiB = 1u << 20;
#ifndef ROW_PAD
#define ROW_PAD 64
#endif
constexpr int PADE = ROW_PAD;
constexpr int H_LD = D + PADE, ACT_LD = DFF + PADE, MIX_LD = D + PADE, ABR_K = 4096, ABR_LD = ABR_K + PADE, ABR_CA = 0, ABR_CB = 1024, ABR_ATT = 2048;
constexpr int WK_D = D + PADE, WK_FF = DFF + PADE, WK_MIX = ABR_K + PADE;
constexpr size_t WS_CTL = 0, CTL_ZERO_BYTES = 1 * MiB;
constexpr size_t WS_MOD = 1 * MiB, WS_ROPE = 2 * MiB, WS_CK = 3 * MiB, WS_CV = 5 * MiB, WS_X = 8 * MiB, WS_H = 104 * MiB;
constexpr size_t WS_ACT = 154 * MiB;
constexpr size_t WS_Q = 154 * MiB, WS_K = 202 * MiB, WS_V = 214 * MiB, WS_GLU = 226 * MiB, WS_BG = 250 * MiB, WS_CX = 274 * MiB, WS_GATES = 298 * MiB;
constexpr size_t WS_ABR = 442 * MiB, WS_MIX = 540 * MiB;
constexpr size_t WS_WT = 590 * MiB, WT_LAYER = 222 * MiB;
constexpr size_t WT_1I = 0, WT_1O = 46 * MiB, WT_IN = 69 * MiB, WT_MIXB = 127 * MiB  , WT_OUT = 144 * MiB, WT_2I = 153 * MiB, WT_2O = 199 * MiB;
constexpr size_t WS_END = WS_WT + 2 * WT_LAYER;
static_assert((size_t)M * H_LD * 2 <= 50 * MiB && (size_t)M * ACT_LD * 2 <= 134 * MiB && (size_t)M * ABR_LD * 2 <= 98 * MiB && (size_t)M * MIX_LD * 2 <= 50 * MiB, "activation map");
static_assert((size_t)2 * DFF * WK_D * 2 <= 46 * MiB && (size_t)D * WK_FF * 2 <= 23 * MiB && (size_t)INC * WK_D * 2 <= 58 * MiB && (size_t)D * WK_MIX * 2 <= 17 * MiB && (size_t)D * WK_D * 2 <= 9 * MiB, "weight map");
constexpr int CW_BAR = 4096;

__device__ __forceinline__ int fresh_tid() { int t = threadIdx.x; asm volatile("" : "+v"(t)); return t; }

__device__ __forceinline__ int fresh_i(int v) { asm volatile("" : "+s"(v)); return v; }
struct Args { const float* in[26]; float* out; unsigned char* ws; int ph_lo, ph_hi; };
__device__ __forceinline__ const Args* fresh_args() { auto p = __builtin_amdgcn_kernarg_segment_ptr(); asm volatile("" : "+s"(p)); return (const Args*)p; }

namespace pg8 {
#define PG8_LAS __attribute__((address_space(3)))
typedef unsigned short bf16_t;
typedef short bf16x8 __attribute__((ext_vector_type(8)));
typedef float f32x4 __attribute__((ext_vector_type(4)));
typedef unsigned u32x4 __attribute__((ext_vector_type(4)));
constexpr int BM = 256, BK = 64, HALF = 128, HTB = HALF * BK * 2  , STAGE_BYTES = 8 * HTB, NXCD = 8, WGM = 8;

__host__ __device__ __forceinline__ int lds_byte(int r, int c) { const int st = (r >> 4) * 2 + (c >> 5), rr = r & 15, cc = c & 31, ob = rr * 64 + cc * 2; return st * 1024 + (ob ^ (((ob >> 9) & 1) << 5)); }
__host__ __device__ __forceinline__ void stage_rc(int b, int& R, int& C) { const int st = b / 1024, sb = b % 1024, swz = sb ^ (((sb >> 9) & 1) << 5); R = (st >> 1) * 16 + swz / 64; C = (st & 1) * 32 + (swz % 64) / 2; }
__host__ __device__ __forceinline__ int perm32(int rho) { const int n = rho >> 4, i = rho & 15; return 8 * (i >> 2) + 4 * n + (i & 3); }

struct Unit { int pm, pn; };
struct Gemm { const bf16_t* A; const bf16_t* Bt; int M, N, K; };

struct StaticOrder {
    int nM, nN, nwg, G, c;
    __host__ __device__ void init(int M, int N, int G_, int c_) { nM = M / BM; nN = N / BM; nwg = nM * nN; G = G_; c = c_; }
    __host__ __device__ bool next(int i, Unit& u) const {
        const long L = (long)i * G + c; if (L >= nwg) return false;
        int wgid = (int)L; { const int q = nwg / NXCD, r = nwg % NXCD, xcd = wgid % NXCD, off = wgid / NXCD; wgid = (xcd < r ? xcd * (q + 1) : r * (q + 1) + (xcd - r) * q) + off; }
        const int nig = WGM * nN, gid = wgid / nig, fm = gid * WGM, gsz = (nM - fm) < WGM ? (nM - fm) : WGM;
        u.pm = fm + ((wgid % nig) % gsz); u.pn = (wgid % nig) / gsz; return true;
    }
    __device__ __forceinline__ void a_ready(const Unit&) const {}
    __device__ __forceinline__ void done(const Unit&) const {}
};

__device__ __forceinline__ unsigned cvt_pk_bf16(float lo, float hi) { unsigned r; asm volatile("v_cvt_pk_bf16_f32 %0, %1, %2" : "=v"(r) : "v"(lo), "v"(hi)); return r; }
typedef float f32x2 __attribute__((ext_vector_type(2)));
__device__ __forceinline__ f32x2 gelu_pk(f32x2 v) {
    const f32x2 av = __builtin_elementwise_abs(v), d = av * 0.2316418882f + 1.0f;
    f32x2 t; t.x = __builtin_amdgcn_rcpf(d.x); t.y = __builtin_amdgcn_rcpf(d.y);
    f32x2 q = t * 0.5307027145f + (-0.7265760135f); q = q * t + 0.7107068705f; q = q * t + (-0.142248368f); q = q * t + 0.127414796f; q = q * t;
    const f32x2 s = (v * v) * (-0.72134752044f);
    f32x2 e; e.x = __builtin_amdgcn_exp2f(s.x); e.y = __builtin_amdgcn_exp2f(s.y);
    const f32x2 m = v * (q * e), r = v - m;
    f32x2 o; o.x = v.x < 0.f ? m.x : r.x; o.y = v.y < 0.f ? m.y : r.y; return o;
}

struct UnitK : Unit { int half, rofs; };
__device__ __forceinline__ float fsigm(float x) { return __builtin_amdgcn_rcpf(1.f + __builtin_amdgcn_exp2f(-1.4426950408889634f * x)); }
__device__ __forceinline__ float fsilu(float x) { return x * fsigm(x); }
__device__ __forceinline__ u32x4 pack8(f32x4 a, f32x4 b) { u32x4 w; w.x = cvt_pk_bf16(a[0], a[1]); w.y = cvt_pk_bf16(a[2], a[3]); w.z = cvt_pk_bf16(b[0], b[1]); w.w = cvt_pk_bf16(b[2], b[3]); return w; }
__device__ __forceinline__ void unpack8(u32x4 w, f32x4& a, f32x4& b) {
    a[0] = __builtin_bit_cast(float, w.x << 16); a[1] = __builtin_bit_cast(float, w.x & 0xffff0000u); a[2] = __builtin_bit_cast(float, w.y << 16); a[3] = __builtin_bit_cast(float, w.y & 0xffff0000u);
    b[0] = __builtin_bit_cast(float, w.z << 16); b[1] = __builtin_bit_cast(float, w.z & 0xffff0000u); b[2] = __builtin_bit_cast(float, w.w << 16); b[3] = __builtin_bit_cast(float, w.w & 0xffff0000u);
}
enum { PO_SWIGLU = 0, PO_GLU = 1, PO_MUL = 2 };
template <int OP> __device__ __forceinline__ f32x4 pair_op(f32x4 a, f32x4 b) {
    f32x4 o;
#pragma unroll
    for (int e = 0; e < 4; ++e) o[e] = OP == PO_SWIGLU ? fsilu(a[e]) * b[e] : (OP == PO_GLU ? a[e] * fsigm(b[e]) : a[e] * b[e]);
    return o;
}
struct EpiSwiglu {
    static constexpr bool PERM = true, AFTER_DRAIN = false, RESCALE = false;
    bf16_t* O; int ldc;
    __device__ __forceinline__ void operator()(const f32x4 (&acc)[2][2][4][2], const UnitK& u, int wr, int wc, int fr, int fq) const {
        const int row0 = u.pm * BM + u.rofs + wr * 64 + fr, col0 = u.pn * HALF + wc * 32 + 8 * fq;
#pragma unroll
        for (int ai = 0; ai < 2; ++ai) { if (ai == 1 && u.half) break;
#pragma unroll
            for (int m = 0; m < 4; ++m) {
                bf16_t* rowp = O + (size_t)(row0 + ai * HALF + m * 16) * ldc + col0;
                *(u32x4*)rowp = pack8(pair_op<PO_SWIGLU>(acc[ai][0][m][0], acc[ai][1][m][0]), pair_op<PO_SWIGLU>(acc[ai][0][m][1], acc[ai][1][m][1]));
            } }
    }
};
struct EpiResid {
    static constexpr bool PERM = true, AFTER_DRAIN = false, RESCALE = false;
    float* X; const float* gate; float coef;
    __device__ __forceinline__ void operator()(const f32x4 (&acc)[2][2][4][2], const UnitK& u, int wr, int wc, int fr, int fq) const {
        const int row0 = u.pm * BM + u.rofs + wr * 64 + fr, col0 = u.pn * BM + wc * 32 + 8 * fq;
        const int cond = u.pm < 16 ? 0 : (u.pm < 32 ? 1 : 2);
        const float* gp = gate + (size_t)cond * NMOD + col0;
        f32x4 g[2][2];
#pragma unroll
        for (int bj = 0; bj < 2; ++bj)
#pragma unroll
            for (int n = 0; n < 2; ++n) g[bj][n] = *(const f32x4*)(gp + bj * HALF + 4 * n) * coef;
#pragma unroll
        for (int ai = 0; ai < 2; ++ai) { if (ai == 1 && u.half) break;
#pragma unroll
            for (int m = 0; m < 4; ++m) {
                float* rowp = X + (size_t)(row0 + ai * HALF + m * 16) * D + col0;
#pragma unroll
                for (int bj = 0; bj < 2; ++bj)
#pragma unroll
                    for (int n = 0; n < 2; ++n) { f32x4* p = (f32x4*)(rowp + bj * HALF + 4 * n); *p = *p + g[bj][n] * acc[ai][bj][m][n]; }
            } }
    }
};
struct EpiWin {
    static constexpr bool PERM = true, AFTER_DRAIN = false, RESCALE = false;
    unsigned char* ws; float* out; int layer;
    __device__ __forceinline__ void operator()(const f32x4 (&acc)[2][2][4][2], const UnitK& u, int wr, int wc, int fr, int fq) const {
        bf16_t* const Qb = (bf16_t*)(ws + WS_Q); bf16_t* const Kb = (bf16_t*)(ws + WS_K); bf16_t* const Vb = (bf16_t*)(ws + WS_V); bf16_t* const GLU = (bf16_t*)(ws + WS_GLU); bf16_t* const BG = (bf16_t*)(ws + WS_BG);
        bf16_t* const CX = (bf16_t*)(ws + WS_CX); bf16_t* const GATES = (bf16_t*)(ws + WS_GATES); const float* const rope = (const float*)(ws + WS_ROPE);
        float* const nk = out + (size_t)M * D; float* const nv = nk + (size_t)16 * 2 * SEQC * KVD;
        const int pn = u.pn, row0 = u.pm * BM + u.rofs + wr * 64 + fr, cw = wc * 32 + 8 * fq;
        const bool latent = u.pm >= 16;
        if (pn < 10) {
            const bool isq = pn < 8; const int hp = isq ? pn : pn - 8;
            const int ocol = (2 * hp + (wc >> 1)) * 128 + 64 * (wc & 1) + 8 * fq;
            bf16_t* base = isq ? Qb : Kb; const int ld = isq ? D : KVD;
#pragma unroll
            for (int ai = 0; ai < 2; ++ai) { if (ai == 1 && u.half) break;
#pragma unroll
                for (int m = 0; m < 4; ++m) {
                    const int row = row0 + ai * HALF + m * 16;
                    const f32x4 x1a = acc[ai][0][m][0], x1b = acc[ai][0][m][1], x2a = acc[ai][1][m][0], x2b = acc[ai][1][m][1];
                    f32x4 o1a = x1a, o1b = x1b, o2a = x2a, o2b = x2b;
                    if (latent) {
                        const int t = (row - MC) & (SEQL - 1), pos = (wc & 1) ? (t & 63) : (t >> 6);
                        const f32x4* rp = (const f32x4*)(rope + ((size_t)pos * 32 + 8 * fq) * 2);
                        const f32x4 r0 = rp[0], r1 = rp[1], r2 = rp[2], r3 = rp[3];
                        o1a[0] = x1a[0] * r0[0] - x2a[0] * r0[1]; o2a[0] = x2a[0] * r0[0] + x1a[0] * r0[1];
                        o1a[1] = x1a[1] * r0[2] - x2a[1] * r0[3]; o2a[1] = x2a[1] * r0[2] + x1a[1] * r0[3];
                        o1a[2] = x1a[2] * r1[0] - x2a[2] * r1[1]; o2a[2] = x2a[2] * r1[0] + x1a[2] * r1[1];
                        o1a[3] = x1a[3] * r1[2] - x2a[3] * r1[3]; o2a[3] = x2a[3] * r1[2] + x1a[3] * r1[3];
                        o1b[0] = x1b[0] * r2[0] - x2b[0] * r2[1]; o2b[0] = x2b[0] * r2[0] + x1b[0] * r2[1];
                        o1b[1] = x1b[1] * r2[2] - x2b[1] * r2[3]; o2b[1] = x2b[1] * r2[2] + x1b[1] * r2[3];
                        o1b[2] = x1b[2] * r3[0] - x2b[2] * r3[1]; o2b[2] = x2b[2] * r3[0] + x1b[2] * r3[1];
                        o1b[3] = x1b[3] * r3[2] - x2b[3] * r3[3]; o2b[3] = x2b[3] * r3[2] + x1b[3] * r3[3];
                    }
                    bf16_t* op = base + (size_t)row * ld + ocol;
                    *(u32x4*)op = pack8(o1a, o1b); *(u32x4*)(op + 32) = pack8(o2a, o2b);
                    if (!isq && !latent) { float* p = nk + ((size_t)((row >> 8) * 2 + layer) * SEQC + (row & 255)) * KVD + ocol;
                        *(f32x4*)p = x1a; *(f32x4*)(p + 4) = x1b; *(f32x4*)(p + 32) = x2a; *(f32x4*)(p + 36) = x2b; }
                } }
        } else if (pn < 12) {
#pragma unroll
            for (int ai = 0; ai < 2; ++ai) { if (ai == 1 && u.half) break;
#pragma unroll
                for (int m = 0; m < 4; ++m) {
                    const int row = row0 + ai * HALF + m * 16;
#pragma unroll
                    for (int bj = 0; bj < 2; ++bj) { const int col = (pn - 10) * BM + bj * HALF + cw;
                        *(u32x4*)(Vb + (size_t)row * KVD + col) = pack8(acc[ai][bj][m][0], acc[ai][bj][m][1]);
                        if (!latent) { float* p = nv + ((size_t)((row >> 8) * 2 + layer) * SEQC + (row & 255)) * KVD + col; *(f32x4*)p = acc[ai][bj][m][0]; *(f32x4*)(p + 4) = acc[ai][bj][m][1]; } }
                } }
        } else if (pn < 20 || (pn >= 24 && pn < 32)) {
            const bool glu = pn < 20; bf16_t* base = glu ? GLU : CX; const int col = (glu ? pn - 12 : pn - 24) * HALF + cw;
#pragma unroll
            for (int ai = 0; ai < 2; ++ai) { if (ai == 1 && u.half) break;
#pragma unroll
                for (int m = 0; m < 4; ++m) {
                    bf16_t* op = base + (size_t)(row0 + ai * HALF + m * 16) * DCA + col;
                    if (glu) *(u32x4*)op = pack8(pair_op<PO_GLU>(acc[ai][0][m][0], acc[ai][1][m][0]), pair_op<PO_GLU>(acc[ai][0][m][1], acc[ai][1][m][1]));
                    else     *(u32x4*)op = pack8(pair_op<PO_MUL>(acc[ai][0][m][0], acc[ai][1][m][0]), pair_op<PO_MUL>(acc[ai][0][m][1], acc[ai][1][m][1]));
                } }
        } else if (pn < 24) {
#pragma unroll
            for (int ai = 0; ai < 2; ++ai) { if (ai == 1 && u.half) break;
#pragma unroll
                for (int m = 0; m < 4; ++m)
#pragma unroll
                    for (int bj = 0; bj < 2; ++bj)
                        *(u32x4*)(BG + (size_t)(row0 + ai * HALF + m * 16) * DCA + (pn - 20) * BM + bj * HALF + cw) = pack8(acc[ai][bj][m][0], acc[ai][bj][m][1]); }
        } else {
#pragma unroll
            for (int ai = 0; ai < 2; ++ai) { if (ai == 1 && u.half) break;
#pragma unroll
                for (int m = 0; m < 4; ++m)
#pragma unroll
                    for (int bj = 0; bj < 2; ++bj) { f32x4 a = acc[ai][bj][m][0], b = acc[ai][bj][m][1];
#pragma unroll
                        for (int e = 0; e < 4; ++e) { a[e] = fmaxf(fsigm(a[e]), 1e-20f); b[e] = fmaxf(fsigm(b[e]), 1e-20f); }
                        *(u32x4*)(GATES + (size_t)(row0 + ai * HALF + m * 16) * (3 * D) + (pn - 32) * BM + bj * HALF + cw) = pack8(a, b); } }
        }
    }
};
struct EpiMixK {
    static constexpr bool PERM = true, AFTER_DRAIN = false, RESCALE = true;
    bf16_t* MIX; const bf16_t* GATES;
    __device__ __forceinline__ void rescale(f32x4 (&acc)[2][2][4][2], const UnitK& u, int stage, int wr, int wc, int fr, int fq) const {
        const int row0 = u.pm * BM + u.rofs + wr * 64 + fr, col0 = u.pn * BM + wc * 32 + 8 * fq;
#pragma unroll
        for (int ai = 0; ai < 2; ++ai) { if (ai == 1 && u.half) break;
#pragma unroll
            for (int m = 0; m < 4; ++m) {
                const bf16_t* gp = GATES + (size_t)(row0 + ai * HALF + m * 16) * (3 * D) + (size_t)stage * D + col0;
#pragma unroll
                for (int bj = 0; bj < 2; ++bj) { f32x4 na, nb, da, db; unpack8(*(const u32x4*)(gp + bj * HALF), na, nb); unpack8(*(const u32x4*)(gp + D + bj * HALF), da, db);
#pragma unroll
                    for (int e_ = 0; e_ < 4; ++e_) { acc[ai][bj][m][0][e_] *= na[e_] * __builtin_amdgcn_rcpf(da[e_]); acc[ai][bj][m][1][e_] *= nb[e_] * __builtin_amdgcn_rcpf(db[e_]); } }
            } }
    }
    __device__ __forceinline__ void operator()(const f32x4 (&acc)[2][2][4][2], const UnitK& u, int wr, int wc, int fr, int fq) const {
        const int row0 = u.pm * BM + u.rofs + wr * 64 + fr, col0 = u.pn * BM + wc * 32 + 8 * fq;
#pragma unroll
        for (int ai = 0; ai < 2; ++ai) { if (ai == 1 && u.half) break;
#pragma unroll
            for (int m = 0; m < 4; ++m) {
                const size_t row = (size_t)(row0 + ai * HALF + m * 16);
#pragma unroll
                for (int bj = 0; bj < 2; ++bj) { const int col = col0 + bj * HALF;
                    f32x4 ga, gb; unpack8(*(const u32x4*)(GATES + row * (3 * D) + 2 * D + col), ga, gb);
                    *(u32x4*)(MIX + row * MIX_LD + col) = pack8(ga * acc[ai][bj][m][0], gb * acc[ai][bj][m][1]); }
            } }
    }
};

template <int MM, int NN, int KK, bool HT> struct TailOrder {
    static constexpr int nM = MM / BM, nN = NN / BM, nwg = nM * nN;
    int G, c;
    __device__ __forceinline__ void init(int G_, int c_) { G = G_; c = c_; }
    __device__ __forceinline__ void map(int L, UnitK& u) const {
        int wgid = L; { constexpr int q = nwg / NXCD, r = nwg % NXCD; const int xcd = wgid % NXCD, off = wgid / NXCD; wgid = (xcd < r ? xcd * (q + 1) : r * (q + 1) + (xcd - r) * q) + off; }
        constexpr int nig = WGM * nN; const int gid = wgid / nig, fm = gid * WGM, gsz = (nM - fm) < WGM ? (nM - fm) : WGM;
        u.pm = fm + ((wgid % nig) % gsz); u.pn = (wgid % nig) / gsz; }
    __device__ __forceinline__ bool next(int i, UnitK& u) const {
        const int F = nwg / G, Rem = nwg - F * G;
        const int s0 = Rem > 0 ? G / Rem : 1; const int s = (HT && Rem > 0 && (G % 8 == 0) && (G % Rem == 0) && ((G / 8) % s0 == 0) && s0 >= 2) ? s0 : 1;
        const bool ht = s > 1; const int x = c & 7, y = c >> 3, q = ht ? y % s : 0;
        const bool tail = i == F;
        const bool has = i < F || (tail && (ht ? q < 2 : c < Rem));
        if (i > F || !has) return false;
        const int L = (tail && ht) ? F * G + x + 8 * (y / s) : i * G + c;
        map(L, u); u.half = (tail && ht) ? 1 : 0; u.rofs = (tail && ht) ? 128 * q : 0;
        return true; }
    __device__ __forceinline__ void a_ready(const Unit&) const {}
    __device__ __forceinline__ void done(const Unit&) const {}
};

template <int NN, int PM0, int NML, int R, int KA, int KB> struct DealOrder {
    static constexpr int nN = NN / BM, U = NML * nN, Q = U / 8;
    static_assert(NML % 8 == 0 && R * KA + (32 - R) * KB == Q, "DealOrder: the per-rank counts must cover the XCD chunk exactly");
    int G, c;
    __device__ __forceinline__ void init(int G_, int c_) { G = G_; c = c_; }
    __device__ __forceinline__ bool next(int i, UnitK& u) const {
        const bool grid_ok = G == 256; const int x = c & 7, r = c >> 3;
        const int cnt = grid_ok ? (r < R ? KA : KB) : (U - c + G - 1) / G;
        if (i >= cnt) return false;
        constexpr int lo = KA < KB ? KA : KB;
        const int idx = i < lo ? i * 32 + r : (KA > KB ? lo * 32 + (i - lo) * R + r : lo * 32 + (i - lo) * (32 - R) + (r - R));
        const int L = grid_ok ? x * Q + idx : i * G + c;
        constexpr int nig = 8 * nN; const int gid = L / nig, rem = L % nig;
        u.pm = PM0 + gid * 8 + (rem & 7); u.pn = rem >> 3; u.half = 0; u.rofs = 0;
        return true; }
    __device__ __forceinline__ void a_ready(const Unit&) const {}
    __device__ __forceinline__ void done(const Unit&) const {}
};
template <class Epi, class Sched, int KK, int LDA, int LDB>
__device__ __forceinline__ void gemm_phase_ht(PG8_LAS unsigned char* lds, const Gemm g, const Sched& S, const Epi& E) {
    constexpr bool ALIGN_EPI = true, SP2 = true;
    const int tid = fresh_tid(), wid = __builtin_amdgcn_readfirstlane(tid >> 6), lane = tid & 63, wr = wid >> 2, wc = wid & 3, fr = lane & 15, fq = lane >> 4;
    constexpr int K = KK, nt = K / BK;
    unsigned voffA[2], voffB[2];
#pragma unroll
    for (int i = 0; i < 2; ++i) { int R, C; stage_rc(tid * 16 + i * 8192, R, C); const int Rb = Epi::PERM ? ((R & ~31) + perm32(R & 31)) : R;
        voffA[i] = (unsigned)(R * LDA + C) * 2u; voffB[i] = (unsigned)(Rb * LDB + C) * 2u; }
    constexpr size_t kstep = (size_t)(BK * 2);
    constexpr size_t hstepA = (size_t)HALF * LDA * 2, hstepB = (size_t)HALF * LDB * 2;
    constexpr size_t tstepA = 2 * hstepA, tstepB = 2 * hstepB;
    const unsigned ldsw = (unsigned)wid * 1024u;
    const int aoff = lds_byte(wr * 64 + fr, fq * 8), boff = lds_byte(wc * 32 + fr, fq * 8);
#define PG8_SA(b, h) (((b) * 2 + (h)) * HTB)
#define PG8_SB(b, h) ((4 + (b) * 2 + (h)) * HTB)
#define PG8_STAGE(bufoff, gbase, voff) do { _Pragma("unroll") for (int _i = 0; _i < 2; ++_i) \
        __builtin_amdgcn_global_load_lds((const unsigned*)((const char*)(gbase) + (voff)[_i]), (PG8_LAS unsigned*)(lds + (bufoff) + ldsw + _i * 8192), 16, 0, 0); } while (0)
#define PG8_LDA(dst, b, h) do { _Pragma("unroll") for (int m = 0; m < 4; ++m) _Pragma("unroll") for (int k = 0; k < 2; ++k) dst[m][k] = *(const PG8_LAS bf16x8*)(lds + PG8_SA(b, h) + aoff + m * 2048 + k * 1024); } while (0)
#define PG8_LDB(dst, b, h) do { _Pragma("unroll") for (int n = 0; n < 2; ++n) _Pragma("unroll") for (int k = 0; k < 2; ++k) dst[n][k] = *(const PG8_LAS bf16x8*)(lds + PG8_SB(b, h) + boff + n * 2048 + k * 1024); } while (0)
#define PG8_MMA(ai, bj, At, Bt) do { __builtin_amdgcn_s_setprio(1); _Pragma("unroll") for (int m = 0; m < 4; ++m) _Pragma("unroll") for (int n = 0; n < 2; ++n) _Pragma("unroll") for (int k = 0; k < 2; ++k) \
        acc[ai][bj][m][n] = __builtin_amdgcn_mfma_f32_16x16x32_bf16(Bt[n][k], At[m][k], acc[ai][bj][m][n], 0, 0, 0); __builtin_amdgcn_s_setprio(0); } while (0)
#define PG8_WAIT_V(n) asm volatile("s_waitcnt vmcnt(" #n ")" ::: "memory")
#define PG8_WAIT_L(n) asm volatile("s_waitcnt lgkmcnt(" #n ")" ::: "memory")
#define PG8_BAR __builtin_amdgcn_s_barrier()
#define PG8_SCHED __builtin_amdgcn_sched_barrier(0)
    UnitK cur, nxt; int ui = 0;
    if (!S.next(0, cur)) return;
    f32x4 acc[2][2][4][2];
#pragma unroll
    for (int a = 0; a < 2; ++a)
#pragma unroll
        for (int b = 0; b < 2; ++b)
#pragma unroll
            for (int m = 0; m < 4; ++m)
#pragma unroll
                for (int n = 0; n < 2; ++n) acc[a][b][m][n] = (f32x4){0.f, 0.f, 0.f, 0.f};
    bf16x8 At[4][2], B0[2][2], B1[2][2];
    const char* cA = (const char*)g.A + (size_t)cur.pm * tstepA + (size_t)cur.rofs * (LDA * 2); const char* cB = (const char*)g.Bt + (size_t)cur.pn * tstepB;
    S.a_ready(cur);
    if constexpr (SP2) {
        PG8_STAGE(PG8_SB(0, 0), cB, voffB); PG8_STAGE(PG8_SB(0, 1), cB + hstepB, voffB); PG8_STAGE(PG8_SA(0, 0), cA, voffA); PG8_STAGE(PG8_SA(0, 1), cA + hstepA, voffA);
        if (wr == 1) PG8_BAR;
        PG8_WAIT_V(2); PG8_BAR;
        PG8_STAGE(PG8_SB(1, 0), cB + kstep, voffB); PG8_STAGE(PG8_SA(1, 0), cA + kstep, voffA); PG8_STAGE(PG8_SB(1, 1), cB + hstepB + kstep, voffB);
        PG8_WAIT_V(6); PG8_BAR;
    } else {
        PG8_STAGE(PG8_SB(0, 0), cB, voffB); PG8_STAGE(PG8_SA(0, 0), cA, voffA); PG8_STAGE(PG8_SB(0, 1), cB + hstepB, voffB); PG8_STAGE(PG8_SA(0, 1), cA + hstepA, voffA);
        if (wr == 1) PG8_BAR;
        PG8_WAIT_V(4); PG8_BAR;
        PG8_STAGE(PG8_SB(1, 0), cB + kstep, voffB); PG8_STAGE(PG8_SA(1, 0), cA + kstep, voffA); PG8_STAGE(PG8_SB(1, 1), cB + hstepB + kstep, voffB);
        PG8_WAIT_V(6); PG8_BAR;
    }
    for (;;) {
        const bool has_next = S.next(ui + 1, nxt);
        const char* nA = has_next ? (const char*)g.A + (size_t)nxt.pm * tstepA + (size_t)nxt.rofs * (LDA * 2) : cA; const char* nB = has_next ? (const char*)g.Bt + (size_t)nxt.pn * tstepB : cB;
        for (int t = 0; t < nt; t += 2) {
            if constexpr (Epi::RESCALE) { if (t == 16 || t == 32) { const int tid_r = fresh_tid(); E.rescale(acc, cur, t == 16 ? 0 : 1, wr, wc, tid_r & 15, (tid_r & 63) >> 4); } }
            const bool last = (t == nt - 2);
            const char* a1 = cA + (size_t)(t + 1) * kstep;
            const char* a2 = last ? nA : cA + (size_t)(t + 2) * kstep; const char* b2 = last ? nB : cB + (size_t)(t + 2) * kstep;
            const char* a3 = a2 + kstep; const char* b3 = b2 + kstep;
            if (last && has_next) S.a_ready(nxt);
            if constexpr (SP2) {
            PG8_LDB(B0, 0, 0); PG8_LDB(B1, 0, 1); PG8_SCHED; PG8_LDA(At, 0, 0); PG8_STAGE(PG8_SA(1, 1), a1 + hstepA, voffA);
            PG8_WAIT_V(8); PG8_WAIT_L(0); PG8_BAR; PG8_MMA(0, 0, At, B0); PG8_MMA(0, 1, At, B1); PG8_BAR; PG8_SCHED;
            PG8_LDA(At, 0, 1); PG8_STAGE(PG8_SB(0, 0), b2, voffB); PG8_STAGE(PG8_SB(0, 1), b2 + hstepB, voffB); PG8_STAGE(PG8_SA(0, 0), a2, voffA);
            PG8_WAIT_V(8); PG8_WAIT_L(0); PG8_BAR; if (!cur.half) { PG8_MMA(1, 0, At, B0); PG8_MMA(1, 1, At, B1); } PG8_BAR; PG8_SCHED;
            PG8_LDB(B0, 1, 0); PG8_LDB(B1, 1, 1); PG8_SCHED; PG8_LDA(At, 1, 0); PG8_STAGE(PG8_SA(0, 1), a2 + hstepA, voffA);
            PG8_WAIT_V(8); PG8_WAIT_L(0); PG8_BAR; PG8_MMA(0, 0, At, B0); PG8_MMA(0, 1, At, B1); PG8_BAR; PG8_SCHED;
            PG8_LDA(At, 1, 1); PG8_STAGE(PG8_SB(1, 0), b3, voffB); PG8_STAGE(PG8_SB(1, 1), b3 + hstepB, voffB); PG8_STAGE(PG8_SA(1, 0), a3, voffA);
            PG8_WAIT_V(8); PG8_WAIT_L(0); PG8_BAR; if (!cur.half) { PG8_MMA(1, 0, At, B0); PG8_MMA(1, 1, At, B1); } PG8_BAR; PG8_SCHED;
            } else {
            PG8_LDB(B0, 0, 0); PG8_SCHED; PG8_LDA(At, 0, 0); PG8_STAGE(PG8_SA(1, 1), a1 + hstepA, voffA);
            PG8_WAIT_L(8); PG8_BAR; PG8_WAIT_L(0); PG8_MMA(0, 0, At, B0); PG8_BAR; PG8_SCHED;
            PG8_LDB(B1, 0, 1); PG8_STAGE(PG8_SB(0, 0), b2, voffB);
            PG8_BAR; PG8_WAIT_L(0); PG8_MMA(0, 1, At, B1); PG8_BAR;
            PG8_LDA(At, 0, 1); PG8_STAGE(PG8_SA(0, 0), a2, voffA);
            PG8_BAR; PG8_WAIT_L(0); PG8_MMA(1, 0, At, B0); PG8_BAR; PG8_SCHED;
            PG8_STAGE(PG8_SB(0, 1), b2 + hstepB, voffB);
            PG8_WAIT_V(6); PG8_BAR; PG8_MMA(1, 1, At, B1); PG8_BAR;
            PG8_LDB(B0, 1, 0); PG8_SCHED; PG8_LDA(At, 1, 0); PG8_STAGE(PG8_SA(0, 1), a2 + hstepA, voffA);
            PG8_WAIT_L(8); PG8_BAR; PG8_WAIT_L(0); PG8_MMA(0, 0, At, B0); PG8_BAR; PG8_SCHED;
            PG8_LDB(B1, 1, 1); PG8_STAGE(PG8_SB(1, 0), b3, voffB);
            PG8_BAR; PG8_WAIT_L(0); PG8_MMA(0, 1, At, B1); PG8_BAR;
            PG8_LDA(At, 1, 1); PG8_STAGE(PG8_SA(1, 0), a3, voffA);
            PG8_BAR; PG8_WAIT_L(0); PG8_MMA(1, 0, At, B0); PG8_BAR; PG8_SCHED;
            PG8_STAGE(PG8_SB(1, 1), b3 + hstepB, voffB);
            PG8_WAIT_V(6); PG8_BAR; PG8_MMA(1, 1, At, B1); PG8_BAR;
            }
        }
        if constexpr (ALIGN_EPI) { if (wr == 0) PG8_BAR; }
        { const int tid_e = fresh_tid(); E(acc, cur, wr, wc, tid_e & 15, (tid_e & 63) >> 4); }
        if (!has_next) break;
#pragma unroll
        for (int a = 0; a < 2; ++a)
#pragma unroll
            for (int b = 0; b < 2; ++b)
#pragma unroll
                for (int m = 0; m < 4; ++m)
#pragma unroll
                    for (int n = 0; n < 2; ++n) acc[a][b][m][n] = (f32x4){0.f, 0.f, 0.f, 0.f};
        cur = nxt; cA = nA; cB = nB; ++ui;
        if constexpr (ALIGN_EPI) { if (wr == 1) PG8_BAR; }
    }
    PG8_WAIT_V(0);
    if constexpr (!ALIGN_EPI) { if (wr == 0) PG8_BAR; }
    PG8_BAR;
#undef PG8_SA
#undef PG8_SB
#undef PG8_STAGE
#undef PG8_LDA
#undef PG8_LDB
#undef PG8_MMA
#undef PG8_WAIT_V
#undef PG8_WAIT_L
#undef PG8_BAR
#undef PG8_SCHED
}
}

namespace att {
typedef unsigned short bf16;
typedef short bf16x8 __attribute__((ext_vector_type(8)));
typedef short s16x4 __attribute__((ext_vector_type(4)));
typedef float f32x16 __attribute__((ext_vector_type(16)));
typedef unsigned u32x4 __attribute__((ext_vector_type(4)));
constexpr float SCALE = 0.08838834764831845f, THR = 8.f;
constexpr int SHM_V = 16384, SHM_K = 16384, NW = 8;
constexpr int LDS_BYTES = 2 * SHM_V + 2 * SHM_K + NW * 64 * 4;
#define KSWZ(row, colB) ((row) * 256 + ((colB) ^ (((row) & 7) << 4)))
#define SBAR() __builtin_amdgcn_sched_barrier(0)
__device__ __forceinline__ int v_st(int k, int c) { const int kk = (k & ~0xC) | ((k & 4) << 1) | ((k & 8) >> 1); return ((kk >> 3) * 4 + (c >> 5)) * 512 + ((kk & 7) * 32 + (c & 31)) * 2; }
__device__ __forceinline__ int v_rd_base(int lane) { return ((lane & 3) << 3) | (((lane >> 2) & 3) << 6) | (((lane >> 4) & 1) << 5) | (((lane >> 5) & 1) << 8); }
constexpr int v_rd_off(int d0, int ks, int half) { return d0 * 512 + ks * 4096 + half * 2048; }
__device__ __forceinline__ int crow(int r, int hi) { return (r & 3) + 8 * (r >> 2) + 4 * hi; }
__device__ __forceinline__ unsigned cvtpk(float lo, float hi) { unsigned r; asm volatile("v_cvt_pk_bf16_f32 %0, %1, %2" : "=v"(r) : "v"(lo), "v"(hi)); return r; }
__device__ __forceinline__ void mask_tile(f32x16& p0, f32x16& p1, int d, int type) {
    const float NEG = -__builtin_inff();
#pragma unroll
    for (int r = 0; r < 16; ++r) {
        const int c = (r & 3) + 8 * (r >> 2);
        if (type == 1) { if (c < d) p0[r] = NEG; if (c + 32 < d) p1[r] = NEG; }
        else           { if (c > d) p0[r] = NEG; if (c + 32 > d) p1[r] = NEG; }
    }
}
__device__ __forceinline__ void partialSM(f32x16& p0, f32x16& p1, float& m_reg, float& mn, float& alpha) {
    float pmax = p0[0]; for (int r = 1; r < 16; ++r) pmax = fmaxf(pmax, p0[r]); for (int r = 0; r < 16; ++r) pmax = fmaxf(pmax, p1[r]);
    { auto rr = __builtin_amdgcn_permlane32_swap(__float_as_uint(pmax), __float_as_uint(pmax), false, false);
      pmax = fmaxf(__uint_as_float(rr[0]), __uint_as_float(rr[1])); }
    constexpr float C2 = 1.4426950408889634f * SCALE;
    if (__builtin_expect(__all((pmax - m_reg) * SCALE <= THR), 1)) { mn = m_reg; alpha = 1.f; }
    else { mn = fmaxf(m_reg, pmax); alpha = __builtin_amdgcn_exp2f((m_reg - mn) * C2); m_reg = mn; }
    const float mnL = -mn * C2;
    for (int r = 0; r < 16; ++r) p0[r] = fmaf(p0[r], C2, mnL); for (int r = 0; r < 16; ++r) p1[r] = fmaf(p1[r], C2, mnL);
    for (int r = 0; r < 16; ++r) p0[r] = __builtin_amdgcn_exp2f(p0[r]);
}
__device__ __forceinline__ void finishSM(f32x16& p0, f32x16& p1, float alpha, float& l_reg, bf16x8& pa0, bf16x8& pa1, bf16x8& pa2, bf16x8& pa3) {
    for (int r = 0; r < 16; ++r) p1[r] = __builtin_amdgcn_exp2f(p1[r]);
    float ps = 0; for (int r = 0; r < 16; ++r) ps += p0[r]; for (int r = 0; r < 16; ++r) ps += p1[r];
    { auto rr = __builtin_amdgcn_permlane32_swap(__float_as_uint(ps), __float_as_uint(ps), false, false);
      ps = __uint_as_float(rr[0]) + __uint_as_float(rr[1]); }
    l_reg = l_reg * alpha + ps;
#define PK4(P, B_, OUT) do { unsigned a0 = cvtpk(P[B_+0], P[B_+1]), a1 = cvtpk(P[B_+2], P[B_+3]);                          \
        unsigned b0 = cvtpk(P[B_+4], P[B_+5]), b1 = cvtpk(P[B_+6], P[B_+7]);                                             \
        auto r0 = __builtin_amdgcn_permlane32_swap(a0, b0, false, false); auto r1 = __builtin_amdgcn_permlane32_swap(a1, b1, false, false); \
        u32x4 w = {r0[0], r1[0], r0[1], r1[1]}; OUT = *reinterpret_cast<bf16x8*>(&w); } while (0)
    PK4(p0, 0, pa0); PK4(p0, 8, pa1); PK4(p1, 0, pa2); PK4(p1, 8, pa3);
#undef PK4
}
template <int KB>
__device__ __forceinline__ void qkt(f32x16& p0, f32x16& p1, const char* K_lds, int r32, int hi, const bf16x8* qr) {
    p0 = f32x16{}; p1 = f32x16{};
    const char* kb[4];
#pragma unroll
    for (int dd = 0; dd < 4; ++dd) kb[dd] = K_lds + KB * SHM_K + KSWZ(r32, (dd * 16 + hi * 8) * 2);
#pragma unroll
    for (int d0 = 0; d0 < 8; ++d0) { const char* a = kb[d0 & 3] + (d0 >> 2) * 128;
        bf16x8 b0 = *reinterpret_cast<const bf16x8*>(a);
        bf16x8 b1 = *reinterpret_cast<const bf16x8*>(a + 32 * 256);
        p0 = __builtin_amdgcn_mfma_f32_32x32x16_bf16(b0, qr[d0], p0, 0, 0, 0);
        p1 = __builtin_amdgcn_mfma_f32_32x32x16_bf16(b1, qr[d0], p1, 0, 0, 0); }
}
template <int VB>
__device__ __forceinline__ void pv_tile(f32x16* o, int vb0, bf16x8 pa0, bf16x8 pa1, bf16x8 pa2, bf16x8 pa3) {
#define TRRD(dst, off) asm volatile("ds_read_b64_tr_b16 %0, %1 offset:%2" : "=&v"(dst) : "v"(vb0), "i"(off) : "memory")
#define PV_D0(d0) do { s16x4 l0, l1, l2, l3, h0, h1, h2, h3; constexpr int b_ = VB * SHM_V + v_rd_off(d0, 0, 0); \
        TRRD(l0, b_); TRRD(h0, b_ + 2048); TRRD(l1, b_ + 4096); TRRD(h1, b_ + 6144); TRRD(l2, b_ + 8192); TRRD(h2, b_ + 10240); TRRD(l3, b_ + 12288); TRRD(h3, b_ + 14336); \
        asm volatile("s_waitcnt lgkmcnt(0)" ::: "memory"); SBAR();   \
        o[d0] = __builtin_amdgcn_mfma_f32_32x32x16_bf16(pa0, (bf16x8){l0[0], l0[1], l0[2], l0[3], h0[0], h0[1], h0[2], h0[3]}, o[d0], 0, 0, 0);   \
        o[d0] = __builtin_amdgcn_mfma_f32_32x32x16_bf16(pa1, (bf16x8){l1[0], l1[1], l1[2], l1[3], h1[0], h1[1], h1[2], h1[3]}, o[d0], 0, 0, 0);   \
        o[d0] = __builtin_amdgcn_mfma_f32_32x32x16_bf16(pa2, (bf16x8){l2[0], l2[1], l2[2], l2[3], h2[0], h2[1], h2[2], h2[3]}, o[d0], 0, 0, 0);   \
        o[d0] = __builtin_amdgcn_mfma_f32_32x32x16_bf16(pa3, (bf16x8){l3[0], l3[1], l3[2], l3[3], h3[0], h3[1], h3[2], h3[3]}, o[d0], 0, 0, 0); } while (0)
    PV_D0(0); PV_D0(1); PV_D0(2); PV_D0(3);
#undef PV_D0
#undef TRRD
}
__device__ __forceinline__ void attn_unit(const bf16* Qw, const bf16* cK, const bf16* cV, const bf16* wK, const bf16* wV, int nctx, int NT, int tm1, int tm2, const float* sinkp, bf16* Ow, int ldo, char* lds) {
    const int tid = fresh_tid(), wid = __builtin_amdgcn_readfirstlane(tid >> 6), lane = tid & 63, r32 = lane & 31, hi = lane >> 5;
    char* V_lds = lds; char* K_lds = lds + 2 * SHM_V;
    float* wsf = (float*)(lds + 2 * SHM_V + 2 * SHM_K) + wid * 64; float* li_l = wsf, * al_l = wsf + 32;
    float m_reg = -1e30f, l_reg = 0; f32x16 o[4] = {};
    const int sr = tid >> 4, sc = (tid & 15) * 8, vst0 = v_st(sr, sc), vst1 = v_st(32 + sr, sc), kws = KSWZ(sr, sc * 2);
    const int vb0 = (int)(uintptr_t)V_lds + v_rd_base(lane);
    const int qrow = 32 * (wid & 1) + r32, hq = wid >> 1, dmask = qrow - 4 * hi;
    bf16x8 qr[8];
#pragma unroll
    for (int d0 = 0; d0 < 8; ++d0) qr[d0] = *(const bf16x8*)(Qw + (size_t)qrow * D + hq * 128 + d0 * 16 + hi * 8);
    bf16x8 st_v0, st_v1, st_k0, st_k1;
#define TILEP(t, kp, vp) const bf16* kp = (t) < nctx ? cK + (size_t)(t) * 64 * KVD : wK + (size_t)((t) - nctx) * 64 * KVD; const bf16* vp = (t) < nctx ? cV + (size_t)(t) * 64 * KVD : wV + (size_t)((t) - nctx) * 64 * KVD
#define SLOAD(t) do { TILEP(t, kp_, vp_); st_v0 = *(const bf16x8*)(vp_ + (size_t)sr * KVD + sc); st_v1 = *(const bf16x8*)(vp_ + (size_t)(32 + sr) * KVD + sc); \
                      st_k0 = *(const bf16x8*)(kp_ + (size_t)sr * KVD + sc); st_k1 = *(const bf16x8*)(kp_ + (size_t)(32 + sr) * KVD + sc); } while (0)
#define SWRITE(bf) do { *(bf16x8*)(V_lds + (bf) * SHM_V + vst0) = st_v0; *(bf16x8*)(V_lds + (bf) * SHM_V + vst1) = st_v1; \
                        *(bf16x8*)(K_lds + (bf) * SHM_K + kws) = st_k0; *(bf16x8*)(K_lds + (bf) * SHM_K + kws + 32 * 256) = st_k1; } while (0)
#define VMW() asm volatile("s_waitcnt vmcnt(0)" ::: "memory")
#define RESC(a) do { if (__any((a) < 1.f)) { if (hi == 0) al_l[r32] = (a); asm volatile("s_waitcnt lgkmcnt(0)" ::: "memory");              \
                     for (int d_ = 0; d_ < 4; ++d_) for (int r = 0; r < 16; ++r) o[d_][r] *= al_l[crow(r, hi)]; } } while (0)
    f32x16 p0, p1; float mn, al; bf16x8 pa0, pa1, pa2, pa3;
#define STEP(t, B) do { if ((t) + 1 < NT) SLOAD((t) + 1); SBAR();                                                   \
        qkt<B>(p0, p1, K_lds, r32, hi, qr);                                                                           \
        if ((t) == tm1) mask_tile(p0, p1, dmask, 1); else if ((t) == tm2) mask_tile(p0, p1, dmask, 2);                \
        partialSM(p0, p1, m_reg, mn, al); RESC(al); finishSM(p0, p1, al, l_reg, pa0, pa1, pa2, pa3); SBAR();          \
        pv_tile<B>(o, vb0, pa0, pa1, pa2, pa3);                                                                       \
        if ((t) + 1 < NT) { VMW(); SWRITE((B) ^ 1); }                                                                 \
        __syncthreads(); } while (0)
    SLOAD(0); VMW(); SWRITE(0); __syncthreads();
    for (int t = 0; t < NT; t += 2) { STEP(t, 0); if (t + 1 < NT) STEP(t + 1, 1); }
    { constexpr float C2 = 1.4426950408889634f * SCALE; const float sk = sinkp[hq];
      l_reg += __builtin_amdgcn_exp2f(sk * 1.4426950408889634f - m_reg * C2); }
    if (hi == 0) li_l[r32] = l_reg; asm volatile("s_waitcnt lgkmcnt(0)" ::: "memory");
    float rli[16];
#pragma unroll
    for (int r = 0; r < 16; ++r) rli[r] = __builtin_amdgcn_rcpf(li_l[crow(r, hi)]);
    bf16* Op = Ow + (size_t)(32 * (wid & 1)) * ldo + hq * 128;
#pragma unroll
    for (int r = 0; r < 16; ++r) { const int orow = crow(r, hi);
#pragma unroll
        for (int d0 = 0; d0 < 4; ++d0) { const float v = o[d0][r] * rli[r]; const float vn = __shfl_xor(v, 1);
            if ((r32 & 1) == 0) *(unsigned*)(Op + (size_t)orow * ldo + d0 * 32 + r32) = cvtpk(v, vn); } }
    __syncthreads();
#undef TILEP
#undef SLOAD
#undef SWRITE
#undef VMW
#undef RESC
#undef STEP
}
#undef KSWZ
#undef SBAR
}

#define GAS __attribute__((address_space(1)))
#define LAS __attribute__((address_space(3)))
typedef unsigned short bf16;
typedef unsigned v4u __attribute__((ext_vector_type(4)));
typedef float f32x4 __attribute__((ext_vector_type(4)));
typedef short bf16x8 __attribute__((ext_vector_type(8)));
typedef GAS unsigned gu32;
#define RLX_AGENT __ATOMIC_RELAXED, __HIP_MEMORY_SCOPE_AGENT
#define LDS_WAIT() asm volatile("s_waitcnt lgkmcnt(0)" ::: "memory")
#define VM_WAIT() asm volatile("s_waitcnt vmcnt(0)" ::: "memory")
__device__ __forceinline__ unsigned f2bf(float f) { unsigned u = __builtin_bit_cast(unsigned, f); return (u + 0x7fffu + ((u >> 16) & 1u)) >> 16; }
__device__ __forceinline__ unsigned pk2(float lo, float hi) { return f2bf(lo) | (f2bf(hi) << 16); }
__device__ __forceinline__ float bflo(unsigned w) { return __builtin_bit_cast(float, w << 16); }
__device__ __forceinline__ float bfhi(unsigned w) { return __builtin_bit_cast(float, w & 0xffff0000u); }
__device__ __forceinline__ float wave_sum(float v) {
#pragma unroll
    for (int o = 1; o < 64; o <<= 1) v += __shfl_xor(v, o);
    return v;
}
__device__ __forceinline__ float silu_acc(float x) { return x / (1.f + __expf(-x)); }
#define XB_TMO      128
#define XB_XCNT(j)  (256  + 64 * (j))
#define XB_XSUB(j)  (1280 + 64 * (j))
#define XB_XGEN(j)  (2304 + 64 * (j))
#define XB_TOP      3328
#define XB_TOPGEN   3392
#define XCD_BAR_WORDS 3456
#define XB_SPIN_CAP (1u << 18)

__device__ __forceinline__ unsigned xb_ld(unsigned* p)              { return __hip_atomic_load(p, __ATOMIC_RELAXED, __HIP_MEMORY_SCOPE_AGENT); }
__device__ __forceinline__ unsigned xb_add(unsigned* p, unsigned v) { return __hip_atomic_fetch_add(p, v, __ATOMIC_RELAXED, __HIP_MEMORY_SCOPE_AGENT); }
__device__ __forceinline__ unsigned xb_xcc_id() { return (unsigned)__builtin_amdgcn_s_getreg((3 << 11) | 20) & 0xFu; }
#define XB_SPIN(cond, bar) do { unsigned _sp = 0; while (cond) { __builtin_amdgcn_s_sleep(1); \
    if ((++_sp & 255u) == 0u) { if (xb_ld(&(bar)[XB_TMO])) break; if (_sp > XB_SPIN_CAP) { atomicAdd(&(bar)[XB_TMO], 1u); break; } } } } while (0)

struct XcdBarrier {
    unsigned* bar; unsigned x;
    volatile LAS unsigned* st;
};

__device__ __forceinline__ XcdBarrier xcd_barrier_post(unsigned* bar, volatile LAS unsigned* st) {
    XcdBarrier b; b.bar = bar; b.x = xb_xcc_id(); b.st = st;
    if (threadIdx.x == 0) (void)xb_add(&bar[XB_XCNT(b.x)], 1u);
    return b;
}
__device__ __forceinline__ void xcd_barrier_complete(unsigned* bar, unsigned x, unsigned& nloc, unsigned& nx) {
    const unsigned G = gridDim.x * gridDim.y * gridDim.z;
    unsigned sum, cnt, mine, sp = 0u;
    for (;;) {
        sum = 0u; cnt = 0u; mine = 0u;
#pragma unroll
        for (unsigned j = 0; j < 16; ++j) { const unsigned c = xb_ld(&bar[XB_XCNT(j)]); sum += c; cnt += (c > 0u) ? 1u : 0u; mine = (j == x) ? c : mine; }
        if (sum == G) break;
        __builtin_amdgcn_s_sleep(1);
        if ((++sp & 255u) == 0u) { if (xb_ld(&bar[XB_TMO])) break; if (sp > XB_SPIN_CAP) { atomicAdd(&bar[XB_TMO], 1u); break; } }
    }
    nloc = mine > 0u ? mine : 1u; nx = cnt > 0u ? cnt : 1u;
}

__device__ __forceinline__ void xcd_barrier(const XcdBarrier& b) {
    asm volatile("s_waitcnt vmcnt(0)" ::: "memory");
    __syncthreads();
    if (threadIdx.x == 0) {
        unsigned* bar = b.bar;
        __builtin_amdgcn_s_waitcnt(0);
        unsigned nloc = b.st[0], nx = b.st[1];
        if (nloc == 0u) { xcd_barrier_complete(bar, b.x, nloc, nx); b.st[0] = nloc; b.st[1] = nx; }
        const unsigned old = xb_add(&bar[XB_XSUB(b.x)], 1u);
        const unsigned gen = old / nloc;
        if (old + 1u == (gen + 1u) * nloc) {
            __builtin_amdgcn_fence(__ATOMIC_RELEASE, "agent");
            asm volatile("s_waitcnt vmcnt(0)" ::: "memory");
            const unsigned og = xb_add(&bar[XB_TOP], 1u);
            const unsigned tg = og / nx;
            if (og + 1u == (tg + 1u) * nx) xb_add(&bar[XB_TOPGEN], 1u);
            else XB_SPIN(xb_ld(&bar[XB_TOPGEN]) == tg, bar);
            __builtin_amdgcn_fence(__ATOMIC_ACQUIRE, "agent");
            xb_add(&bar[XB_XGEN(b.x)], 1u);
            asm volatile("s_waitcnt vmcnt(0)" ::: "memory");
        } else {
            XB_SPIN(xb_ld(&bar[XB_XGEN(b.x)]) == gen, bar);
            __builtin_amdgcn_fence(__ATOMIC_ACQUIRE, "agent");
            asm volatile("s_waitcnt vmcnt(0)" ::: "memory");
        }
    }
    __syncthreads();
}


constexpr int NWAVES = 8, NTHR = NWAVES * 64;
constexpr int RING_OFF = 0, RING_BYTES = 131072;
constexpr int LDSCTL_OFF = RING_BYTES, MISC_OFF = LDSCTL_OFF + 320;
constexpr int LDS_BYTES = 147456;
static_assert(att::LDS_BYTES <= RING_BYTES && MISC_OFF + 128 <= LDS_BYTES, "LDS map");
constexpr int N_PHASES = 27;

__device__ __forceinline__ int dest_row(int kind, int n0) {
    if (kind == 1) { const int uv = n0 / DFF, j = n0 % DFF; return 256 * (j >> 7) + 128 * uv + (j & 127); }
    if (kind == 2) {
        if (n0 < 2560) { const int isk = n0 >= 2048, nn = isk ? n0 - 2048 : n0, head = nn >> 7, d = nn & 127, part = d >> 6, x = (d >> 5) & 1;
                         return 256 * ((isk ? 8 : 0) + (head >> 1)) + 128 * x + 64 * (head & 1) + 32 * part; }
        if (n0 < 3072) return n0;
        if (n0 < 5120) { const int nn = n0 - 3072, ag = nn >> 10, j = nn & 1023; return 256 * (12 + (j >> 7)) + 128 * ag + (j & 127); }
        if (n0 < 6144) return n0;
        if (n0 < 8192) { const int nn = n0 - 6144, xv = nn >> 10, j = nn & 1023; return 256 * (24 + (j >> 7)) + 128 * xv + (j & 127); }
        return n0;
    }
    return n0;
}
__device__ __forceinline__ void p0_transpose_item(const float* W, int K, int N, bf16* WT, int kind, LAS float* scr, int item, int lane, int ldk = 0, int koff = 0) {
    if (ldk == 0) ldk = K;
    const int nblk = N / 32, kb = item / nblk, nb = item % nblk, k0 = 64 * kb, n0 = 32 * nb, drow = dest_row(kind, n0);
#pragma unroll 8
    for (int i = 0; i < 32; ++i) { const int kk = 2 * i + (lane >> 5); scr[kk * 33 + (lane & 31)] = W[(size_t)(k0 + kk) * N + n0 + (lane & 31)]; }
    LDS_WAIT(); asm volatile("" ::: "memory");
    const int c = lane & 7;
#pragma unroll
    for (int j = 0; j < 4; ++j) { const int n = (lane >> 3) + 8 * j; const LAS float* s = scr + (8 * c) * 33 + n;
        v4u o; o.x = pk2(s[0 * 33], s[1 * 33]); o.y = pk2(s[2 * 33], s[3 * 33]); o.z = pk2(s[4 * 33], s[5 * 33]); o.w = pk2(s[6 * 33], s[7 * 33]);
        *(GAS v4u*)(WT + (size_t)(drow + n) * ldk + koff + k0 + 8 * c) = o; }
    LDS_WAIT(); asm volatile("" ::: "memory");
}
constexpr int I_FI = (D / 64) * (2 * DFF / 32), I_FO = (DFF / 64) * (D / 32), I_IN = (D / 64) * (INC / 32), I_DD = (D / 64) * (D / 32), I_HD = (DCA / 64) * (D / 32);
constexpr int I_LAYER = 2 * I_FI + 2 * I_FO + I_IN + 2 * I_DD + 2 * I_HD;

constexpr int R_1I = 0, R_1O = I_FI, R_IN = R_1O + I_FO, R_AO = R_IN + I_IN, R_OUT = R_AO + I_DD + 2 * I_HD, R_2I = R_OUT + I_DD, R_2O = R_2I + I_FI, R_END = R_2O + I_FO;
static_assert(R_END == I_LAYER, "item map");
__device__ __forceinline__ void convert_range(const Args& a, unsigned char* lds, int l, int r_lo, int r_hi, int wi, int nw) {
    const int tid = fresh_tid(), lane = tid & 63, wave = __builtin_amdgcn_readfirstlane(tid >> 6);
    LAS float* scr = (LAS float*)((LAS unsigned char*)lds + wave * 16384);
    unsigned char* wl = a.ws + WS_WT + (size_t)l * WT_LAYER;
    for (int it = r_lo + wi; it < r_hi; it += nw) {
        int r = it;
        if (r < I_FI) { p0_transpose_item(a.in[9] + (size_t)l * D * 2 * DFF, D, 2 * DFF, (bf16*)(wl + WT_1I), 1, scr, r, lane, WK_D, 0); continue; } r -= I_FI;
        if (r < I_FO) { p0_transpose_item(a.in[10] + (size_t)l * DFF * D, DFF, D, (bf16*)(wl + WT_1O), 0, scr, r, lane, WK_FF, 0); continue; } r -= I_FO;
        if (r < I_IN) { p0_transpose_item(a.in[12] + (size_t)l * D * INC, D, INC, (bf16*)(wl + WT_IN), 2, scr, r, lane, WK_D, 0); continue; } r -= I_IN;
        if (r < I_DD) { p0_transpose_item(a.in[14] + (size_t)l * D * D, D, D, (bf16*)(wl + WT_MIXB), 0, scr, r, lane, WK_MIX, 2048); continue; } r -= I_DD;
        if (r < I_HD) { p0_transpose_item(a.in[18] + (size_t)l * DCA * D, DCA, D, (bf16*)(wl + WT_MIXB), 0, scr, r, lane, WK_MIX, 0); continue; } r -= I_HD;
        if (r < I_HD) { p0_transpose_item(a.in[20] + (size_t)l * DCA * D, DCA, D, (bf16*)(wl + WT_MIXB), 0, scr, r, lane, WK_MIX, 1024); continue; } r -= I_HD;
        if (r < I_DD) { p0_transpose_item(a.in[21] + (size_t)l * D * D, D, D, (bf16*)(wl + WT_OUT), 0, scr, r, lane, WK_D, 0); continue; } r -= I_DD;
        if (r < I_FI) { p0_transpose_item(a.in[23] + (size_t)l * D * 2 * DFF, D, 2 * DFF, (bf16*)(wl + WT_2I), 1, scr, r, lane, WK_D, 0); continue; } r -= I_FI;
        p0_transpose_item(a.in[24] + (size_t)l * DFF * D, DFF, D, (bf16*)(wl + WT_2O), 0, scr, r, lane, WK_FF, 0);
    }
}
__device__ __forceinline__ void ada_layer(const Args& a, unsigned char* lds, int l, int bi, int nb, int item_lo = 0, int item_hi = NMOD / 64) {
    const int tid = fresh_tid(), lane = tid & 63, wave = __builtin_amdgcn_readfirstlane(tid >> 6);
    const float* c = a.in[4]; const float* c_ctx = a.in[5]; const float* w_ada = a.in[6]; const float* b_ada = a.in[7];
    float* sv = (float*)lds;
    float* part = (float*)(lds + 24576);
    __syncthreads();
    for (int i = tid; i < D; i += NTHR) { sv[i] = silu_acc(c_ctx[i]); sv[D + i] = silu_acc(c[i]); sv[2 * D + i] = silu_acc(c[D + i]); }
    __syncthreads();
    float* MOD = (float*)(a.ws + WS_MOD);
    for (int item = item_lo + bi; item < item_hi; item += nb) {
        const int j0 = item * 64;
        const float* w = w_ada + ((size_t)l * D + wave * 256) * NMOD + j0 + lane;
        const float* s0 = sv + wave * 256;
        float a0 = 0.f, a1 = 0.f, a2 = 0.f;
#pragma unroll 16
        for (int k = 0; k < 256; ++k) { const float x = w[(size_t)k * NMOD]; a0 += s0[k] * x; a1 += s0[D + k] * x; a2 += s0[2 * D + k] * x; }
        part[(wave * 3 + 0) * 64 + lane] = a0; part[(wave * 3 + 1) * 64 + lane] = a1; part[(wave * 3 + 2) * 64 + lane] = a2;
        __syncthreads();
        if (tid < 192) { const int cc = tid >> 6, j = tid & 63; float s = b_ada[l * NMOD + j0 + j];
#pragma unroll
            for (int wv = 0; wv < 8; ++wv) s += part[(wv * 3 + cc) * 64 + j];
            MOD[(size_t)(l * 3 + cc) * NMOD + j0 + j] = s; }
        __syncthreads();
    }
}
#ifndef FILL_MASK
#define FILL_MASK 0
#endif
__device__ __forceinline__ void filler(const Args& a, unsigned char* lds, int job, int idle, int nidle) {
    const int wave = __builtin_amdgcn_readfirstlane(fresh_tid() >> 6), wi = idle * NWAVES + wave, nw = nidle * NWAVES;
    if (job == 1) convert_range(a, lds, 0, R_IN, R_AO, wi, nw);
    else if (job == 2) convert_range(a, lds, 0, R_AO, R_END, wi, nw);
    else if (job == 3) ada_layer(a, lds, 1, idle, nidle, 0, NMOD / 128);
    else if (job == 7) ada_layer(a, lds, 1, idle, nidle, NMOD / 128, NMOD / 64);
    else if (job == 4) convert_range(a, lds, 1, R_1I, R_IN, wi, nw);
    else if (job == 5) convert_range(a, lds, 1, R_IN, R_AO, wi, nw);
    else if (job == 6) convert_range(a, lds, 1, R_AO, R_END, wi, nw);
}
__device__ __forceinline__ void prologue(const Args& a, unsigned char* lds, int vcu, int G) {
    const int tid = fresh_tid(), wave = __builtin_amdgcn_readfirstlane(tid >> 6);
    unsigned char* ws = a.ws;
    ada_layer(a, lds, 0, vcu, G);
    convert_range(a, lds, 0, R_1I, R_IN, vcu * NWAVES + wave, G * NWAVES);
#pragma unroll
    for (int j = 1; j <= 7; ++j) if (!(((FILL_MASK) >> j) & 1)) filler(a, lds, j, vcu, G);
    {
        const int gt = vcu * NTHR + tid, NT = G * NTHR;
        const int n8 = 2 * 2 * PAST * KVD / 8;
        for (int i = gt; i < 2 * n8; i += NT) { const bool isk = i < n8; const int j = isk ? i : i - n8;
            const f32x4* s = (const f32x4*)((isk ? a.in[2] : a.in[3]) + (size_t)j * 8); const f32x4 x = s[0], y = s[1];
            v4u o; o.x = pk2(x[0], x[1]); o.y = pk2(x[2], x[3]); o.z = pk2(y[0], y[1]); o.w = pk2(y[2], y[3]);
            *(v4u*)(ws + (isk ? WS_CK : WS_CV) + (size_t)j * 16) = o; }
        if (gt < 64 * 32) { const int pos = gt >> 5, i = gt & 31; const float inv = powf(10000.f, -(float)i / 32.f), ang = (float)pos * inv;
            float* rp = (float*)(ws + WS_ROPE) + (size_t)gt * 2; rp[0] = cosf(ang); rp[1] = sinf(ang); }
        const size_t n4c = (size_t)MC * D / 4, n4 = (size_t)M * D / 4;
        const f32x4* xp = (const f32x4*)a.in[0]; const f32x4* xs = (const f32x4*)a.in[1]; f32x4* X = (f32x4*)(ws + WS_X);
        for (size_t i = gt; i < n4; i += NT) X[i] = i < n4c ? xp[i] : xs[i - n4c];
    }
}
template <bool FINAL>
__device__ __forceinline__ void norm_phase(const float* X, const float* g, const float* MODl, int sub, bf16* H, float* out, int vcu, int G, int row_lo, int row_hi) {
    const int tid = fresh_tid(), lane = tid & 63, gw = vcu * NWAVES + __builtin_amdgcn_readfirstlane(tid >> 6), NGW = G * NWAVES;
    for (int m = row_lo + gw; m < row_hi; m += NGW) {
        const f32x4* xr = (const f32x4*)(X + (size_t)m * D) + lane; f32x4 v[8]; float ss = 0.f;
#pragma unroll
        for (int j = 0; j < 8; ++j) { v[j] = xr[64 * j]; ss += (v[j][0] * v[j][0] + v[j][1] * v[j][1]) + (v[j][2] * v[j][2] + v[j][3] * v[j][3]); }
        const float r = rsqrtf(wave_sum(ss) * (1.f / D) + EPS);
        const f32x4* gr = (const f32x4*)g + lane;
        if (FINAL) { f32x4* o = (f32x4*)(out + (size_t)m * D) + lane;
#pragma unroll
            for (int j = 0; j < 8; ++j) o[64 * j] = v[j] * r * gr[64 * j];
        } else {
            const int cond = m < MC ? 0 : (m < MC + SEQL ? 1 : 2);
            const float* mod = MODl + (size_t)cond * NMOD + (size_t)sub * 3 * D;
            const f32x4* sh = (const f32x4*)mod + lane; const f32x4* sc = (const f32x4*)(mod + D) + lane;
            unsigned long long* o8 = (unsigned long long*)(H + (size_t)m * H_LD) + lane;
#pragma unroll
            for (int j = 0; j < 8; ++j) { const f32x4 h = v[j] * r * gr[64 * j] * (sc[64 * j] + 1.f) + sh[64 * j];
                o8[64 * j] = (unsigned long long)pk2(h[0], h[1]) | ((unsigned long long)pk2(h[2], h[3]) << 32); }
        }
    }
}
__device__ __forceinline__ void conv_a_phase(const bf16* GLU, const float* w, const float* bias, const float* g, bf16* CA, int vcu, int G, unsigned char* lds, int u_lo, int u_hi) {
    const int tid = fresh_tid(), wid = tid >> 6, lane = tid & 63;
    float* part = (float*)lds;
    float* rs = (float*)(lds + 16384);
    float wv0[31], wv1[31];
#pragma unroll
    for (int t = 0; t < 31; ++t) { wv0[t] = w[t * DCA + 2 * tid]; wv1[t] = w[t * DCA + 2 * tid + 1]; }
    const float b0 = bias[2 * tid], b1 = bias[2 * tid + 1], g0 = g[2 * tid], g1 = g[2 * tid + 1];
    for (int u = u_lo + vcu; u < u_hi; u += G) {
        const int row0 = u * 16, s0 = row0 < MC ? (row0 & ~(SEQC - 1)) : MC + ((row0 - MC) & ~(SEQL - 1)), L = row0 < MC ? SEQC : SEQL;
#pragma unroll 1
        for (int grp = 0; grp < 2; ++grp) {
            const int p0 = row0 - s0 + 8 * grp;
            float x0[38], x1[38];
#pragma unroll
            for (int q = 0; q < 38; ++q) { const int p = p0 - 15 + q; unsigned xw = 0u; if (p >= 0 && p < L) xw = *(const unsigned*)(GLU + (size_t)(s0 + p) * DCA + 2 * tid); x0[q] = bflo(xw); x1[q] = bfhi(xw); }
            float a0[8], a1[8];
#pragma unroll
            for (int r = 0; r < 8; ++r) { float s_0 = b0, s_1 = b1;
#pragma unroll
                for (int t = 0; t < 31; ++t) { s_0 += x0[r + t] * wv0[t]; s_1 += x1[r + t] * wv1[t]; }
                a0[r] = s_0; a1[r] = s_1; part[r * 512 + tid] = s_0 * s_0 + s_1 * s_1; }
            __syncthreads();
            { float v = 0.f;
#pragma unroll
              for (int k = 0; k < 8; ++k) v += part[wid * 512 + lane + 64 * k];
              v = wave_sum(v); if (lane == 0) rs[wid] = rsqrtf(v * (1.f / DCA) + EPS); }
            __syncthreads();
#pragma unroll
            for (int r = 0; r < 8; ++r) { const float rr = rs[r];
                *(unsigned*)(CA + (size_t)(row0 + 8 * grp + r) * ABR_LD + 2 * tid) = pk2(silu_acc(a0[r] * rr * g0), silu_acc(a1[r] * rr * g1)); }
        }
    }
    __syncthreads();
}
__device__ __forceinline__ void conv_b_phase(const bf16* BG, const bf16* CX, const float* w, bf16* CB, int vcu, int G, int row_lo, int row_hi) {
    const int gt = vcu * NTHR + fresh_tid(), NT = G * NTHR;
    for (int idx = row_lo * (DCA / 8) + gt; idx < row_hi * (DCA / 8); idx += NT) {
        const int m = idx >> 7, c8 = (idx & 127) * 8;
        const int s0 = m < MC ? (m & ~(SEQC - 1)) : MC + ((m - MC) & ~(SEQL - 1)), L = m < MC ? SEQC : SEQL, pos = m - s0;
        f32x4 aa = {0.f, 0.f, 0.f, 0.f}, ab = {0.f, 0.f, 0.f, 0.f};
#pragma unroll
        for (int t = 0; t < 3; ++t) { const int p = pos + t - 1;
            if (p >= 0 && p < L) { const v4u xw = *(const v4u*)(CX + (size_t)(s0 + p) * DCA + c8); const f32x4 wa = *(const f32x4*)(w + t * DCA + c8), wb = *(const f32x4*)(w + t * DCA + c8 + 4);
                aa[0] += bflo(xw.x) * wa[0]; aa[1] += bfhi(xw.x) * wa[1]; aa[2] += bflo(xw.y) * wa[2]; aa[3] += bfhi(xw.y) * wa[3];
                ab[0] += bflo(xw.z) * wb[0]; ab[1] += bfhi(xw.z) * wb[1]; ab[2] += bflo(xw.w) * wb[2]; ab[3] += bfhi(xw.w) * wb[3]; } }
        const v4u bw = *(const v4u*)(BG + (size_t)m * DCA + c8);
        v4u o; o.x = pk2(bflo(bw.x) * aa[0], bfhi(bw.x) * aa[1]); o.y = pk2(bflo(bw.y) * aa[2], bfhi(bw.y) * aa[3]); o.z = pk2(bflo(bw.z) * ab[0], bfhi(bw.z) * ab[1]); o.w = pk2(bflo(bw.w) * ab[2], bfhi(bw.w) * ab[3]);
        *(v4u*)(CB + (size_t)m * ABR_LD + c8) = o;
    }
}
__device__ __forceinline__ void attn_lat_phase(const bf16* Qb, const bf16* Kb, const bf16* Vb, const bf16* CK, const bf16* CV, const float* sink, bf16* ATT, int layer, int bx, int vcu, int G, unsigned char* lds) {
    const bool deal = G == 256; const int x = bx & 7, r = bx >> 3;
    const int cnt = deal ? (r >= 16 ? 3 : 1) : (512 - vcu + G - 1) / G;
    for (int i = 0; i < cnt; ++i) {
        const int u = deal ? x * 64 + (r >= 16 ? (r - 16) * 3 + i : 48 + r) : vcu + i * G;
        const int b = u >> 8, kvh = (u >> 6) & 3, tb = u & 63;
        const int lo = tb < 2 ? -tb : -2, hi = tb > 61 ? 63 - tb : 2, NT = 8 + (hi - lo + 1);
        const size_t seq0 = (size_t)MC + (size_t)b * SEQL, q0 = seq0 + 64 * tb, c0 = (size_t)(b * 2 + layer) * PAST;
        att::attn_unit(Qb + q0 * D + kvh * 512, CK + c0 * KVD + kvh * 128, CV + c0 * KVD + kvh * 128,
                       Kb + (seq0 + 64 * (tb + lo)) * KVD + kvh * 128, Vb + (seq0 + 64 * (tb + lo)) * KVD + kvh * 128,
                       8, NT, lo == -2 ? 8 : -1, hi == 2 ? NT - 1 : -1, sink + kvh * 4, ATT + q0 * ABR_LD + kvh * 512, ABR_LD, (char*)lds);
    }
}
__device__ __forceinline__ void attn_ctx_phase(const bf16* Qb, const bf16* Kb, const bf16* Vb, const float* sink, bf16* ATT, int vcu, int G, unsigned char* lds) {
    for (int u = vcu; u < 256; u += G) {
        const int b = u >> 4, kvh = (u >> 2) & 3, qb = u & 3;
        const size_t seq0 = (size_t)b * SEQC, q0 = seq0 + 64 * qb;
        att::attn_unit(Qb + q0 * D + kvh * 512, Kb, Vb, Kb + seq0 * KVD + kvh * 128, Vb + seq0 * KVD + kvh * 128, 0, 4, -1, -1, sink + kvh * 4, ATT + q0 * ABR_LD + kvh * 512, ABR_LD, (char*)lds);
    }
}

#define P_MOD   ((float*)(ws + WS_MOD))
#define P_CK    ((bf16*)(ws + WS_CK))
#define P_CV    ((bf16*)(ws + WS_CV))
#define P_X     ((float*)(ws + WS_X))
#define P_H     ((bf16*)(ws + WS_H))
#define P_ACT   ((bf16*)(ws + WS_ACT))
#define P_Q     ((bf16*)(ws + WS_Q))
#define P_K     ((bf16*)(ws + WS_K))
#define P_V     ((bf16*)(ws + WS_V))
#define P_GLU   ((bf16*)(ws + WS_GLU))
#define P_BG    ((bf16*)(ws + WS_BG))
#define P_CX    ((bf16*)(ws + WS_CX))
#define P_GATES ((bf16*)(ws + WS_GATES))
#define P_ABR   ((bf16*)(ws + WS_ABR))
#define P_ATT   (P_ABR + ABR_ATT)
#define P_CA    (P_ABR + ABR_CA)
#define P_CB    (P_ABR + ABR_CB)
#define P_MIX   ((bf16*)(ws + WS_MIX))
#define P_MODL  (P_MOD + (size_t)l * 3 * NMOD)
#define P_WL(off) ((const bf16*)(ws + WS_WT + (size_t)l * WT_LAYER + (off)))
__global__ void __launch_bounds__(NTHR, 2) fwd(Args args) {
    extern __shared__ __attribute__((aligned(16))) unsigned char lds[];
    const int tid = threadIdx.x;
    const int G0 = gridDim.x, bx = blockIdx.x, vcu0 = (G0 % 8 == 0) ? (bx % 8) * (G0 / 8) + bx / 8 : bx;
    LAS unsigned char* ldsl = (LAS unsigned char*)lds;
    volatile LAS unsigned* MISC = (volatile LAS unsigned*)(ldsl + MISC_OFF);
    for (int u = tid; u < (LDS_BYTES - LDSCTL_OFF) / 4; u += NTHR) ((LAS unsigned*)(ldsl + LDSCTL_OFF))[u] = 0u;
    __syncthreads();
    unsigned* barw = (unsigned*)(args.ws + WS_CTL) + CW_BAR;
    XcdBarrier bar; bar.bar = barw; bar.x = 0; bar.st = nullptr;
    if (!MK_PER_PHASE) bar = xcd_barrier_post(barw, MISC + 8);
#if MK_PER_PHASE
    const int lo = args.ph_lo, hi = args.ph_hi;
#define IN(k) (lo <= (k) && (k) < hi)
#else
#define IN(k) true
#endif
#ifndef DUP_PHASE
#define DUP_PHASE (-1)
#endif
#define PH_BEGIN const Args* A_ = fresh_args(); unsigned char* ws = A_->ws; (void)ws; const int vcu = fresh_i(vcu0), G = fresh_i(G0); (void)vcu; (void)G
#define FILL_JOB(j) ((l == 0 && (((FILL_MASK) >> (j)) & 1)) ? (j) : 0)
#define RUN_GEMM(EpiT, Eobj, Aptr, Bptr, N_, K_, LDA_, LDB_, kind_, job_) do { pg8::Gemm g{Aptr, Bptr, M, N_, K_}; typedef pg8::TailOrder<M, N_, K_, (((HT_MASK) >> (kind_)) & 1) != 0> SO_; SO_ S; S.init(fresh_i(G), fresh_i(bx)); \
        pg8::gemm_phase_ht<EpiT, SO_, K_, LDA_, LDB_>(ldsl + RING_OFF, g, S, Eobj); \
        { const int job__ = (job_); if (job__ > 0) { constexpr int nwg__ = (M / 256) * ((N_) / 256); const int G__ = fresh_i(G), bx__ = fresh_i(bx), Rem__ = nwg__ - (nwg__ / G__) * G__; \
            if (bx__ >= Rem__) filler(*fresh_args(), lds, job__, bx__ - Rem__, G__ - Rem__); } } } while (0)
#ifdef XTRA_BAR
#define XTRA_BAR_STMT xcd_barrier(bb_);
#else
#define XTRA_BAR_STMT
#endif
#ifndef HT_MASK
#define HT_MASK 0
#endif
#define REP(k) for (int rep_ = 0; rep_ < ((DUP_PHASE == (k)) ? 2 : 1); ++rep_)
#define SEAM(k) do { if (!MK_PER_PHASE && IN(k) && IN((k) + 1)) { XcdBarrier bb_ = bar; bb_.x = (unsigned)fresh_i((int)bar.x); bb_.bar = (unsigned*)(fresh_args()->ws + WS_CTL) + CW_BAR; xcd_barrier(bb_); XTRA_BAR_STMT } } while (0)

#define RUN_GEMM_D(EpiT, Eobj, Aptr, Bptr, N_, K_, LDA_, LDB_, PM0_, NML_, R_, KA_, KB_) do { pg8::Gemm g{Aptr, Bptr, M, N_, K_}; typedef pg8::DealOrder<N_, PM0_, NML_, R_, KA_, KB_> SO_; SO_ S; S.init(fresh_i(G), fresh_i(bx)); \
        pg8::gemm_phase_ht<EpiT, SO_, K_, LDA_, LDB_>(ldsl + RING_OFF, g, S, Eobj); } while (0)
#define NORM_C(sub_, gin_, lc) { PH_BEGIN; norm_phase<false>(P_X, A_->in[gin_] + (lc) * D, P_MOD + (size_t)(lc) * 3 * NMOD, sub_, P_H, nullptr, vcu, G, 0, MC); }
#define NORM_L(sub_, gin_, ll) { PH_BEGIN; norm_phase<false>(P_X, A_->in[gin_] + (ll) * D, P_MOD + (size_t)(ll) * 3 * NMOD, sub_, P_H, nullptr, vcu, G, MC, M); }
#define WLY(lx, off) ((const bf16*)(ws + WS_WT + (size_t)(lx) * WT_LAYER + (off)))
#define MODLY(lx) (P_MOD + (size_t)(lx) * 3 * NMOD)
    if (IN(0)) REP(0) { prologue(*fresh_args(), lds, vcu0, G0); } SEAM(0);
    if (IN(1)) NORM_C(0, 8, 0)
    SEAM(1);
    for (int l = 0; l < 2; ++l) {
        const int pb = 2 + 12 * l;
        if (IN(pb + 0)) { NORM_L(0, 8, l)
            { PH_BEGIN; pg8::EpiSwiglu E{P_ACT, ACT_LD}; RUN_GEMM_D(pg8::EpiSwiglu, E, P_H, WLY(l, WT_1I), 2 * DFF, D, H_LD, WK_D, 0, 16, 24, 3, 2); } }
        SEAM(pb + 0);
        if (IN(pb + 1)) {
            { PH_BEGIN; pg8::EpiResid E{P_X, MODLY(l) + 2 * D, 0.5f}; RUN_GEMM_D(pg8::EpiResid, E, P_ACT, WLY(l, WT_1O), D, DFF, ACT_LD, WK_FF, 0, 16, 16, 1, 0); }
            { PH_BEGIN; pg8::EpiSwiglu E{P_ACT, ACT_LD}; RUN_GEMM_D(pg8::EpiSwiglu, E, P_H, WLY(l, WT_1I), 2 * DFF, D, H_LD, WK_D, 16, 32, 16, 4, 7); } }
        SEAM(pb + 1);
        if (IN(pb + 2)) { NORM_C(1, 11, l)
            { PH_BEGIN; pg8::EpiResid E{P_X, MODLY(l) + 2 * D, 0.5f}; RUN_GEMM_D(pg8::EpiResid, E, P_ACT, WLY(l, WT_1O), D, DFF, ACT_LD, WK_FF, 16, 32, 16, 1, 1); } }
        SEAM(pb + 2);
        if (IN(pb + 3)) {
            { PH_BEGIN; pg8::EpiWin E{ws, A_->out, l}; RUN_GEMM_D(pg8::EpiWin, E, P_H, WLY(l, WT_IN), INC, D, H_LD, WK_D, 0, 16, 16, 4, 3); }
            { PH_BEGIN; const int r_ = bx >> 3; if (G != 256) norm_phase<false>(P_X, A_->in[11] + l * D, MODLY(l), 1, P_H, nullptr, vcu, G, MC, M);
              else if (r_ >= 16) norm_phase<false>(P_X, A_->in[11] + l * D, MODLY(l), 1, P_H, nullptr, (r_ - 16) * 8 + (bx & 7), 128, MC, M); } }
        SEAM(pb + 3);
        if (IN(pb + 4)) {
            { PH_BEGIN; attn_ctx_phase(P_Q, P_K, P_V, A_->in[13] + l * 16, P_ATT, vcu, G, lds); }
            { PH_BEGIN; conv_a_phase(P_GLU, A_->in[15] + (size_t)l * 31 * DCA, A_->in[16] + l * DCA, A_->in[17] + l * DCA, P_CA, vcu, G, lds, 0, MC / 16); }
            { PH_BEGIN; conv_b_phase(P_BG, P_CX, A_->in[19] + (size_t)l * 3 * DCA, P_CB, vcu, G, 0, MC); } }
        SEAM(pb + 4);
        if (IN(pb + 5)) {
            { PH_BEGIN; pg8::EpiMixK E{P_MIX, P_GATES}; RUN_GEMM_D(pg8::EpiMixK, E, P_ABR, WLY(l, WT_MIXB), D, ABR_K, ABR_LD, WK_MIX, 0, 16, 16, 1, 0); }
            { PH_BEGIN; pg8::EpiWin E{ws, A_->out, l}; RUN_GEMM_D(pg8::EpiWin, E, P_H, WLY(l, WT_IN), INC, D, H_LD, WK_D, 16, 32, 16, 6, 8); } }
        SEAM(pb + 5);
        if (IN(pb + 6)) {
            { PH_BEGIN; pg8::EpiResid E{P_X, MODLY(l) + 5 * D, 1.0f}; RUN_GEMM_D(pg8::EpiResid, E, P_MIX, WLY(l, WT_OUT), D, D, MIX_LD, WK_D, 0, 16, 16, 1, 0); }
            { PH_BEGIN; attn_lat_phase(P_Q, P_K, P_V, P_CK, P_CV, A_->in[13] + l * 16, P_ATT, l, bx, vcu, G, lds); }
            { PH_BEGIN; const int r_ = bx >> 3; const bool all_ = G != 256;
              if (all_ || r_ < 16) { const int pi = all_ ? vcu : r_ * 8 + (bx & 7), np = all_ ? G : 128;
                conv_a_phase(P_GLU, A_->in[15] + (size_t)l * 31 * DCA, A_->in[16] + l * DCA, A_->in[17] + l * DCA, P_CA, pi, np, lds, MC / 16, M / 16);
                conv_b_phase(P_BG, P_CX, A_->in[19] + (size_t)l * 3 * DCA, P_CB, pi, np, MC, M); } } }
        SEAM(pb + 6);
        if (IN(pb + 7)) { PH_BEGIN; pg8::EpiMixK E{P_MIX, P_GATES}; RUN_GEMM_D(pg8::EpiMixK, E, P_ABR, WLY(l, WT_MIXB), D, ABR_K, ABR_LD, WK_MIX, 16, 32, 16, 1, 1); }
        SEAM(pb + 7);
        if (IN(pb + 8)) { NORM_C(2, 22, l)
            { PH_BEGIN; pg8::EpiResid E{P_X, MODLY(l) + 5 * D, 1.0f}; RUN_GEMM_D(pg8::EpiResid, E, P_MIX, WLY(l, WT_OUT), D, D, MIX_LD, WK_D, 16, 32, 16, 1, 1); } }
        SEAM(pb + 8);
        if (IN(pb + 9)) { NORM_L(2, 22, l)
            { PH_BEGIN; pg8::EpiSwiglu E{P_ACT, ACT_LD}; RUN_GEMM_D(pg8::EpiSwiglu, E, P_H, WLY(l, WT_2I), 2 * DFF, D, H_LD, WK_D, 0, 16, 24, 3, 2); } }
        SEAM(pb + 9);
        if (IN(pb + 10)) {
            { PH_BEGIN; pg8::EpiResid E{P_X, MODLY(l) + 8 * D, 0.5f}; RUN_GEMM_D(pg8::EpiResid, E, P_ACT, WLY(l, WT_2O), D, DFF, ACT_LD, WK_FF, 0, 16, 16, 1, 0); }
            { PH_BEGIN; pg8::EpiSwiglu E{P_ACT, ACT_LD}; RUN_GEMM_D(pg8::EpiSwiglu, E, P_H, WLY(l, WT_2I), 2 * DFF, D, H_LD, WK_D, 16, 32, 16, 4, 7); } }
        SEAM(pb + 10);
        if (IN(pb + 11)) {
            if (l == 0) NORM_C(0, 8, 1)
            else { PH_BEGIN; norm_phase<true>(P_X, A_->in[25], nullptr, 0, nullptr, A_->out, vcu, G, 0, MC); }
            { PH_BEGIN; pg8::EpiResid E{P_X, MODLY(l) + 8 * D, 0.5f}; RUN_GEMM_D(pg8::EpiResid, E, P_ACT, WLY(l, WT_2O), D, DFF, ACT_LD, WK_FF, 16, 32, 16, 1, 1); } }
        SEAM(pb + 11);
    }
    if (IN(26)) { PH_BEGIN; norm_phase<true>(P_X, A_->in[25], nullptr, 0, nullptr, A_->out, vcu, G, MC, M); }
#undef IN
#undef SEAM
}

extern "C" void kernel_launch(void* const* d_in, const int* in_sizes, int n_in, void* d_out, int out_size, void* d_ws, size_t ws_size, hipStream_t stream) {
    static int grid = 0;
    if (grid == 0) {
        if (n_in != 26 || ws_size < WS_END) { fprintf(stderr, "kernel_launch: built for 26 inputs and >= %zu bytes of workspace; got n_in %d, ws %zu; nothing launched\n", (size_t)WS_END, n_in, ws_size); grid = -1; return; }
        int dev = 0, cus = 0, per_cu = 0;
        if (hipGetDevice(&dev) != hipSuccess || hipDeviceGetAttribute(&cus, hipDeviceAttributeMultiprocessorCount, dev) != hipSuccess) { fprintf(stderr, "kernel_launch: device query failed\n"); grid = -1; return; }
        if (hipFuncSetAttribute((const void*)fwd, hipFuncAttributeMaxDynamicSharedMemorySize, LDS_BYTES) != hipSuccess) { fprintf(stderr, "kernel_launch: hipFuncSetAttribute failed\n"); grid = -1; return; }
        if (hipOccupancyMaxActiveBlocksPerMultiprocessor(&per_cu, (const void*)fwd, NTHR, LDS_BYTES) != hipSuccess || per_cu < 1)
            fprintf(stderr, "kernel_launch: note: occupancy query reports %d workgroups per CU\n", per_cu);
        (void)hipGetLastError();
        grid = cus;
    }
    if (grid < 0) return;
    if (hipMemsetAsync((char*)d_ws + WS_CTL, 0, CTL_ZERO_BYTES, stream) != hipSuccess) { fprintf(stderr, "kernel_launch: hipMemsetAsync failed\n"); return; }
    Args a{};
    for (int i = 0; i < 26; ++i) a.in[i] = (const float*)d_in[i];
    a.out = (float*)d_out; a.ws = (unsigned char*)d_ws;
#if MK_PER_PHASE
    for (int p = 0; p < N_PHASES; ++p) { a.ph_lo = p; a.ph_hi = p + 1; hipLaunchKernelGGL(fwd, dim3(grid), dim3(NTHR), LDS_BYTES, stream, a); }
#else
    a.ph_lo = 0; a.ph_hi = N_PHASES; hipLaunchKernelGGL(fwd, dim3(grid), dim3(NTHR), LDS_BYTES, stream, a);
#endif
    const hipError_t le = hipPeekAtLastError();
    if (le != hipSuccess) fprintf(stderr, "kernel_launch: launch failed: %s\n", hipGetErrorName(le));
}
```

```cpp
#include <hip/hip_runtime.h>
#include <cstdio>
#include <cstdint>

#ifndef MK_PER_PHASE
#define MK_PER_PHASE 0
#endif
constexpr int D = 2048, MC = 4096, ML = 8192, M = MC + ML, DFF = 5632, NMOD = 9 * D, INC = 14336;
constexpr int SEQC = 256, SEQL = 4096, PAST = 512, KVD = 512, DCA = 1024;
constexpr float EPS = 1e-6f;
constexpr size_t MiB = 1u << 20;
#ifndef ROW_PAD
#define ROW_PAD 64
#endif
constexpr int PADE = ROW_PAD;
constexpr int H_LD = D + PADE, ACT_LD = DFF + PADE, MIX_LD = D + PADE, ABR_K = 4096, ABR_LD = ABR_K + PADE, ABR_CA = 0, ABR_CB = 1024, ABR_ATT = 2048;
constexpr int WK_D = D + PADE, WK_FF = DFF + PADE, WK_MIX = ABR_K + PADE;
constexpr size_t WS_CTL = 0, CTL_ZERO_BYTES = 1 * MiB;
constexpr size_t WS_MOD = 1 * MiB, WS_ROPE = 2 * MiB, WS_CK = 3 * MiB, WS_CV = 5 * MiB, WS_X = 8 * MiB, WS_H = 104 * MiB;
constexpr size_t WS_ACT = 154 * MiB;
constexpr size_t WS_Q = 154 * MiB, WS_K = 202 * MiB, WS_V = 214 * MiB, WS_GLU = 226 * MiB, WS_BG = 250 * MiB, WS_CX = 274 * MiB, WS_GATES = 298 * MiB;
constexpr size_t WS_ABR = 442 * MiB, WS_MIX = 540 * MiB;
constexpr size_t WS_WT = 590 * MiB, WT_LAYER = 222 * MiB;
constexpr size_t WT_1I = 0, WT_1O = 46 * MiB, WT_IN = 69 * MiB, WT_MIXB = 127 * MiB  , WT_OUT = 144 * MiB, WT_2I = 153 * MiB, WT_2O = 199 * MiB;
constexpr size_t WS_END = WS_WT + 2 * WT_LAYER;
static_assert((size_t)M * H_LD * 2 <= 50 * MiB && (size_t)M * ACT_LD * 2 <= 134 * MiB && (size_t)M * ABR_LD * 2 <= 98 * MiB && (size_t)M * MIX_LD * 2 <= 50 * MiB, "activation map");
static_assert((size_t)2 * DFF * WK_D * 2 <= 46 * MiB && (size_t)D * WK_FF * 2 <= 23 * MiB && (size_t)INC * WK_D * 2 <= 58 * MiB && (size_t)D * WK_MIX * 2 <= 17 * MiB && (size_t)D * WK_D * 2 <= 9 * MiB, "weight map");
constexpr int CW_Q = 32768;
constexpr int CW_BAR = 4096;

__device__ __forceinline__ size_t xt_off(int row, int col) { return ((size_t)((row >> 8) * (D / 256) + (col >> 8)) << 16) + (size_t)(((row & 255) << 8) + (col & 255)); }

__device__ __forceinline__ int fresh_tid() { int t = threadIdx.x; asm volatile("" : "+v"(t)); return t; }

__device__ __forceinline__ int fresh_i(int v) { asm volatile("" : "+s"(v)); return v; }
struct Args { const float* in[26]; float* out; unsigned char* ws; int ph_lo, ph_hi; };
__device__ __forceinline__ const Args* fresh_args() { auto p = __builtin_amdgcn_kernarg_segment_ptr(); asm volatile("" : "+s"(p)); return (const Args*)p; }

namespace pg8 {
#define PG8_LAS __attribute__((address_space(3)))
typedef unsigned short bf16_t;
typedef short bf16x8 __attribute__((ext_vector_type(8)));
typedef float f32x4 __attribute__((ext_vector_type(4)));
typedef unsigned u32x4 __attribute__((ext_vector_type(4)));
constexpr int BM = 256, BK = 64, HALF = 128, HTB = HALF * BK * 2  , STAGE_BYTES = 8 * HTB, NXCD = 8, WGM = 8;

__host__ __device__ __forceinline__ int lds_byte(int r, int c) { const int st = (r >> 4) * 2 + (c >> 5), rr = r & 15, cc = c & 31, ob = rr * 64 + cc * 2; return st * 1024 + (ob ^ (((ob >> 9) & 1) << 5)); }
__host__ __device__ __forceinline__ void stage_rc(int b, int& R, int& C) { const int st = b / 1024, sb = b % 1024, swz = sb ^ (((sb >> 9) & 1) << 5); R = (st >> 1) * 16 + swz / 64; C = (st & 1) * 32 + (swz % 64) / 2; }
__host__ __device__ __forceinline__ int perm32(int rho) { const int n = rho >> 4, i = rho & 15; return 8 * (i >> 2) + 4 * n + (i & 3); }

struct Unit { int pm, pn; };
struct Gemm { const bf16_t* A; const bf16_t* Bt; int M, N, K; int hit = 0, hitpm = 0; };

struct StaticOrder {
    int nM, nN, nwg, G, c;
    __host__ __device__ void init(int M, int N, int G_, int c_) { nM = M / BM; nN = N / BM; nwg = nM * nN; G = G_; c = c_; }
    __host__ __device__ bool next(int i, Unit& u) const {
        const long L = (long)i * G + c; if (L >= nwg) return false;
        int wgid = (int)L; { const int q = nwg / NXCD, r = nwg % NXCD, xcd = wgid % NXCD, off = wgid / NXCD; wgid = (xcd < r ? xcd * (q + 1) : r * (q + 1) + (xcd - r) * q) + off; }
        const int nig = WGM * nN, gid = wgid / nig, fm = gid * WGM, gsz = (nM - fm) < WGM ? (nM - fm) : WGM;
        u.pm = fm + ((wgid % nig) % gsz); u.pn = (wgid % nig) / gsz; return true;
    }
    __device__ __forceinline__ void a_ready(const Unit&) const {}
    __device__ __forceinline__ void done(const Unit&) const {}
};

__device__ __forceinline__ unsigned cvt_pk_bf16(float lo, float hi) { unsigned r; asm volatile("v_cvt_pk_bf16_f32 %0, %1, %2" : "=v"(r) : "v"(lo), "v"(hi)); return r; }
typedef float f32x2 __attribute__((ext_vector_type(2)));
__device__ __forceinline__ f32x2 gelu_pk(f32x2 v) {
    const f32x2 av = __builtin_elementwise_abs(v), d = av * 0.2316418882f + 1.0f;
    f32x2 t; t.x = __builtin_amdgcn_rcpf(d.x); t.y = __builtin_amdgcn_rcpf(d.y);
    f32x2 q = t * 0.5307027145f + (-0.7265760135f); q = q * t + 0.7107068705f; q = q * t + (-0.142248368f); q = q * t + 0.127414796f; q = q * t;
    const f32x2 s = (v * v) * (-0.72134752044f);
    f32x2 e; e.x = __builtin_amdgcn_exp2f(s.x); e.y = __builtin_amdgcn_exp2f(s.y);
    const f32x2 m = v * (q * e), r = v - m;
    f32x2 o; o.x = v.x < 0.f ? m.x : r.x; o.y = v.y < 0.f ? m.y : r.y; return o;
}

struct UnitK : Unit { int half, rofs; };
__device__ __forceinline__ float fsigm(float x) { return __builtin_amdgcn_rcpf(1.f + __builtin_amdgcn_exp2f(-1.4426950408889634f * x)); }
__device__ __forceinline__ float fsilu(float x) { return x * fsigm(x); }
__device__ __forceinline__ u32x4 pack8(f32x4 a, f32x4 b) { u32x4 w; w.x = cvt_pk_bf16(a[0], a[1]); w.y = cvt_pk_bf16(a[2], a[3]); w.z = cvt_pk_bf16(b[0], b[1]); w.w = cvt_pk_bf16(b[2], b[3]); return w; }
__device__ __forceinline__ void unpack8(u32x4 w, f32x4& a, f32x4& b) {
    a[0] = __builtin_bit_cast(float, w.x << 16); a[1] = __builtin_bit_cast(float, w.x & 0xffff0000u); a[2] = __builtin_bit_cast(float, w.y << 16); a[3] = __builtin_bit_cast(float, w.y & 0xffff0000u);
    b[0] = __builtin_bit_cast(float, w.z << 16); b[1] = __builtin_bit_cast(float, w.z & 0xffff0000u); b[2] = __builtin_bit_cast(float, w.w << 16); b[3] = __builtin_bit_cast(float, w.w & 0xffff0000u);
}
enum { PO_SWIGLU = 0, PO_GLU = 1, PO_MUL = 2 };
template <int OP> __device__ __forceinline__ f32x4 pair_op(f32x4 a, f32x4 b) {
    f32x4 o;
#pragma unroll
    for (int e = 0; e < 4; ++e) o[e] = OP == PO_SWIGLU ? fsilu(a[e]) * b[e] : (OP == PO_GLU ? a[e] * fsigm(b[e]) : a[e] * b[e]);
    return o;
}
__device__ __forceinline__ int gt_reg(int wr, int wc, int fr, int fq, int ai, int m, int bj) { return ((((((wr * 4 + wc) * 2 + ai) * 4 + m) * 2 + bj) << 6) + ((fq << 4) | fr)) << 3; }
__device__ __forceinline__ size_t gt_off(int stage, int pm, int pn) { return (size_t)((stage * (::M / 256) + pm) * 8 + pn) << 16; }
struct EpiSwiglu {
    static constexpr bool PERM = true, AFTER_DRAIN = false, RESCALE = false, PREFETCH = false;
    bf16_t* O; int ldc;
    __device__ __forceinline__ void operator()(const f32x4 (&acc)[2][2][4][2], const UnitK& u, int wr, int wc, int fr, int fq, PG8_LAS unsigned char* ldsb) const {
        const int row0 = u.pm * BM + u.rofs + wr * 64 + fr, col0 = u.pn * HALF + wc * 32 + 8 * fq;
#pragma unroll
        for (int ai = 0; ai < 2; ++ai) { if (ai == 1 && u.half) break;
#pragma unroll
            for (int m = 0; m < 4; ++m) {
                bf16_t* rowp = O + (size_t)(row0 + ai * HALF + m * 16) * ldc + col0;
                *(u32x4*)rowp = pack8(pair_op<PO_SWIGLU>(acc[ai][0][m][0], acc[ai][1][m][0]), pair_op<PO_SWIGLU>(acc[ai][0][m][1], acc[ai][1][m][1]));
            } }
    }
};
#ifndef RESID_BATCH
#define RESID_BATCH 4
#endif
#if defined(PROBE_HIT) && PROBE_HIT >= 2
#define RESID_PROBE 1
#else
#define RESID_PROBE 0
#endif
constexpr int EPI_T_OFF_ = 133120;
struct EpiResid {
    static constexpr bool PERM = true, AFTER_DRAIN = false, RESCALE = false, PREFETCH = false;
    float* X; const float* gate; const float* Xs; float coef; int xs_tiled;
    __device__ __forceinline__ void operator()(const f32x4 (&acc)[2][2][4][2], const UnitK& u, int wr, int wc, int fr, int fq, PG8_LAS unsigned char* ldsb) const {
        const int lane = (fq << 4) | fr, wv = wr * 4 + wc;
        PG8_LAS float* tw = (PG8_LAS float*)(ldsb + EPI_T_OFF_) + wv * 576;
        PG8_LAS float* twr = tw + fr * 36 + 8 * fq;
        const PG8_LAS float* trd = tw + (lane >> 3) * 36 + 4 * (lane & 7);
        const int cond = u.pm < 16 ? 0 : (u.pm < 32 ? 1 : 2);
        const int colT = u.pn * BM + wc * 32 + 4 * (lane & 7);
        f32x4 gT[2];
#pragma unroll
        for (int bj = 0; bj < 2; ++bj) gT[bj] = *(const f32x4*)(gate + (size_t)cond * NMOD + colT + bj * HALF) * coef;
        const int rloc = u.rofs + wr * 64 + (lane >> 3), cloc = wc * 32 + 4 * (lane & 7);
        const unsigned offX0 = (unsigned)(((((u.pm * (D / 256) + u.pn) << 16) + (rloc << 8) + cloc)) * 4);
        const unsigned offS0 = xs_tiled ? offX0 : (unsigned)(((u.pm * BM + rloc) * D + u.pn * BM + cloc) * 4);
        const unsigned rsS = xs_tiled ? 1024u : (unsigned)(D * 4); constexpr unsigned tsS = (unsigned)(HALF * 4);
        const char* Xsb = (const char*)Xs; char* Xb = (char*)X;
        f32x4 xq[4][2][2];
#define RESID_LD(q, gi) do { _Pragma("unroll") for (int bj = 0; bj < 2; ++bj) _Pragma("unroll") for (int h = 0; h < 2; ++h) \
            xq[q][bj][h] = *(const f32x4*)(Xsb + (size_t)(offS0 + (unsigned)(((gi) >> 2) * HALF + ((gi) & 3) * 16 + 8 * h) * rsS + (unsigned)bj * tsS)); } while (0)
        const int ngrp = u.half ? 4 : 8;
        RESID_LD(0, 0); RESID_LD(1, 1); RESID_LD(2, 2);
#pragma unroll
        for (int gi = 0; gi < 8; ++gi) { if (gi >= ngrp) break;
            const int ai = gi >> 2, m = gi & 3, q = gi & 3;
            if (gi + 3 < ngrp) RESID_LD((gi + 3) & 3, gi + 3);
#pragma unroll
            for (int bj = 0; bj < 2; ++bj) {
                *(PG8_LAS f32x4*)twr = acc[ai][bj][m][0]; *(PG8_LAS f32x4*)(twr + 4) = acc[ai][bj][m][1];
                asm volatile("" ::: "memory");
                f32x4 t0 = *(const PG8_LAS f32x4*)trd, t1 = *(const PG8_LAS f32x4*)(trd + 8 * 36);
                asm volatile("" ::: "memory");
                if (RESID_PROBE && coef == 0.f) { t0 = (f32x4){0.f, 0.f, 0.f, 0.f}; t1 = t0; }
                const f32x4 y0 = xq[q][bj][0] + gT[bj] * t0, y1 = xq[q][bj][1] + gT[bj] * t1;
                *(f32x4*)(Xb + (size_t)(offX0 + (unsigned)(((ai * HALF + m * 16) * 256 + bj * HALF) * 4))) = y0;
                *(f32x4*)(Xb + (size_t)(offX0 + (unsigned)(((ai * HALF + m * 16 + 8) * 256 + bj * HALF) * 4))) = y1; }
        }
#undef RESID_LD
    }
};
struct EpiWin {
    static constexpr bool PERM = true, AFTER_DRAIN = false, RESCALE = false, PREFETCH = false;
    unsigned char* ws; float* out; int layer;
    __device__ __forceinline__ void operator()(const f32x4 (&acc)[2][2][4][2], const UnitK& u, int wr, int wc, int fr, int fq, PG8_LAS unsigned char* ldsb) const {
        bf16_t* const Qb = (bf16_t*)(ws + WS_Q); bf16_t* const Kb = (bf16_t*)(ws + WS_K); bf16_t* const Vb = (bf16_t*)(ws + WS_V); bf16_t* const GLU = (bf16_t*)(ws + WS_GLU); bf16_t* const BG = (bf16_t*)(ws + WS_BG);
        bf16_t* const CX = (bf16_t*)(ws + WS_CX); bf16_t* const GATES = (bf16_t*)(ws + WS_GATES); const float* const rope = (const float*)(ws + WS_ROPE);
        float* const nk = out + (size_t)M * D; float* const nv = nk + (size_t)16 * 2 * SEQC * KVD;
        const int pn = u.pn, row0 = u.pm * BM + u.rofs + wr * 64 + fr, cw = wc * 32 + 8 * fq;
        const bool latent = u.pm >= 16;
        if (pn < 10) {
            const bool isq = pn < 8; const int hp = isq ? pn : pn - 8;
            const int ocol = (2 * hp + (wc >> 1)) * 128 + 64 * (wc & 1) + 8 * fq;
            bf16_t* base = isq ? Qb : Kb; const int ld = isq ? D : KVD;
#pragma unroll
            for (int ai = 0; ai < 2; ++ai) { if (ai == 1 && u.half) break;
#pragma unroll
                for (int m = 0; m < 4; ++m) {
                    const int row = row0 + ai * HALF + m * 16;
                    const f32x4 x1a = acc[ai][0][m][0], x1b = acc[ai][0][m][1], x2a = acc[ai][1][m][0], x2b = acc[ai][1][m][1];
                    f32x4 o1a = x1a, o1b = x1b, o2a = x2a, o2b = x2b;
                    if (latent) {
                        const int t = (row - MC) & (SEQL - 1), pos = (wc & 1) ? (t & 63) : (t >> 6);
                        const f32x4* rp = (const f32x4*)(rope + ((size_t)pos * 32 + 8 * fq) * 2);
                        const f32x4 r0 = rp[0], r1 = rp[1], r2 = rp[2], r3 = rp[3];
                        o1a[0] = x1a[0] * r0[0] - x2a[0] * r0[1]; o2a[0] = x2a[0] * r0[0] + x1a[0] * r0[1];
                        o1a[1] = x1a[1] * r0[2] - x2a[1] * r0[3]; o2a[1] = x2a[1] * r0[2] + x1a[1] * r0[3];
                        o1a[2] = x1a[2] * r1[0] - x2a[2] * r1[1]; o2a[2] = x2a[2] * r1[0] + x1a[2] * r1[1];
                        o1a[3] = x1a[3] * r1[2] - x2a[3] * r1[3]; o2a[3] = x2a[3] * r1[2] + x1a[3] * r1[3];
                        o1b[0] = x1b[0] * r2[0] - x2b[0] * r2[1]; o2b[0] = x2b[0] * r2[0] + x1b[0] * r2[1];
                        o1b[1] = x1b[1] * r2[2] - x2b[1] * r2[3]; o2b[1] = x2b[1] * r2[2] + x1b[1] * r2[3];
                        o1b[2] = x1b[2] * r3[0] - x2b[2] * r3[1]; o2b[2] = x2b[2] * r3[0] + x1b[2] * r3[1];
                        o1b[3] = x1b[3] * r3[2] - x2b[3] * r3[3]; o2b[3] = x2b[3] * r3[2] + x1b[3] * r3[3];
                    }
                    bf16_t* op = base + (size_t)row * ld + ocol;
                    *(u32x4*)op = pack8(o1a, o1b); *(u32x4*)(op + 32) = pack8(o2a, o2b);
                    if (!isq && !latent) { float* p = nk + ((size_t)((row >> 8) * 2 + layer) * SEQC + (row & 255)) * KVD + ocol;
                        *(f32x4*)p = x1a; *(f32x4*)(p + 4) = x1b; *(f32x4*)(p + 32) = x2a; *(f32x4*)(p + 36) = x2b; }
                } }
        } else if (pn < 12) {
#pragma unroll
            for (int ai = 0; ai < 2; ++ai) { if (ai == 1 && u.half) break;
#pragma unroll
                for (int m = 0; m < 4; ++m) {
                    const int row = row0 + ai * HALF + m * 16;
#pragma unroll
                    for (int bj = 0; bj < 2; ++bj) { const int col = (pn - 10) * BM + bj * HALF + cw;
                        *(u32x4*)(Vb + (size_t)row * KVD + col) = pack8(acc[ai][bj][m][0], acc[ai][bj][m][1]);
                        if (!latent) { float* p = nv + ((size_t)((row >> 8) * 2 + layer) * SEQC + (row & 255)) * KVD + col; *(f32x4*)p = acc[ai][bj][m][0]; *(f32x4*)(p + 4) = acc[ai][bj][m][1]; } }
                } }
        } else if (pn < 20 || (pn >= 24 && pn < 32)) {
            const bool glu = pn < 20; bf16_t* base = glu ? GLU : CX; const int col = (glu ? pn - 12 : pn - 24) * HALF + cw;
#pragma unroll
            for (int ai = 0; ai < 2; ++ai) { if (ai == 1 && u.half) break;
#pragma unroll
                for (int m = 0; m < 4; ++m) {
                    bf16_t* op = base + (size_t)(row0 + ai * HALF + m * 16) * DCA + col;
                    if (glu) *(u32x4*)op = pack8(pair_op<PO_GLU>(acc[ai][0][m][0], acc[ai][1][m][0]), pair_op<PO_GLU>(acc[ai][0][m][1], acc[ai][1][m][1]));
                    else     *(u32x4*)op = pack8(pair_op<PO_MUL>(acc[ai][0][m][0], acc[ai][1][m][0]), pair_op<PO_MUL>(acc[ai][0][m][1], acc[ai][1][m][1]));
                } }
        } else if (pn < 24) {
#pragma unroll
            for (int ai = 0; ai < 2; ++ai) { if (ai == 1 && u.half) break;
#pragma unroll
                for (int m = 0; m < 4; ++m)
#pragma unroll
                    for (int bj = 0; bj < 2; ++bj)
                        *(u32x4*)(BG + (size_t)(row0 + ai * HALF + m * 16) * DCA + (pn - 20) * BM + bj * HALF + cw) = pack8(acc[ai][bj][m][0], acc[ai][bj][m][1]); }
        } else {
#pragma unroll
            for (int ai = 0; ai < 2; ++ai) { if (ai == 1 && u.half) break;
#pragma unroll
                for (int m = 0; m < 4; ++m)
#pragma unroll
                    for (int bj = 0; bj < 2; ++bj) { f32x4 a = acc[ai][bj][m][0], b = acc[ai][bj][m][1];
#pragma unroll
                        for (int e = 0; e < 4; ++e) { a[e] = fmaxf(fsigm(a[e]), 1e-20f); b[e] = fmaxf(fsigm(b[e]), 1e-20f); }
                        *(u32x4*)(GATES + gt_off((pn - 32) >> 3, u.pm, (pn - 32) & 7) + gt_reg(wr, wc, fr, fq, ai, m, bj)) = pack8(a, b); } }
        }
    }
};
struct EpiMixK {
    static constexpr bool PERM = true, AFTER_DRAIN = false, RESCALE = true, PREFETCH = false;
    bf16_t* MIX; const bf16_t* GATES;
    __device__ __forceinline__ void rescale(f32x4 (&acc)[2][2][4][2], const UnitK& u, int stage, int wr, int wc, int fr, int fq) const {
        const int row0 = u.pm * BM + u.rofs + wr * 64 + fr, col0 = u.pn * BM + wc * 32 + 8 * fq;
#pragma unroll
        for (int ai = 0; ai < 2; ++ai) { if (ai == 1 && u.half) break;
            u32x4 gn[4][2], gd[4][2];
#pragma unroll
            for (int m = 0; m < 4; ++m) {
                const bf16_t* gp = GATES + gt_off(stage, u.pm, u.pn);
#pragma unroll
                for (int bj = 0; bj < 2; ++bj) { gn[m][bj] = *(const u32x4*)(gp + gt_reg(wr, wc, fr, fq, ai, m, bj)); gd[m][bj] = *(const u32x4*)(gp + gt_off(1, 0, 0) + gt_reg(wr, wc, fr, fq, ai, m, bj)); } }
            __builtin_amdgcn_sched_barrier(0);
#pragma unroll
            for (int m = 0; m < 4; ++m)
#pragma unroll
                for (int bj = 0; bj < 2; ++bj) { f32x4 na, nb, da, db; unpack8(gn[m][bj], na, nb); unpack8(gd[m][bj], da, db);
#pragma unroll
                    for (int e_ = 0; e_ < 4; ++e_) { acc[ai][bj][m][0][e_] *= na[e_] * __builtin_amdgcn_rcpf(da[e_]); acc[ai][bj][m][1][e_] *= nb[e_] * __builtin_amdgcn_rcpf(db[e_]); } }
        }
    }
    __device__ __forceinline__ void operator()(const f32x4 (&acc)[2][2][4][2], const UnitK& u, int wr, int wc, int fr, int fq, PG8_LAS unsigned char* ldsb) const {
        const int row0 = u.pm * BM + u.rofs + wr * 64 + fr, col0 = u.pn * BM + wc * 32 + 8 * fq;
#pragma unroll
        for (int ai = 0; ai < 2; ++ai) { if (ai == 1 && u.half) break;
            u32x4 gc[4][2];
#pragma unroll
            for (int m = 0; m < 4; ++m)
#pragma unroll
                for (int bj = 0; bj < 2; ++bj) gc[m][bj] = *(const u32x4*)(GATES + gt_off(2, u.pm, u.pn) + gt_reg(wr, wc, fr, fq, ai, m, bj));
            __builtin_amdgcn_sched_barrier(0);
#pragma unroll
            for (int m = 0; m < 4; ++m) {
                const size_t row = (size_t)(row0 + ai * HALF + m * 16);
#pragma unroll
                for (int bj = 0; bj < 2; ++bj) { const int col = col0 + bj * HALF;
                    f32x4 ga, gb; unpack8(gc[m][bj], ga, gb);
                    *(u32x4*)(MIX + row * MIX_LD + col) = pack8(ga * acc[ai][bj][m][0], gb * acc[ai][bj][m][1]); }
            } }
    }
};

template <int MM, int NN, int KK, bool HT> struct TailOrder {
    static constexpr bool QUEUE = false;
    static constexpr int nM = MM / BM, nN = NN / BM, nwg = nM * nN;
    int G, c;
    __device__ __forceinline__ void init(int G_, int c_) { G = G_; c = c_; }
    __device__ __forceinline__ void map(int L, UnitK& u) const {
        int wgid = L; { constexpr int q = nwg / NXCD, r = nwg % NXCD; const int xcd = wgid % NXCD, off = wgid / NXCD; wgid = (xcd < r ? xcd * (q + 1) : r * (q + 1) + (xcd - r) * q) + off; }
        constexpr int nig = WGM * nN; const int gid = wgid / nig, fm = gid * WGM, gsz = (nM - fm) < WGM ? (nM - fm) : WGM;
        u.pm = fm + ((wgid % nig) % gsz); u.pn = (wgid % nig) / gsz; }
    __device__ __forceinline__ bool next(int i, UnitK& u) const {
        const int F = nwg / G, Rem = nwg - F * G;
        const int s0 = Rem > 0 ? G / Rem : 1; const int s = (HT && Rem > 0 && (G % 8 == 0) && (G % Rem == 0) && ((G / 8) % s0 == 0) && s0 >= 2) ? s0 : 1;
        const bool ht = s > 1; const int x = c & 7, y = c >> 3, q = ht ? y % s : 0;
        const bool tail = i == F;
        const bool has = i < F || (tail && (ht ? q < 2 : c < Rem));
        if (i > F || !has) return false;
        const int L = (tail && ht) ? F * G + x + 8 * (y / s) : i * G + c;
        map(L, u); u.half = (tail && ht) ? 1 : 0; u.rofs = (tail && ht) ? 128 * q : 0;
        return true; }
    __device__ __forceinline__ void a_ready(const Unit&) const {}
    __device__ __forceinline__ void done(const Unit&) const {}
};

template <int NN, int PM0, int NML, int R, int KA, int KB, bool PNMIX = false> struct DealOrder {
    static constexpr bool QUEUE = false;
    static constexpr int nN = NN / BM, U = NML * nN, Q = U / 8;
    static_assert(NML % 8 == 0 && R * KA + (32 - R) * KB == Q, "DealOrder: the per-rank counts must cover the XCD chunk exactly");
    int G, c;
    __device__ __forceinline__ void init(int G_, int c_) { G = G_; c = c_; }
    __device__ __forceinline__ bool next(int i, UnitK& u) const {
        const bool grid_ok = G == 256; const int x = c & 7, r = c >> 3;
        const int cnt = grid_ok ? (r < R ? KA : KB) : (U - c + G - 1) / G;
        if (i >= cnt) return false;
        constexpr int lo = KA < KB ? KA : KB;
        const int idx = i < lo ? i * 32 + r : (KA > KB ? lo * 32 + (i - lo) * R + r : lo * 32 + (i - lo) * (32 - R) + (r - R));
        const int L = grid_ok ? x * Q + idx : i * G + c;
        constexpr int nig = 8 * nN; const int gid = L / nig, rem = L % nig;
        const int pj = rem >> 3;
        u.pm = PM0 + gid * 8 + (rem & 7); u.pn = PNMIX ? ((pj & 1) ? nN / 2 + (pj >> 1) : (pj >> 1)) : pj; u.half = 0; u.rofs = 0;
        return true; }
    __device__ __forceinline__ void a_ready(const Unit&) const {}
    __device__ __forceinline__ void done(const Unit&) const {}
};

#ifndef B_AUX
#define B_AUX 0
#endif
#define QGRP_C_DEFAULT 4
#ifndef QGRP_C
#define QGRP_C QGRP_C_DEFAULT
#endif
#ifndef QGRP
#define QGRP 4
#endif
template <int NN, int PM0, int NML, int TYPE, bool PNMIX = false> struct QueueOrder {
    static constexpr bool QUEUE = true;
    static constexpr int nN = NN / BM, U = NML * nN, Q = U / 8;
    static_assert(NML % 8 == 0 && NML % QGRP == 0 && 16 % QGRP_C == 0, "QueueOrder: whole panel groups");
    int G, c; unsigned* head;
    __device__ __forceinline__ void init(int G_, int c_, unsigned* head_) { G = G_; c = c_; head = head_; }
    __device__ __forceinline__ bool dynamic() const { return G == 256 && Q > 32; }
    __device__ __forceinline__ void decode(int L, UnitK& u) const {
        constexpr int GRP = (NML == 16) ? QGRP_C : QGRP; constexpr int nig = GRP * nN; const int gid = L / nig, rem = L % nig; int pj = rem / GRP;
#ifdef USE_STAGGER
        if (Q % nig == 0) { pj += (c & 7) * (nN / 8); if (pj >= nN) pj -= nN; }
#endif
        u.pm = PM0 + gid * GRP + (rem % GRP); u.pn = PNMIX ? ((pj & 1) ? nN / 2 + (pj >> 1) : (pj >> 1)) : pj; u.half = 0; u.rofs = 0; }
    __device__ __forceinline__ bool first(UnitK& u) const {
        if (G != 256) { if (c >= U) return false; decode(c, u); return true; }
        const int x = c & 7, r = c >> 3, idx = TYPE == 0 ? r : (r >= 16 ? r - 16 : r + 16);
        if (idx >= Q) return false; decode(x * Q + idx, u); return true; }
    __device__ __forceinline__ unsigned* ticket_word() const { return head + 64 * (c & 7); }
    __device__ __forceinline__ bool later(int i, unsigned ticket, UnitK& u) const {
        if (G != 256) { const long L = (long)i * G + c; if (L >= U) return false; decode((int)L, u); return true; }
        if (!dynamic()) return false;
        const int idx = 32 + (int)ticket; if (idx >= Q) return false; decode((c & 7) * Q + idx, u); return true; }
    __device__ __forceinline__ void a_ready(const Unit&) const {}
    __device__ __forceinline__ void done(const Unit&) const {}
};
template <class Epi, class Sched, int KK, int LDA, int LDB>
__device__ __forceinline__ void gemm_phase_ht(PG8_LAS unsigned char* lds, const Gemm g, const Sched& S, const Epi& E) {
#ifdef NO_SP2
    constexpr bool ALIGN_EPI = true, SP2 = false;
#else
    constexpr bool ALIGN_EPI = true, SP2 = true;
#endif
    const int tid = fresh_tid(), wid = __builtin_amdgcn_readfirstlane(tid >> 6), lane = tid & 63, wr = wid >> 2, wc = wid & 3, fr = lane & 15, fq = lane >> 4;
    constexpr int K = KK, nt = K / BK;
    unsigned voffA[2], voffB[2];
#pragma unroll
    for (int i = 0; i < 2; ++i) { int R, C; stage_rc(tid * 16 + i * 8192, R, C); const int Rb = Epi::PERM ? ((R & ~31) + perm32(R & 31)) : R;
        voffA[i] = (unsigned)(R * LDA + C) * 2u; voffB[i] = (unsigned)(Rb * LDB + C) * 2u; }
    constexpr size_t kstep = (size_t)(BK * 2);
    constexpr size_t hstepA = (size_t)HALF * LDA * 2, hstepB = (size_t)HALF * LDB * 2;
    constexpr size_t tstepA = 2 * hstepA, tstepB = 2 * hstepB;
    const unsigned ldsb32 = (unsigned)(__UINTPTR_TYPE__)lds; (void)ldsb32;
    const unsigned ldsw = (unsigned)wid * 1024u;
    const int aoff = lds_byte(wr * 64 + fr, fq * 8), boff = lds_byte(wc * 32 + fr, fq * 8);
#define PG8_SA(b, h) (((b) * 2 + (h)) * HTB)
#define PG8_SB(b, h) ((4 + (b) * 2 + (h)) * HTB)
#ifndef PROBE_HIT
#define PROBE_HIT 0
#endif
#ifdef KNOB_NOPRIO
#define PG8_PRIO_HI
#define PG8_PRIO_LO
#else
#define PG8_PRIO_HI __builtin_amdgcn_s_setprio(1)
#define PG8_PRIO_LO __builtin_amdgcn_s_setprio(0)
#endif
#ifdef KNOB_SADDR
#define PG8_STAGE(bufoff, gbase, voff) do { if ((PROBE_HIT == 2 || PROBE_HIT == 5) && g.hit) break; _Pragma("unroll") for (int _i = 0; _i < 2; ++_i) { \
        const unsigned la_ = ldsb32 + (unsigned)(bufoff) + ldsw + (unsigned)_i * 8192u; const char* gb_ = (const char*)(gbase); \
        asm volatile("s_mov_b32 m0, %2\n\ts_nop 0\n\tglobal_load_lds_dwordx4 %0, %1" :: "v"((voff)[_i]), "s"(gb_), "s"(la_) : "memory"); } } while (0)
#define PG8_STAGEB(bufoff, gbase, voff) PG8_STAGE(bufoff, gbase, voff)
#else
#define PG8_STAGE(bufoff, gbase, voff) do { if ((PROBE_HIT == 2 || PROBE_HIT == 5) && g.hit) break; _Pragma("unroll") for (int _i = 0; _i < 2; ++_i) \
        __builtin_amdgcn_global_load_lds((const unsigned*)((const char*)(gbase) + (voff)[_i]), (PG8_LAS unsigned*)(lds + (bufoff) + ldsw + _i * 8192), 16, 0, 0); } while (0)
#define PG8_STAGEB(bufoff, gbase, voff) do { if ((PROBE_HIT == 2 || PROBE_HIT == 5) && g.hit) break; _Pragma("unroll") for (int _i = 0; _i < 2; ++_i) \
        __builtin_amdgcn_global_load_lds((const unsigned*)((const char*)(gbase) + (voff)[_i]), (PG8_LAS unsigned*)(lds + (bufoff) + ldsw + _i * 8192), 16, 0, B_AUX); } while (0)
#endif
#define PG8_LDA(dst, b, h) do { if ((PROBE_HIT == 4 || PROBE_HIT == 5) && g.hit) break; _Pragma("unroll") for (int m = 0; m < 4; ++m) _Pragma("unroll") for (int k = 0; k < 2; ++k) dst[m][k] = *(const PG8_LAS bf16x8*)(lds + PG8_SA(b, h) + aoff + m * 2048 + k * 1024); } while (0)
#define PG8_LDB(dst, b, h) do { if ((PROBE_HIT == 4 || PROBE_HIT == 5) && g.hit) break; _Pragma("unroll") for (int n = 0; n < 2; ++n) _Pragma("unroll") for (int k = 0; k < 2; ++k) dst[n][k] = *(const PG8_LAS bf16x8*)(lds + PG8_SB(b, h) + boff + n * 2048 + k * 1024); } while (0)
#define PG8_MMA(ai, bj, At, Bt) do { if (PROBE_HIT == 3 && g.hit) break; PG8_PRIO_HI; _Pragma("unroll") for (int m = 0; m < 4; ++m) _Pragma("unroll") for (int n = 0; n < 2; ++n) _Pragma("unroll") for (int k = 0; k < 2; ++k) \
        acc[ai][bj][m][n] = __builtin_amdgcn_mfma_f32_16x16x32_bf16(Bt[n][k], At[m][k], acc[ai][bj][m][n], 0, 0, 0); PG8_PRIO_LO; } while (0)
#define PG8_WAIT_V(n) asm volatile("s_waitcnt vmcnt(" #n ")" ::: "memory")
#define PG8_WAIT_L(n) asm volatile("s_waitcnt lgkmcnt(" #n ")" ::: "memory")
#define PG8_BAR __builtin_amdgcn_s_barrier()
#define PG8_SCHED __builtin_amdgcn_sched_barrier(0)
    UnitK cur, nxt; int ui = 0;
    if constexpr (Sched::QUEUE) { if (!S.first(cur)) return; } else { if (!S.next(0, cur)) return; }
    volatile PG8_LAS unsigned* tkw = (volatile PG8_LAS unsigned*)(lds + STAGE_BYTES + 1024);
    f32x4 acc[2][2][4][2];
#pragma unroll
    for (int a = 0; a < 2; ++a)
#pragma unroll
        for (int b = 0; b < 2; ++b)
#pragma unroll
            for (int m = 0; m < 4; ++m)
#pragma unroll
                for (int n = 0; n < 2; ++n) acc[a][b][m][n] = (f32x4){0.f, 0.f, 0.f, 0.f};
    bf16x8 At[4][2], B0[2][2], B1[2][2];
    const char* cA = (const char*)g.A + (size_t)(g.hit ? g.hitpm : cur.pm) * tstepA + (size_t)cur.rofs * (LDA * 2); const char* cB = (const char*)g.Bt + (size_t)(g.hit ? 0 : cur.pn) * tstepB;
    S.a_ready(cur);
    if constexpr (SP2) {
        PG8_STAGEB(PG8_SB(0, 0), cB, voffB); PG8_STAGEB(PG8_SB(0, 1), cB + hstepB, voffB); PG8_STAGE(PG8_SA(0, 0), cA, voffA); PG8_STAGE(PG8_SA(0, 1), cA + hstepA, voffA);
        if (wr == 1) PG8_BAR;
        PG8_WAIT_V(2); PG8_BAR;
        PG8_STAGEB(PG8_SB(1, 0), cB + kstep, voffB); PG8_STAGE(PG8_SA(1, 0), cA + kstep, voffA); PG8_STAGEB(PG8_SB(1, 1), cB + hstepB + kstep, voffB);
        PG8_WAIT_V(6); PG8_BAR;
#ifdef KNOB_ASYM
        if (wr == 1) PG8_STAGE(PG8_SA(1, 1), cA + kstep + hstepA, voffA);
#endif
    } else {
        PG8_STAGEB(PG8_SB(0, 0), cB, voffB); PG8_STAGE(PG8_SA(0, 0), cA, voffA); PG8_STAGEB(PG8_SB(0, 1), cB + hstepB, voffB); PG8_STAGE(PG8_SA(0, 1), cA + hstepA, voffA);
        if (wr == 1) PG8_BAR;
        PG8_WAIT_V(4); PG8_BAR;
        PG8_STAGEB(PG8_SB(1, 0), cB + kstep, voffB); PG8_STAGE(PG8_SA(1, 0), cA + kstep, voffA); PG8_STAGEB(PG8_SB(1, 1), cB + hstepB + kstep, voffB);
        PG8_WAIT_V(6); PG8_BAR;
    }
    for (;;) {
        bool has_next = false; const char* nA = cA; const char* nB = cB; unsigned tk_ = 0u;
        if constexpr (Sched::QUEUE) { if (S.dynamic() && tid == 0) tk_ = __hip_atomic_fetch_add(S.ticket_word(), 1u, __ATOMIC_RELAXED, __HIP_MEMORY_SCOPE_AGENT); }
        else { has_next = S.next(ui + 1, nxt);
            nA = has_next ? (const char*)g.A + (size_t)(g.hit ? g.hitpm : nxt.pm) * tstepA + (size_t)nxt.rofs * (LDA * 2) : cA; nB = has_next ? (const char*)g.Bt + (size_t)(g.hit ? 0 : nxt.pn) * tstepB : cB; }
        for (int t = 0; t < nt; t += 2) {
            if constexpr (Epi::RESCALE) { if (t == 16 || t == 32) { const int tid_r = fresh_tid(); E.rescale(acc, cur, t == 16 ? 0 : 1, wr, wc, tid_r & 15, (tid_r & 63) >> 4); } }
            if constexpr (Epi::PREFETCH) { if (nt >= 32 && t == nt - 16) { const int tid_p = fresh_tid(); E.prefetch(cur, wid, tid_p & 63); } }
            const bool last = (t == nt - 2);
            if constexpr (Sched::QUEUE) {
                if (t == 4 && tid == 0) *tkw = tk_;
                if (last) { const unsigned tkv = S.dynamic() ? (unsigned)__builtin_amdgcn_readfirstlane((int)*tkw) : 0u; has_next = S.later(ui + 1, tkv, nxt);
                    nA = has_next ? (const char*)g.A + (size_t)(g.hit ? g.hitpm : nxt.pm) * tstepA + (size_t)nxt.rofs * (LDA * 2) : cA; nB = has_next ? (const char*)g.Bt + (size_t)(g.hit ? 0 : nxt.pn) * tstepB : cB; } }
            const char* a1 = cA + (size_t)(t + 1) * kstep;
            const char* a2 = last ? nA : cA + (size_t)(t + 2) * kstep; const char* b2 = last ? nB : cB + (size_t)(t + 2) * kstep;
            const char* a3 = a2 + kstep; const char* b3 = b2 + kstep;
            if (last && has_next) S.a_ready(nxt);
            if constexpr (SP2) {
#ifdef KNOB_ASYM
            PG8_LDB(B0, 0, 0); PG8_LDB(B1, 0, 1); PG8_SCHED; PG8_LDA(At, 0, 0);
            if (wr == 0) { PG8_STAGE(PG8_SA(1, 1), a1 + hstepA, voffA); }
            PG8_WAIT_V(8);
            PG8_WAIT_L(0); PG8_BAR;
            if (wr == 1) { PG8_STAGEB(PG8_SB(0, 0), b2, voffB); PG8_STAGEB(PG8_SB(0, 1), b2 + hstepB, voffB); PG8_STAGE(PG8_SA(0, 0), a2, voffA); }
            PG8_MMA(0, 0, At, B0); PG8_MMA(0, 1, At, B1); PG8_BAR; PG8_SCHED;
            PG8_LDA(At, 0, 1);
            if (wr == 0) { PG8_STAGEB(PG8_SB(0, 0), b2, voffB); PG8_STAGEB(PG8_SB(0, 1), b2 + hstepB, voffB); PG8_STAGE(PG8_SA(0, 0), a2, voffA); }
            PG8_WAIT_V(8);
            PG8_WAIT_L(0); PG8_BAR;
            if (wr == 1) { PG8_STAGE(PG8_SA(0, 1), a2 + hstepA, voffA); }
            if (!cur.half) { PG8_MMA(1, 0, At, B0); PG8_MMA(1, 1, At, B1); } PG8_BAR; PG8_SCHED;
            PG8_LDB(B0, 1, 0); PG8_LDB(B1, 1, 1); PG8_SCHED; PG8_LDA(At, 1, 0);
            if (wr == 0) { PG8_STAGE(PG8_SA(0, 1), a2 + hstepA, voffA); }
            PG8_WAIT_V(8);
            PG8_WAIT_L(0); PG8_BAR;
            if (wr == 1) { PG8_STAGEB(PG8_SB(1, 0), b3, voffB); PG8_STAGEB(PG8_SB(1, 1), b3 + hstepB, voffB); PG8_STAGE(PG8_SA(1, 0), a3, voffA); }
            PG8_MMA(0, 0, At, B0); PG8_MMA(0, 1, At, B1); PG8_BAR; PG8_SCHED;
            PG8_LDA(At, 1, 1);
            if (wr == 0) { PG8_STAGEB(PG8_SB(1, 0), b3, voffB); PG8_STAGEB(PG8_SB(1, 1), b3 + hstepB, voffB); PG8_STAGE(PG8_SA(1, 0), a3, voffA); }
            PG8_WAIT_V(8);
            PG8_WAIT_L(0); PG8_BAR;
            if (wr == 1) { PG8_STAGE(PG8_SA(1, 1), a3 + hstepA, voffA); }
            if (!cur.half) { PG8_MMA(1, 0, At, B0); PG8_MMA(1, 1, At, B1); } PG8_BAR; PG8_SCHED;
#else
#ifdef KNOB_FILLFIRST
            PG8_STAGE(PG8_SA(1, 1), a1 + hstepA, voffA); PG8_SCHED; PG8_LDB(B0, 0, 0); PG8_LDB(B1, 0, 1); PG8_SCHED; PG8_LDA(At, 0, 0);
#else
            PG8_LDB(B0, 0, 0); PG8_LDB(B1, 0, 1); PG8_SCHED; PG8_LDA(At, 0, 0); PG8_STAGE(PG8_SA(1, 1), a1 + hstepA, voffA);
#endif
            PG8_WAIT_V(8); PG8_WAIT_L(0); PG8_BAR; PG8_MMA(0, 0, At, B0); PG8_MMA(0, 1, At, B1); PG8_BAR; PG8_SCHED;
#ifdef KNOB_FILLFIRST
            PG8_STAGEB(PG8_SB(0, 0), b2, voffB); PG8_STAGEB(PG8_SB(0, 1), b2 + hstepB, voffB); PG8_STAGE(PG8_SA(0, 0), a2, voffA); PG8_SCHED; PG8_LDA(At, 0, 1);
#else
            PG8_LDA(At, 0, 1); PG8_STAGEB(PG8_SB(0, 0), b2, voffB); PG8_STAGEB(PG8_SB(0, 1), b2 + hstepB, voffB); PG8_STAGE(PG8_SA(0, 0), a2, voffA);
#endif
            PG8_WAIT_V(8); PG8_WAIT_L(0); PG8_BAR; if (!cur.half) { PG8_MMA(1, 0, At, B0); PG8_MMA(1, 1, At, B1); } PG8_BAR; PG8_SCHED;
#ifdef KNOB_FILLFIRST
            PG8_STAGE(PG8_SA(0, 1), a2 + hstepA, voffA); PG8_SCHED; PG8_LDB(B0, 1, 0); PG8_LDB(B1, 1, 1); PG8_SCHED; PG8_LDA(At, 1, 0);
#else
            PG8_LDB(B0, 1, 0); PG8_LDB(B1, 1, 1); PG8_SCHED; PG8_LDA(At, 1, 0); PG8_STAGE(PG8_SA(0, 1), a2 + hstepA, voffA);
#endif
            PG8_WAIT_V(8); PG8_WAIT_L(0); PG8_BAR; PG8_MMA(0, 0, At, B0); PG8_MMA(0, 1, At, B1); PG8_BAR; PG8_SCHED;
#ifdef KNOB_FILLFIRST
            PG8_STAGEB(PG8_SB(1, 0), b3, voffB); PG8_STAGEB(PG8_SB(1, 1), b3 + hstepB, voffB); PG8_STAGE(PG8_SA(1, 0), a3, voffA); PG8_SCHED; PG8_LDA(At, 1, 1);
#else
            PG8_LDA(At, 1, 1); PG8_STAGEB(PG8_SB(1, 0), b3, voffB); PG8_STAGEB(PG8_SB(1, 1), b3 + hstepB, voffB); PG8_STAGE(PG8_SA(1, 0), a3, voffA);
#endif
            PG8_WAIT_V(8); PG8_WAIT_L(0); PG8_BAR; if (!cur.half) { PG8_MMA(1, 0, At, B0); PG8_MMA(1, 1, At, B1); } PG8_BAR; PG8_SCHED;
#endif
            } else {
            PG8_LDB(B0, 0, 0); PG8_SCHED; PG8_LDA(At, 0, 0); PG8_STAGE(PG8_SA(1, 1), a1 + hstepA, voffA);
            PG8_WAIT_L(8); PG8_BAR; PG8_WAIT_L(0); PG8_MMA(0, 0, At, B0); PG8_BAR; PG8_SCHED;
            PG8_LDB(B1, 0, 1); PG8_STAGEB(PG8_SB(0, 0), b2, voffB);
            PG8_BAR; PG8_WAIT_L(0); PG8_MMA(0, 1, At, B1); PG8_BAR;
            PG8_LDA(At, 0, 1); PG8_STAGE(PG8_SA(0, 0), a2, voffA);
            PG8_BAR; PG8_WAIT_L(0); PG8_MMA(1, 0, At, B0); PG8_BAR; PG8_SCHED;
            PG8_STAGEB(PG8_SB(0, 1), b2 + hstepB, voffB);
            PG8_WAIT_V(6); PG8_BAR; PG8_MMA(1, 1, At, B1); PG8_BAR;
            PG8_LDB(B0, 1, 0); PG8_SCHED; PG8_LDA(At, 1, 0); PG8_STAGE(PG8_SA(0, 1), a2 + hstepA, voffA);
            PG8_WAIT_L(8); PG8_BAR; PG8_WAIT_L(0); PG8_MMA(0, 0, At, B0); PG8_BAR; PG8_SCHED;
            PG8_LDB(B1, 1, 1); PG8_STAGEB(PG8_SB(1, 0), b3, voffB);
            PG8_BAR; PG8_WAIT_L(0); PG8_MMA(0, 1, At, B1); PG8_BAR;
            PG8_LDA(At, 1, 1); PG8_STAGE(PG8_SA(1, 0), a3, voffA);
            PG8_BAR; PG8_WAIT_L(0); PG8_MMA(1, 0, At, B0); PG8_BAR; PG8_SCHED;
            PG8_STAGEB(PG8_SB(1, 1), b3 + hstepB, voffB);
            PG8_WAIT_V(6); PG8_BAR; PG8_MMA(1, 1, At, B1); PG8_BAR;
            }
        }
        if constexpr (ALIGN_EPI) { if (wr == 0) PG8_BAR; }
        if (!(PROBE_HIT == 6 && g.hit)) { const int tid_e = fresh_tid(); E(acc, cur, wr, wc, tid_e & 15, (tid_e & 63) >> 4, lds); }
        if (!has_next) break;
#pragma unroll
        for (int a = 0; a < 2; ++a)
#pragma unroll
            for (int b = 0; b < 2; ++b)
#pragma unroll
                for (int m = 0; m < 4; ++m)
#pragma unroll
                    for (int n = 0; n < 2; ++n) acc[a][b][m][n] = (f32x4){0.f, 0.f, 0.f, 0.f};
        cur = nxt; cA = nA; cB = nB; ++ui;
        if constexpr (ALIGN_EPI) { if (wr == 1) PG8_BAR; }
    }
    PG8_WAIT_V(0);
    if constexpr (!ALIGN_EPI) { if (wr == 0) PG8_BAR; }
    PG8_BAR;
#undef PG8_SA
#undef PG8_SB
#undef PG8_STAGE
#undef PG8_STAGEB
#undef PG8_LDA
#undef PG8_LDB
#undef PG8_MMA
#undef PG8_WAIT_V
#undef PG8_WAIT_L
#undef PG8_BAR
#undef PG8_SCHED
}
}

namespace att {
typedef unsigned short bf16;
typedef short bf16x8 __attribute__((ext_vector_type(8)));
typedef short s16x4 __attribute__((ext_vector_type(4)));
typedef float f32x16 __attribute__((ext_vector_type(16)));
typedef unsigned u32x4 __attribute__((ext_vector_type(4)));
constexpr float SCALE = 0.08838834764831845f, THR = 8.f;
constexpr int SHM_V = 16384, SHM_K = 16384, NW = 8;
constexpr int LDS_BYTES = 2 * SHM_V + 2 * SHM_K + NW * 64 * 4;
#define KSWZ(row, colB) ((row) * 256 + ((colB) ^ (((row) & 7) << 4)))
#define SBAR() __builtin_amdgcn_sched_barrier(0)
__device__ __forceinline__ int v_st(int k, int c) { const int kk = (k & ~0xC) | ((k & 4) << 1) | ((k & 8) >> 1); return ((kk >> 3) * 4 + (c >> 5)) * 512 + ((kk & 7) * 32 + (c & 31)) * 2; }
__device__ __forceinline__ int v_rd_base(int lane) { return ((lane & 3) << 3) | (((lane >> 2) & 3) << 6) | (((lane >> 4) & 1) << 5) | (((lane >> 5) & 1) << 8); }
constexpr int v_rd_off(int d0, int ks, int half) { return d0 * 512 + ks * 4096 + half * 2048; }
__device__ __forceinline__ int crow(int r, int hi) { return (r & 3) + 8 * (r >> 2) + 4 * hi; }
__device__ __forceinline__ unsigned cvtpk(float lo, float hi) { unsigned r; asm volatile("v_cvt_pk_bf16_f32 %0, %1, %2" : "=v"(r) : "v"(lo), "v"(hi)); return r; }
__device__ __forceinline__ void mask_tile(f32x16& p0, f32x16& p1, int d, int type) {
    const float NEG = -__builtin_inff();
#pragma unroll
    for (int r = 0; r < 16; ++r) {
        const int c = (r & 3) + 8 * (r >> 2);
        if (type == 1) { if (c < d) p0[r] = NEG; if (c + 32 < d) p1[r] = NEG; }
        else           { if (c > d) p0[r] = NEG; if (c + 32 > d) p1[r] = NEG; }
    }
}
__device__ __forceinline__ void partialSM(f32x16& p0, f32x16& p1, float& m_reg, float& mn, float& alpha) {
    float pmax = p0[0]; for (int r = 1; r < 16; ++r) pmax = fmaxf(pmax, p0[r]); for (int r = 0; r < 16; ++r) pmax = fmaxf(pmax, p1[r]);
    { auto rr = __builtin_amdgcn_permlane32_swap(__float_as_uint(pmax), __float_as_uint(pmax), false, false);
      pmax = fmaxf(__uint_as_float(rr[0]), __uint_as_float(rr[1])); }
    constexpr float C2 = 1.4426950408889634f * SCALE;
    if (__builtin_expect(__all((pmax - m_reg) * SCALE <= THR), 1)) { mn = m_reg; alpha = 1.f; }
    else { mn = fmaxf(m_reg, pmax); alpha = __builtin_amdgcn_exp2f((m_reg - mn) * C2); m_reg = mn; }
    const float mnL = -mn * C2;
    for (int r = 0; r < 16; ++r) p0[r] = fmaf(p0[r], C2, mnL); for (int r = 0; r < 16; ++r) p1[r] = fmaf(p1[r], C2, mnL);
    for (int r = 0; r < 16; ++r) p0[r] = __builtin_amdgcn_exp2f(p0[r]);
}
__device__ __forceinline__ void finishSM(f32x16& p0, f32x16& p1, float alpha, float& l_reg, bf16x8& pa0, bf16x8& pa1, bf16x8& pa2, bf16x8& pa3) {
    for (int r = 0; r < 16; ++r) p1[r] = __builtin_amdgcn_exp2f(p1[r]);
    float ps = 0; for (int r = 0; r < 16; ++r) ps += p0[r]; for (int r = 0; r < 16; ++r) ps += p1[r];
    { auto rr = __builtin_amdgcn_permlane32_swap(__float_as_uint(ps), __float_as_uint(ps), false, false);
      ps = __uint_as_float(rr[0]) + __uint_as_float(rr[1]); }
    l_reg = l_reg * alpha + ps;
#define PK4(P, B_, OUT) do { unsigned a0 = cvtpk(P[B_+0], P[B_+1]), a1 = cvtpk(P[B_+2], P[B_+3]);                          \
        unsigned b0 = cvtpk(P[B_+4], P[B_+5]), b1 = cvtpk(P[B_+6], P[B_+7]);                                             \
        auto r0 = __builtin_amdgcn_permlane32_swap(a0, b0, false, false); auto r1 = __builtin_amdgcn_permlane32_swap(a1, b1, false, false); \
        u32x4 w = {r0[0], r1[0], r0[1], r1[1]}; OUT = *reinterpret_cast<bf16x8*>(&w); } while (0)
    PK4(p0, 0, pa0); PK4(p0, 8, pa1); PK4(p1, 0, pa2); PK4(p1, 8, pa3);
#undef PK4
}
template <int KB>
__device__ __forceinline__ void qkt(f32x16& p0, f32x16& p1, const char* K_lds, int r32, int hi, const bf16x8* qr) {
    p0 = f32x16{}; p1 = f32x16{};
    const char* kb[4];
#pragma unroll
    for (int dd = 0; dd < 4; ++dd) kb[dd] = K_lds + KB * SHM_K + KSWZ(r32, (dd * 16 + hi * 8) * 2);
#pragma unroll
    for (int d0 = 0; d0 < 8; ++d0) { const char* a = kb[d0 & 3] + (d0 >> 2) * 128;
        bf16x8 b0 = *reinterpret_cast<const bf16x8*>(a);
        bf16x8 b1 = *reinterpret_cast<const bf16x8*>(a + 32 * 256);
        p0 = __builtin_amdgcn_mfma_f32_32x32x16_bf16(b0, qr[d0], p0, 0, 0, 0);
        p1 = __builtin_amdgcn_mfma_f32_32x32x16_bf16(b1, qr[d0], p1, 0, 0, 0); }
}
template <int VB>
__device__ __forceinline__ void pv_tile(f32x16* o, int vb0, bf16x8 pa0, bf16x8 pa1, bf16x8 pa2, bf16x8 pa3) {
#define TRRD(dst, off) asm volatile("ds_read_b64_tr_b16 %0, %1 offset:%2" : "=&v"(dst) : "v"(vb0), "i"(off) : "memory")
#define PV_RD(S, d0) do { constexpr int b_ = VB * SHM_V + v_rd_off(d0, 0, 0); \
        TRRD(l0##S, b_); TRRD(h0##S, b_ + 2048); TRRD(l1##S, b_ + 4096); TRRD(h1##S, b_ + 6144); TRRD(l2##S, b_ + 8192); TRRD(h2##S, b_ + 10240); TRRD(l3##S, b_ + 12288); TRRD(h3##S, b_ + 14336); } while (0)
#define PV_MM(S, d0) do { \
        o[d0] = __builtin_amdgcn_mfma_f32_32x32x16_bf16(pa0, (bf16x8){l0##S[0], l0##S[1], l0##S[2], l0##S[3], h0##S[0], h0##S[1], h0##S[2], h0##S[3]}, o[d0], 0, 0, 0);   \
        o[d0] = __builtin_amdgcn_mfma_f32_32x32x16_bf16(pa1, (bf16x8){l1##S[0], l1##S[1], l1##S[2], l1##S[3], h1##S[0], h1##S[1], h1##S[2], h1##S[3]}, o[d0], 0, 0, 0);   \
        o[d0] = __builtin_amdgcn_mfma_f32_32x32x16_bf16(pa2, (bf16x8){l2##S[0], l2##S[1], l2##S[2], l2##S[3], h2##S[0], h2##S[1], h2##S[2], h2##S[3]}, o[d0], 0, 0, 0);   \
        o[d0] = __builtin_amdgcn_mfma_f32_32x32x16_bf16(pa3, (bf16x8){l3##S[0], l3##S[1], l3##S[2], l3##S[3], h3##S[0], h3##S[1], h3##S[2], h3##S[3]}, o[d0], 0, 0, 0); } while (0)
    s16x4 l0a, l1a, l2a, l3a, h0a, h1a, h2a, h3a, l0b, l1b, l2b, l3b, h0b, h1b, h2b, h3b;
    PV_RD(a, 0); PV_RD(b, 1);
    asm volatile("s_waitcnt lgkmcnt(8)" ::: "memory"); SBAR(); PV_MM(a, 0); SBAR();
    PV_RD(a, 2);
    asm volatile("s_waitcnt lgkmcnt(8)" ::: "memory"); SBAR(); PV_MM(b, 1); SBAR();
    PV_RD(b, 3);
    asm volatile("s_waitcnt lgkmcnt(8)" ::: "memory"); SBAR(); PV_MM(a, 2); SBAR();
    asm volatile("s_waitcnt lgkmcnt(0)" ::: "memory"); SBAR(); PV_MM(b, 3);
#undef PV_RD
#undef PV_MM
#undef TRRD
}
__device__ __forceinline__ void attn_unit(const bf16* Qw, const bf16* cK, const bf16* cV, const bf16* wK, const bf16* wV, int nctx, int NT, int tm1, int tm2, const float* sinkp, bf16* Ow, int ldo, char* lds) {
    const int tid = fresh_tid(), wid = __builtin_amdgcn_readfirstlane(tid >> 6), lane = tid & 63, r32 = lane & 31, hi = lane >> 5;
    char* V_lds = lds; char* K_lds = lds + 2 * SHM_V;
    float* wsf = (float*)(lds + 2 * SHM_V + 2 * SHM_K) + wid * 64; float* li_l = wsf, * al_l = wsf + 32;
    float m_reg = -1e30f, l_reg = 0; f32x16 o[4] = {};
    const int sr = tid >> 4, sc = (tid & 15) * 8, vst0 = v_st(sr, sc), vst1 = v_st(32 + sr, sc), kws = KSWZ(sr, sc * 2);
    const int vb0 = (int)(uintptr_t)V_lds + v_rd_base(lane);
    const int qrow = 32 * (wid & 1) + r32, hq = wid >> 1, dmask = qrow - 4 * hi;
    bf16x8 qr[8];
#pragma unroll
    for (int d0 = 0; d0 < 8; ++d0) qr[d0] = *(const bf16x8*)(Qw + (size_t)qrow * D + hq * 128 + d0 * 16 + hi * 8);
    bf16x8 st_v0a, st_v1a, st_k0a, st_k1a, st_v0b, st_v1b, st_k0b, st_k1b;
#define TILEP(t, kp, vp) const bf16* kp = (t) < nctx ? cK + (size_t)(t) * 64 * KVD : wK + (size_t)((t) - nctx) * 64 * KVD; const bf16* vp = (t) < nctx ? cV + (size_t)(t) * 64 * KVD : wV + (size_t)((t) - nctx) * 64 * KVD
#define SLOAD(t, S) do { TILEP(t, kp_, vp_); st_v0##S = *(const bf16x8*)(vp_ + (size_t)sr * KVD + sc); st_v1##S = *(const bf16x8*)(vp_ + (size_t)(32 + sr) * KVD + sc); \
                      st_k0##S = *(const bf16x8*)(kp_ + (size_t)sr * KVD + sc); st_k1##S = *(const bf16x8*)(kp_ + (size_t)(32 + sr) * KVD + sc); } while (0)
#define SWRITE(bf, S) do { *(bf16x8*)(V_lds + (bf) * SHM_V + vst0) = st_v0##S; *(bf16x8*)(V_lds + (bf) * SHM_V + vst1) = st_v1##S; \
                        *(bf16x8*)(K_lds + (bf) * SHM_K + kws) = st_k0##S; *(bf16x8*)(K_lds + (bf) * SHM_K + kws + 32 * 256) = st_k1##S; } while (0)
#define VMW() asm volatile("s_waitcnt vmcnt(0)" ::: "memory")
#define RESC(a) do { if (__any((a) < 1.f)) { if (hi == 0) al_l[r32] = (a); asm volatile("s_waitcnt lgkmcnt(0)" ::: "memory");              \
                     for (int d_ = 0; d_ < 4; ++d_) for (int r = 0; r < 16; ++r) o[d_][r] *= al_l[crow(r, hi)]; } } while (0)
    f32x16 p0, p1; float mn, al; bf16x8 pa0, pa1, pa2, pa3;
#define STEP(t, B, SN, SW) do { if ((t) + 2 < NT) SLOAD((t) + 2, SN); SBAR();     \
        qkt<B>(p0, p1, K_lds, r32, hi, qr);                                                                           \
        if ((t) == tm1) mask_tile(p0, p1, dmask, 1); else if ((t) == tm2) mask_tile(p0, p1, dmask, 2);                \
        partialSM(p0, p1, m_reg, mn, al); RESC(al); finishSM(p0, p1, al, l_reg, pa0, pa1, pa2, pa3); SBAR();          \
        pv_tile<B>(o, vb0, pa0, pa1, pa2, pa3);                                                                       \
        if ((t) + 1 < NT) { SWRITE((B) ^ 1, SW); }          \
        __syncthreads(); } while (0)
    SLOAD(0, a); if (NT > 1) SLOAD(1, b); SWRITE(0, a); __syncthreads();
    for (int t = 0; t < NT; t += 2) { STEP(t, 0, a, b); if (t + 1 < NT) STEP(t + 1, 1, b, a); }
    { constexpr float C2 = 1.4426950408889634f * SCALE; const float sk = sinkp[hq];
      l_reg += __builtin_amdgcn_exp2f(sk * 1.4426950408889634f - m_reg * C2); }
    if (hi == 0) li_l[r32] = l_reg; asm volatile("s_waitcnt lgkmcnt(0)" ::: "memory");
    float rli[16];
#pragma unroll
    for (int r = 0; r < 16; ++r) rli[r] = __builtin_amdgcn_rcpf(li_l[crow(r, hi)]);
    typedef unsigned ou4 __attribute__((ext_vector_type(4)));
    char* Ost = lds + wid * 8192;
#pragma unroll
    for (int r = 0; r < 16; ++r) { const int orow = crow(r, hi);
#pragma unroll
        for (int d0 = 0; d0 < 4; ++d0) { const float v = o[d0][r] * rli[r]; const float vn = __shfl_xor(v, 1);
            if ((r32 & 1) == 0) *(unsigned*)(Ost + orow * 256 + (d0 * 32 + r32) * 2) = cvtpk(v, vn); } }
    asm volatile("s_waitcnt lgkmcnt(0)" ::: "memory");
    bf16* Op = Ow + (size_t)(32 * (wid & 1)) * ldo + hq * 128;
    ou4 ov[8];
#pragma unroll
    for (int j = 0; j < 8; ++j) { const int c = j * 64 + lane; ov[j] = *(const ou4*)(Ost + (c >> 4) * 256 + (c & 15) * 16); }
#pragma unroll
    for (int j = 0; j < 8; ++j) { const int c = j * 64 + lane; *(ou4*)(Op + (size_t)(c >> 4) * ldo + (c & 15) * 8) = ov[j]; }
    __syncthreads();
#undef TILEP
#undef SLOAD
#undef SWRITE
#undef VMW
#undef RESC
#undef STEP
}
#undef KSWZ
#undef SBAR
}

#define GAS __attribute__((address_space(1)))
#define LAS __attribute__((address_space(3)))
typedef unsigned short bf16;
typedef unsigned v4u __attribute__((ext_vector_type(4)));
typedef float f32x4 __attribute__((ext_vector_type(4)));
typedef short bf16x8 __attribute__((ext_vector_type(8)));
typedef GAS unsigned gu32;
#define RLX_AGENT __ATOMIC_RELAXED, __HIP_MEMORY_SCOPE_AGENT
#define LDS_WAIT() asm volatile("s_waitcnt lgkmcnt(0)" ::: "memory")
#define VM_WAIT() asm volatile("s_waitcnt vmcnt(0)" ::: "memory")
__device__ __forceinline__ unsigned f2bf(float f) { unsigned u = __builtin_bit_cast(unsigned, f); return (u + 0x7fffu + ((u >> 16) & 1u)) >> 16; }
__device__ __forceinline__ unsigned pk2(float lo, float hi) { return f2bf(lo) | (f2bf(hi) << 16); }
__device__ __forceinline__ float bflo(unsigned w) { return __builtin_bit_cast(float, w << 16); }
__device__ __forceinline__ float bfhi(unsigned w) { return __builtin_bit_cast(float, w & 0xffff0000u); }
__device__ __forceinline__ float wave_sum(float v) {
#pragma unroll
    for (int o = 1; o < 64; o <<= 1) v += __shfl_xor(v, o);
    return v;
}
__device__ __forceinline__ float silu_acc(float x) { return x / (1.f + __expf(-x)); }
#define XB_TMO      128
#define XB_XCNT(j)  (256  + 64 * (j))
#define XB_XSUB(j)  (1280 + 64 * (j))
#define XB_XGEN(j)  (2304 + 64 * (j))
#define XB_TOP      3328
#define XB_TOPGEN   3392
#define XCD_BAR_WORDS 3456
#define XB_SPIN_CAP (1u << 18)

__device__ __forceinline__ unsigned xb_ld(unsigned* p)              { return __hip_atomic_load(p, __ATOMIC_RELAXED, __HIP_MEMORY_SCOPE_AGENT); }
__device__ __forceinline__ unsigned xb_add(unsigned* p, unsigned v) { return __hip_atomic_fetch_add(p, v, __ATOMIC_RELAXED, __HIP_MEMORY_SCOPE_AGENT); }
__device__ __forceinline__ unsigned xb_xcc_id() { return (unsigned)__builtin_amdgcn_s_getreg((3 << 11) | 20) & 0xFu; }
#define XB_SPIN(cond, bar) do { unsigned _sp = 0; while (cond) { __builtin_amdgcn_s_sleep(1); \
    if ((++_sp & 255u) == 0u) { if (xb_ld(&(bar)[XB_TMO])) break; if (_sp > XB_SPIN_CAP) { atomicAdd(&(bar)[XB_TMO], 1u); break; } } } } while (0)

struct XcdBarrier {
    unsigned* bar; unsigned x;
    volatile LAS unsigned* st;
};

__device__ __forceinline__ XcdBarrier xcd_barrier_post(unsigned* bar, volatile LAS unsigned* st) {
    XcdBarrier b; b.bar = bar; b.x = xb_xcc_id(); b.st = st;
    if (threadIdx.x == 0) (void)xb_add(&bar[XB_XCNT(b.x)], 1u);
    return b;
}
__device__ __forceinline__ void xcd_barrier_complete(unsigned* bar, unsigned x, unsigned& nloc, unsigned& nx) {
    const unsigned G = gridDim.x * gridDim.y * gridDim.z;
    unsigned sum, cnt, mine, sp = 0u;
    for (;;) {
        sum = 0u; cnt = 0u; mine = 0u;
#pragma unroll
        for (unsigned j = 0; j < 16; ++j) { const unsigned c = xb_ld(&bar[XB_XCNT(j)]); sum += c; cnt += (c > 0u) ? 1u : 0u; mine = (j == x) ? c : mine; }
        if (sum == G) break;
        __builtin_amdgcn_s_sleep(1);
        if ((++sp & 255u) == 0u) { if (xb_ld(&bar[XB_TMO])) break; if (sp > XB_SPIN_CAP) { atomicAdd(&bar[XB_TMO], 1u); break; } }
    }
    nloc = mine > 0u ? mine : 1u; nx = cnt > 0u ? cnt : 1u;
}

__device__ __forceinline__ void xcd_barrier(const XcdBarrier& b) {
    asm volatile("s_waitcnt vmcnt(0)" ::: "memory");
    __syncthreads();
    if (threadIdx.x == 0) {
        unsigned* bar = b.bar;
        __builtin_amdgcn_s_waitcnt(0);
        unsigned nloc = b.st[0], nx = b.st[1];
        if (nloc == 0u) { xcd_barrier_complete(bar, b.x, nloc, nx); b.st[0] = nloc; b.st[1] = nx; }
        const unsigned old = xb_add(&bar[XB_XSUB(b.x)], 1u);
        const unsigned gen = old / nloc;
        if (old + 1u == (gen + 1u) * nloc) {
            __builtin_amdgcn_fence(__ATOMIC_RELEASE, "agent");
            asm volatile("s_waitcnt vmcnt(0)" ::: "memory");
            const unsigned og = xb_add(&bar[XB_TOP], 1u);
            const unsigned tg = og / nx;
            if (og + 1u == (tg + 1u) * nx) xb_add(&bar[XB_TOPGEN], 1u);
            else XB_SPIN(xb_ld(&bar[XB_TOPGEN]) == tg, bar);
            __builtin_amdgcn_fence(__ATOMIC_ACQUIRE, "agent");
            xb_add(&bar[XB_XGEN(b.x)], 1u);
            asm volatile("s_waitcnt vmcnt(0)" ::: "memory");
        } else {
            XB_SPIN(xb_ld(&bar[XB_XGEN(b.x)]) == gen, bar);
            __builtin_amdgcn_fence(__ATOMIC_ACQUIRE, "agent");
            asm volatile("s_waitcnt vmcnt(0)" ::: "memory");
        }
    }
    __syncthreads();
}


constexpr int NWAVES = 8, NTHR = NWAVES * 64;
constexpr int RING_OFF = 0, RING_BYTES = 131072;
constexpr int LDSCTL_OFF = RING_BYTES, MISC_OFF = LDSCTL_OFF + 320;
static_assert(pg8::EPI_T_OFF_ == 133120, "slab offset");
constexpr int EPI_T_OFF = 133120, EPI_T_BYTES = 8 * 2304;
constexpr int LDS_BYTES = 155648;
static_assert(att::LDS_BYTES <= RING_BYTES && MISC_OFF + 128 <= EPI_T_OFF && RING_BYTES + 1024 + 64 <= EPI_T_OFF && EPI_T_OFF + EPI_T_BYTES <= LDS_BYTES && LDS_BYTES <= 163840, "LDS map");
constexpr int N_PHASES = 27;

__device__ __forceinline__ int dest_row(int kind, int n0) {
    if (kind == 1) { const int uv = n0 / DFF, j = n0 % DFF; return 256 * (j >> 7) + 128 * uv + (j & 127); }
    if (kind == 2) {
        if (n0 < 2560) { const int isk = n0 >= 2048, nn = isk ? n0 - 2048 : n0, head = nn >> 7, d = nn & 127, part = d >> 6, x = (d >> 5) & 1;
                         return 256 * ((isk ? 8 : 0) + (head >> 1)) + 128 * x + 64 * (head & 1) + 32 * part; }
        if (n0 < 3072) return n0;
        if (n0 < 5120) { const int nn = n0 - 3072, ag = nn >> 10, j = nn & 1023; return 256 * (12 + (j >> 7)) + 128 * ag + (j & 127); }
        if (n0 < 6144) return n0;
        if (n0 < 8192) { const int nn = n0 - 6144, xv = nn >> 10, j = nn & 1023; return 256 * (24 + (j >> 7)) + 128 * xv + (j & 127); }
        return n0;
    }
    return n0;
}
__device__ __forceinline__ void p0_transpose_item(const float* W, int K, int N, bf16* WT, int kind, LAS float* scr, int item, int lane, int ldk = 0, int koff = 0) {
    if (ldk == 0) ldk = K;
    const int nblk = N / 32, kb = item / nblk, nb = item % nblk, k0 = 64 * kb, n0 = 32 * nb, drow = dest_row(kind, n0);
    { float wv_[32];
#pragma unroll
      for (int i = 0; i < 32; ++i) wv_[i] = __builtin_nontemporal_load(W + (size_t)(k0 + 2 * i + (lane >> 5)) * N + n0 + (lane & 31));
#pragma unroll
      for (int i = 0; i < 32; ++i) scr[(2 * i + (lane >> 5)) * 33 + (lane & 31)] = wv_[i]; }
    LDS_WAIT(); asm volatile("" ::: "memory");
    const int c = lane & 7;
#pragma unroll
    for (int j = 0; j < 4; ++j) { const int n = (lane >> 3) + 8 * j; const LAS float* s = scr + (8 * c) * 33 + n;
        v4u o; o.x = pk2(s[0 * 33], s[1 * 33]); o.y = pk2(s[2 * 33], s[3 * 33]); o.z = pk2(s[4 * 33], s[5 * 33]); o.w = pk2(s[6 * 33], s[7 * 33]);
        __builtin_nontemporal_store(o, (GAS v4u*)(WT + (size_t)(drow + n) * ldk + koff + k0 + 8 * c)); }
    LDS_WAIT(); asm volatile("" ::: "memory");
}
constexpr int I_FI = (D / 64) * (2 * DFF / 32), I_FO = (DFF / 64) * (D / 32), I_IN = (D / 64) * (INC / 32), I_DD = (D / 64) * (D / 32), I_HD = (DCA / 64) * (D / 32);
constexpr int I_LAYER = 2 * I_FI + 2 * I_FO + I_IN + 2 * I_DD + 2 * I_HD;

constexpr int R_1I = 0, R_1O = I_FI, R_IN = R_1O + I_FO, R_AO = R_IN + I_IN, R_OUT = R_AO + I_DD + 2 * I_HD, R_2I = R_OUT + I_DD, R_2O = R_2I + I_FI, R_END = R_2O + I_FO;
static_assert(R_END == I_LAYER, "item map");
__device__ __forceinline__ void convert_range(const Args& a, unsigned char* lds, int l, int r_lo, int r_hi, int wi, int nw) {
    const int tid = fresh_tid(), lane = tid & 63, wave = __builtin_amdgcn_readfirstlane(tid >> 6);
    LAS float* scr = (LAS float*)((LAS unsigned char*)lds + wave * 16384);
    unsigned char* wl = a.ws + WS_WT + (size_t)l * WT_LAYER;
    for (int it = r_lo + wi; it < r_hi; it += nw) {
        int r = it;
        if (r < I_FI) { p0_transpose_item(a.in[9] + (size_t)l * D * 2 * DFF, D, 2 * DFF, (bf16*)(wl + WT_1I), 1, scr, r, lane, WK_D, 0); continue; } r -= I_FI;
        if (r < I_FO) { p0_transpose_item(a.in[10] + (size_t)l * DFF * D, DFF, D, (bf16*)(wl + WT_1O), 0, scr, r, lane, WK_FF, 0); continue; } r -= I_FO;
        if (r < I_IN) { p0_transpose_item(a.in[12] + (size_t)l * D * INC, D, INC, (bf16*)(wl + WT_IN), 2, scr, r, lane, WK_D, 0); continue; } r -= I_IN;
        if (r < I_DD) { p0_transpose_item(a.in[14] + (size_t)l * D * D, D, D, (bf16*)(wl + WT_MIXB), 0, scr, r, lane, WK_MIX, 2048); continue; } r -= I_DD;
        if (r < I_HD) { p0_transpose_item(a.in[18] + (size_t)l * DCA * D, DCA, D, (bf16*)(wl + WT_MIXB), 0, scr, r, lane, WK_MIX, 0); continue; } r -= I_HD;
        if (r < I_HD) { p0_transpose_item(a.in[20] + (size_t)l * DCA * D, DCA, D, (bf16*)(wl + WT_MIXB), 0, scr, r, lane, WK_MIX, 1024); continue; } r -= I_HD;
        if (r < I_DD) { p0_transpose_item(a.in[21] + (size_t)l * D * D, D, D, (bf16*)(wl + WT_OUT), 0, scr, r, lane, WK_D, 0); continue; } r -= I_DD;
        if (r < I_FI) { p0_transpose_item(a.in[23] + (size_t)l * D * 2 * DFF, D, 2 * DFF, (bf16*)(wl + WT_2I), 1, scr, r, lane, WK_D, 0); continue; } r -= I_FI;
        p0_transpose_item(a.in[24] + (size_t)l * DFF * D, DFF, D, (bf16*)(wl + WT_2O), 0, scr, r, lane, WK_FF, 0);
    }
}
__device__ __forceinline__ void ada_layer(const Args& a, unsigned char* lds, int l, int bi, int nb, int item_lo = 0, int item_hi = NMOD / 64) {
    const int tid = fresh_tid(), lane = tid & 63, wave = __builtin_amdgcn_readfirstlane(tid >> 6);
    const float* c = a.in[4]; const float* c_ctx = a.in[5]; const float* w_ada = a.in[6]; const float* b_ada = a.in[7];
    float* sv = (float*)lds;
    float* part = (float*)(lds + 24576);
    __syncthreads();
    for (int i = tid; i < D; i += NTHR) { sv[i] = silu_acc(c_ctx[i]); sv[D + i] = silu_acc(c[i]); sv[2 * D + i] = silu_acc(c[D + i]); }
    __syncthreads();
    float* MOD = (float*)(a.ws + WS_MOD);
    for (int item = item_lo + bi; item < item_hi; item += nb) {
        const int j0 = item * 64;
        const float* w = w_ada + ((size_t)l * D + wave * 256) * NMOD + j0 + lane;
        const float* s0 = sv + wave * 256;
        float a0 = 0.f, a1 = 0.f, a2 = 0.f;
#pragma unroll 16
        for (int k = 0; k < 256; ++k) { const float x = w[(size_t)k * NMOD]; a0 += s0[k] * x; a1 += s0[D + k] * x; a2 += s0[2 * D + k] * x; }
        part[(wave * 3 + 0) * 64 + lane] = a0; part[(wave * 3 + 1) * 64 + lane] = a1; part[(wave * 3 + 2) * 64 + lane] = a2;
        __syncthreads();
        if (tid < 192) { const int cc = tid >> 6, j = tid & 63; float s = b_ada[l * NMOD + j0 + j];
#pragma unroll
            for (int wv = 0; wv < 8; ++wv) s += part[(wv * 3 + cc) * 64 + j];
            MOD[(size_t)(l * 3 + cc) * NMOD + j0 + j] = s; }
        __syncthreads();
    }
}
#ifndef CVT_CHUNK
#define CVT_CHUNK 2
#endif
constexpr int CW_CVT = 16384;
__device__ __forceinline__ void convert_item(const Args& a, LAS float* scr, int gi, int lane) {
    const int l = gi < I_LAYER ? 1 : 0; int r = gi < I_LAYER ? gi : gi - I_LAYER;
    unsigned char* wl = a.ws + WS_WT + (size_t)l * WT_LAYER;
    if (r < I_FI) { p0_transpose_item(a.in[9] + (size_t)l * D * 2 * DFF, D, 2 * DFF, (bf16*)(wl + WT_1I), 1, scr, r, lane, WK_D, 0); return; } r -= I_FI;
    if (r < I_FO) { p0_transpose_item(a.in[10] + (size_t)l * DFF * D, DFF, D, (bf16*)(wl + WT_1O), 0, scr, r, lane, WK_FF, 0); return; } r -= I_FO;
    if (r < I_IN) { p0_transpose_item(a.in[12] + (size_t)l * D * INC, D, INC, (bf16*)(wl + WT_IN), 2, scr, r, lane, WK_D, 0); return; } r -= I_IN;
    if (r < I_DD) { p0_transpose_item(a.in[14] + (size_t)l * D * D, D, D, (bf16*)(wl + WT_MIXB), 0, scr, r, lane, WK_MIX, 2048); return; } r -= I_DD;
    if (r < I_HD) { p0_transpose_item(a.in[18] + (size_t)l * DCA * D, DCA, D, (bf16*)(wl + WT_MIXB), 0, scr, r, lane, WK_MIX, 0); return; } r -= I_HD;
    if (r < I_HD) { p0_transpose_item(a.in[20] + (size_t)l * DCA * D, DCA, D, (bf16*)(wl + WT_MIXB), 0, scr, r, lane, WK_MIX, 1024); return; } r -= I_HD;
    if (r < I_DD) { p0_transpose_item(a.in[21] + (size_t)l * D * D, D, D, (bf16*)(wl + WT_OUT), 0, scr, r, lane, WK_D, 0); return; } r -= I_DD;
    if (r < I_FI) { p0_transpose_item(a.in[23] + (size_t)l * D * 2 * DFF, D, 2 * DFF, (bf16*)(wl + WT_2I), 1, scr, r, lane, WK_D, 0); return; } r -= I_FI;
    p0_transpose_item(a.in[24] + (size_t)l * DFF * D, DFF, D, (bf16*)(wl + WT_2O), 0, scr, r, lane, WK_FF, 0);
}
__device__ __forceinline__ void convert_all(const Args& a, unsigned char* lds, int vcu, int G) {
    const int tid = fresh_tid(), lane = tid & 63, wave = __builtin_amdgcn_readfirstlane(tid >> 6);
    LAS float* scr = (LAS float*)((LAS unsigned char*)lds + wave * 16384);
    constexpr int TOT = 2 * I_LAYER, PER = TOT / 8, CH = CVT_CHUNK, NCH = PER / CH;
    static_assert(TOT % 8 == 0 && PER % CH == 0, "conversion chunks");
    if (G != 256) { for (int gi = vcu * NWAVES + wave; gi < TOT; gi += G * NWAVES) convert_item(a, scr, gi, lane); return; }
    const int x = vcu >> 5, r = vcu & 31;
    unsigned* cnt = (unsigned*)(a.ws + WS_CTL) + CW_CVT + 64 * x;
    int ch = r * NWAVES + wave;
    while (ch < NCH) {
        unsigned nx = 0u; if (lane == 0) nx = __hip_atomic_fetch_add(cnt, 1u, __ATOMIC_RELAXED, __HIP_MEMORY_SCOPE_AGENT);
#pragma unroll 1
        for (int j = 0; j < CH; ++j) convert_item(a, scr, x * PER + ch * CH + j, lane);
        ch = 256 + __builtin_amdgcn_readfirstlane((int)nx);
    }
}
__device__ __forceinline__ void ada_all(const Args& a, unsigned char* lds, int bi, int nb) {
    const int tid = fresh_tid(), lane = tid & 63, wave = __builtin_amdgcn_readfirstlane(tid >> 6);
    const float* c = a.in[4]; const float* c_ctx = a.in[5]; const float* w_ada = a.in[6]; const float* b_ada = a.in[7];
    float* sv = (float*)lds;
    float* part = (float*)(lds + 24576);
    __syncthreads();
    for (int i = tid; i < D; i += NTHR) { sv[i] = silu_acc(c_ctx[i]); sv[D + i] = silu_acc(c[i]); sv[2 * D + i] = silu_acc(c[D + i]); }
    __syncthreads();
    float* MOD = (float*)(a.ws + WS_MOD);
    constexpr int NI = NMOD / 64;
    for (int it = bi; it < 2 * NI; it += nb) {
        const int l = it / NI, j0 = (it - l * NI) * 64;
        const float* w = w_ada + ((size_t)l * D + wave * 256) * NMOD + j0 + lane;
        const float* s0 = sv + wave * 256;
        float a0 = 0.f, a1 = 0.f, a2 = 0.f;
#pragma unroll 1
        for (int kk = 0; kk < 256; kk += 32) { float xw[32];
#pragma unroll
            for (int i = 0; i < 32; ++i) xw[i] = __builtin_nontemporal_load(w + (size_t)(kk + i) * NMOD);
#pragma unroll
            for (int i = 0; i < 32; ++i) { a0 += s0[kk + i] * xw[i]; a1 += s0[D + kk + i] * xw[i]; a2 += s0[2 * D + kk + i] * xw[i]; } }
        part[(wave * 3 + 0) * 64 + lane] = a0; part[(wave * 3 + 1) * 64 + lane] = a1; part[(wave * 3 + 2) * 64 + lane] = a2;
        __syncthreads();
        if (tid < 192) { const int cc = tid >> 6, j = tid & 63; float s = b_ada[l * NMOD + j0 + j];
#pragma unroll
            for (int wv = 0; wv < 8; ++wv) s += part[(wv * 3 + cc) * 64 + j];
            MOD[(size_t)(l * 3 + cc) * NMOD + j0 + j] = s; }
        __syncthreads();
    }
}
#ifndef FILL_MASK
#define FILL_MASK 0
#endif
__device__ __forceinline__ void filler(const Args& a, unsigned char* lds, int job, int idle, int nidle) {
    const int wave = __builtin_amdgcn_readfirstlane(fresh_tid() >> 6), wi = idle * NWAVES + wave, nw = nidle * NWAVES;
    if (job == 1) convert_range(a, lds, 0, R_IN, R_AO, wi, nw);
    else if (job == 2) convert_range(a, lds, 0, R_AO, R_END, wi, nw);
    else if (job == 3) ada_layer(a, lds, 1, idle, nidle, 0, NMOD / 128);
    else if (job == 7) ada_layer(a, lds, 1, idle, nidle, NMOD / 128, NMOD / 64);
    else if (job == 4) convert_range(a, lds, 1, R_1I, R_IN, wi, nw);
    else if (job == 5) convert_range(a, lds, 1, R_IN, R_AO, wi, nw);
    else if (job == 6) convert_range(a, lds, 1, R_AO, R_END, wi, nw);
}
__device__ __forceinline__ void prologue(const Args& a, unsigned char* lds, int vcu, int G) {
    const int tid = fresh_tid(), wave = __builtin_amdgcn_readfirstlane(tid >> 6);
    unsigned char* ws = a.ws;
#ifdef PROLOGUE_STATIC
    ada_layer(a, lds, 0, vcu, G); ada_layer(a, lds, 1, vcu, G);
    convert_range(a, lds, 1, 0, R_END, vcu * NWAVES + wave, G * NWAVES); convert_range(a, lds, 0, 0, R_END, vcu * NWAVES + wave, G * NWAVES);
#else
    ada_all(a, lds, vcu, G);
    convert_all(a, lds, vcu, G);
#endif
    {
        const int gt = vcu * NTHR + tid, NT = G * NTHR;
        const int n8 = 2 * 2 * PAST * KVD / 8;
        for (int i = gt; i < 2 * n8; i += NT) { const bool isk = i < n8; const int j = isk ? i : i - n8;
            const f32x4* s = (const f32x4*)((isk ? a.in[2] : a.in[3]) + (size_t)j * 8); const f32x4 x = s[0], y = s[1];
            v4u o; o.x = pk2(x[0], x[1]); o.y = pk2(x[2], x[3]); o.z = pk2(y[0], y[1]); o.w = pk2(y[2], y[3]);
            *(v4u*)(ws + (isk ? WS_CK : WS_CV) + (size_t)j * 16) = o; }
        if (gt < 64 * 32) { const int pos = gt >> 5, i = gt & 31; const float inv = powf(10000.f, -(float)i / 32.f), ang = (float)pos * inv;
            float* rp = (float*)(ws + WS_ROPE) + (size_t)gt * 2; rp[0] = cosf(ang); rp[1] = sinf(ang); }
    }
}
template <bool FINAL>
__device__ __forceinline__ void norm_phase(const float* X, const float* g, const float* MODl, int sub, bf16* H, float* out, int vcu, int G, int row_lo, int row_hi, bool xt) {
    const int tid = fresh_tid(), lane = tid & 63, gw = vcu * NWAVES + __builtin_amdgcn_readfirstlane(tid >> 6), NGW = G * NWAVES;
    int m = row_lo + gw;
    if (m >= row_hi) return;
    f32x4 gv[8], scv[8], shv[8]; int cur = -1;
    const f32x4* gr = (const f32x4*)g + lane;
#pragma unroll
    for (int j = 0; j < 8; ++j) gv[j] = gr[64 * j];
    f32x4 v[8];
    {
#pragma unroll
      for (int j = 0; j < 8; ++j) v[j] = *(const f32x4*)(X + (xt ? xt_off(m, 256 * j) : (size_t)m * D + 256 * j) + 4 * lane); }
    for (; m < row_hi; m += NGW) {
        f32x4 vn[8];
        const int mn = m + NGW;
        if (mn < row_hi) {
#pragma unroll
            for (int j = 0; j < 8; ++j) vn[j] = *(const f32x4*)(X + (xt ? xt_off(mn, 256 * j) : (size_t)mn * D + 256 * j) + 4 * lane); }
        else {
#pragma unroll
            for (int j = 0; j < 8; ++j) vn[j] = v[j]; }
        if (!FINAL) { const int cond = m < MC ? 0 : (m < MC + SEQL ? 1 : 2);
            if (cond != cur) { cur = cond; const float* mod = MODl + (size_t)cond * NMOD + (size_t)sub * 3 * D;
                const f32x4* sh = (const f32x4*)mod + lane; const f32x4* sc = (const f32x4*)(mod + D) + lane;
#pragma unroll
                for (int j = 0; j < 8; ++j) { scv[j] = sc[64 * j] + 1.f; shv[j] = sh[64 * j]; } } }
        __builtin_amdgcn_sched_barrier(0);
        float ss = 0.f;
#pragma unroll
        for (int j = 0; j < 8; ++j) ss += (v[j][0] * v[j][0] + v[j][1] * v[j][1]) + (v[j][2] * v[j][2] + v[j][3] * v[j][3]);
        const float r = rsqrtf(wave_sum(ss) * (1.f / D) + EPS);
        if (FINAL) { f32x4* o = (f32x4*)(out + (size_t)m * D) + lane;
#pragma unroll
            for (int j = 0; j < 8; ++j) o[64 * j] = v[j] * r * gv[j];
        } else {
            unsigned long long* o8 = (unsigned long long*)(H + (size_t)m * H_LD) + lane;
#pragma unroll
            for (int j = 0; j < 8; ++j) { const f32x4 h = v[j] * r * gv[j] * scv[j] + shv[j];
                o8[64 * j] = (unsigned long long)pk2(h[0], h[1]) | ((unsigned long long)pk2(h[2], h[3]) << 32); }
        }
#pragma unroll
        for (int j = 0; j < 8; ++j) v[j] = vn[j];
    }
}
__device__ __forceinline__ void conv_a_phase(const bf16* GLU, const float* w, const float* bias, const float* g, bf16* CA, unsigned char* lds, int u_first, int u_count, int u_stride) {
    typedef float f32x2 __attribute__((ext_vector_type(2)));
    const int tid = fresh_tid(), wid = tid >> 6, lane = tid & 63;
    float* part = (float*)lds;
    float* rs = (float*)(lds + 32768);
    f32x2 wv[31];
#pragma unroll
    for (int t = 0; t < 31; ++t) wv[t] = *(const f32x2*)(w + t * DCA + 2 * tid);
    const f32x2 bb = *(const f32x2*)(bias + 2 * tid), gg = *(const f32x2*)(g + 2 * tid);
    for (int ui_ = 0; ui_ < u_count; ++ui_) { const int u = u_first + ui_ * u_stride;
        const int row0 = u * 16, s0 = row0 < MC ? (row0 & ~(SEQC - 1)) : MC + ((row0 - MC) & ~(SEQL - 1)), L = row0 < MC ? SEQC : SEQL, p0 = row0 - s0;
        f32x2 xv[46];
#pragma unroll
        for (int q = 0; q < 46; ++q) { const int p = p0 - 15 + q; unsigned xw = 0u; if (p >= 0 && p < L) xw = *(const unsigned*)(GLU + (size_t)(s0 + p) * DCA + 2 * tid); xv[q] = (f32x2){bflo(xw), bfhi(xw)}; }
        f32x2 acc[16];
#pragma unroll
        for (int r = 0; r < 16; ++r) { f32x2 s_ = bb;
#pragma unroll
            for (int t = 0; t < 31; ++t) s_ = s_ + xv[r + t] * wv[t];
            acc[r] = s_; part[r * 512 + tid] = s_.x * s_.x + s_.y * s_.y; }
        __syncthreads();
#pragma unroll
        for (int h = 0; h < 2; ++h) { const int r = wid + 8 * h; float v = 0.f;
#pragma unroll
            for (int k = 0; k < 8; ++k) v += part[r * 512 + lane + 64 * k];
            v = wave_sum(v); if (lane == 0) rs[r] = rsqrtf(v * (1.f / DCA) + EPS); }
        __syncthreads();
#pragma unroll
        for (int r = 0; r < 16; ++r) { const float rr = rs[r]; const f32x2 y = acc[r] * rr * gg;
            *(unsigned*)(CA + (size_t)(row0 + r) * ABR_LD + 2 * tid) = pk2(silu_acc(y.x), silu_acc(y.y)); }
    }
    __syncthreads();
}
__device__ __forceinline__ void conv_b_phase(const bf16* BG, const bf16* CX, const float* w, bf16* CB, int vcu, int G, int row_lo, int row_hi) {
    const int gt = vcu * NTHR + fresh_tid(), NT = G * NTHR;
    const int c8 = (gt & 127) * 8;
    f32x4 wa[3], wb[3];
#pragma unroll
    for (int t = 0; t < 3; ++t) { wa[t] = *(const f32x4*)(w + t * DCA + c8); wb[t] = *(const f32x4*)(w + t * DCA + c8 + 4); }
    const int end = row_hi * (DCA / 8);
    constexpr int QB = 4;
    for (int idx0 = row_lo * (DCA / 8) + gt; idx0 < end; idx0 += QB * NT) {
        v4u xw[QB][3], bw[QB];
#pragma unroll
        for (int q = 0; q < QB; ++q) { const int idx = idx0 + q * NT; const int m = idx >> 7;
            const int s0 = m < MC ? (m & ~(SEQC - 1)) : MC + ((m - MC) & ~(SEQL - 1)), L = m < MC ? SEQC : SEQL, pos = m - s0;
#pragma unroll
            for (int t = 0; t < 3; ++t) { const int p = pos + t - 1; xw[q][t] = (v4u){0u, 0u, 0u, 0u};
                if (idx < end && p >= 0 && p < L) xw[q][t] = *(const v4u*)(CX + (size_t)(s0 + p) * DCA + c8); }
            bw[q] = (v4u){0u, 0u, 0u, 0u}; if (idx < end) bw[q] = *(const v4u*)(BG + (size_t)m * DCA + c8); }
        __builtin_amdgcn_sched_barrier(0);
#pragma unroll
        for (int q = 0; q < QB; ++q) { const int idx = idx0 + q * NT; const int m = idx >> 7;
            f32x4 aa = {0.f, 0.f, 0.f, 0.f}, ab = {0.f, 0.f, 0.f, 0.f};
#pragma unroll
            for (int t = 0; t < 3; ++t) { const v4u x = xw[q][t];
                aa[0] += bflo(x.x) * wa[t][0]; aa[1] += bfhi(x.x) * wa[t][1]; aa[2] += bflo(x.y) * wa[t][2]; aa[3] += bfhi(x.y) * wa[t][3];
                ab[0] += bflo(x.z) * wb[t][0]; ab[1] += bfhi(x.z) * wb[t][1]; ab[2] += bflo(x.w) * wb[t][2]; ab[3] += bfhi(x.w) * wb[t][3]; }
            const v4u b = bw[q];
            v4u o; o.x = pk2(bflo(b.x) * aa[0], bfhi(b.x) * aa[1]); o.y = pk2(bflo(b.y) * aa[2], bfhi(b.y) * aa[3]); o.z = pk2(bflo(b.z) * ab[0], bfhi(b.z) * ab[1]); o.w = pk2(bflo(b.w) * ab[2], bfhi(b.w) * ab[3]);
            if (idx < end) *(v4u*)(CB + (size_t)m * ABR_LD + c8) = o; }
    }
}
#ifndef ATT_LO
#define ATT_LO 1
#endif
#ifndef CONV_LO
#define CONV_LO 2
#endif
__device__ __forceinline__ void attn_lat_phase(const bf16* Qb, const bf16* Kb, const bf16* Vb, const bf16* CK, const bf16* CV, const float* sink, bf16* ATT, int layer, int bx, int vcu, int G, unsigned char* lds) {
    const bool deal = G == 256; const int x = bx & 7, r = bx >> 3;
    const int cnt = deal ? (r >= 16 ? 4 - ATT_LO : ATT_LO) : (512 - vcu + G - 1) / G;
    for (int i = 0; i < cnt; ++i) {
        const int u = deal ? x * 64 + (r >= 16 ? 16 * ATT_LO + (r - 16) * (4 - ATT_LO) + i : r * ATT_LO + i) : vcu + i * G;
        const int b = u >> 8, kvh = (u >> 6) & 3, tb = u & 63;
        const int lo = tb < 2 ? -tb : -2, hi = tb > 61 ? 63 - tb : 2, NT = 8 + (hi - lo + 1);
        const size_t seq0 = (size_t)MC + (size_t)b * SEQL, q0 = seq0 + 64 * tb, c0 = (size_t)(b * 2 + layer) * PAST;
        att::attn_unit(Qb + q0 * D + kvh * 512, CK + c0 * KVD + kvh * 128, CV + c0 * KVD + kvh * 128,
                       Kb + (seq0 + 64 * (tb + lo)) * KVD + kvh * 128, Vb + (seq0 + 64 * (tb + lo)) * KVD + kvh * 128,
                       8, NT, lo == -2 ? 8 : -1, hi == 2 ? NT - 1 : -1, sink + kvh * 4, ATT + q0 * ABR_LD + kvh * 512, ABR_LD, (char*)lds);
    }
}
__device__ __forceinline__ void attn_ctx_phase(const bf16* Qb, const bf16* Kb, const bf16* Vb, const float* sink, bf16* ATT, int vcu, int G, unsigned char* lds) {
    for (int u = vcu; u < 256; u += G) {
        const int b = u >> 4, kvh = (u >> 2) & 3, qb = u & 3;
        const size_t seq0 = (size_t)b * SEQC, q0 = seq0 + 64 * qb;
        att::attn_unit(Qb + q0 * D + kvh * 512, Kb, Vb, Kb + seq0 * KVD + kvh * 128, Vb + seq0 * KVD + kvh * 128, 0, 4, -1, -1, sink + kvh * 4, ATT + q0 * ABR_LD + kvh * 512, ABR_LD, (char*)lds);
    }
}

#define P_MOD   ((float*)(ws + WS_MOD))
#define P_CK    ((bf16*)(ws + WS_CK))
#define P_CV    ((bf16*)(ws + WS_CV))
#define P_X     ((float*)(ws + WS_X))
#define P_H     ((bf16*)(ws + WS_H))
#define P_ACT   ((bf16*)(ws + WS_ACT))
#define P_Q     ((bf16*)(ws + WS_Q))
#define P_K     ((bf16*)(ws + WS_K))
#define P_V     ((bf16*)(ws + WS_V))
#define P_GLU   ((bf16*)(ws + WS_GLU))
#define P_BG    ((bf16*)(ws + WS_BG))
#define P_CX    ((bf16*)(ws + WS_CX))
#define P_GATES ((bf16*)(ws + WS_GATES))
#define P_ABR   ((bf16*)(ws + WS_ABR))
#define P_ATT   (P_ABR + ABR_ATT)
#define P_CA    (P_ABR + ABR_CA)
#define P_CB    (P_ABR + ABR_CB)
#define P_MIX   ((bf16*)(ws + WS_MIX))
#define P_MODL  (P_MOD + (size_t)l * 3 * NMOD)
#define P_WL(off) ((const bf16*)(ws + WS_WT + (size_t)l * WT_LAYER + (off)))
__global__ void __launch_bounds__(NTHR, 2) fwd(Args args) {
    extern __shared__ __attribute__((aligned(16))) unsigned char lds[];
    const int tid = threadIdx.x;
    const int G0 = gridDim.x, bx = blockIdx.x, vcu0 = (G0 % 8 == 0) ? (bx % 8) * (G0 / 8) + bx / 8 : bx;
    LAS unsigned char* ldsl = (LAS unsigned char*)lds;
    volatile LAS unsigned* MISC = (volatile LAS unsigned*)(ldsl + MISC_OFF);
    for (int u = tid; u < (LDS_BYTES - LDSCTL_OFF) / 4; u += NTHR) ((LAS unsigned*)(ldsl + LDSCTL_OFF))[u] = 0u;
    __syncthreads();
    unsigned* barw = (unsigned*)(args.ws + WS_CTL) + CW_BAR;
    XcdBarrier bar; bar.bar = barw; bar.x = 0; bar.st = nullptr;
    if (!MK_PER_PHASE) bar = xcd_barrier_post(barw, MISC + 8);
#if MK_PER_PHASE
    const int lo = args.ph_lo, hi = args.ph_hi;
#define IN(k) (lo <= (k) && (k) < hi)
#else
#define IN(k) true
#endif
#ifndef DUP_PHASE
#define DUP_PHASE (-1)
#endif
#define EPI_T 0
#define PH_BEGIN const Args* A_ = fresh_args(); unsigned char* ws = A_->ws; (void)ws; const int vcu = fresh_i(vcu0), G = fresh_i(G0); (void)vcu; (void)G
#define FILL_JOB(j) ((l == 0 && (((FILL_MASK) >> (j)) & 1)) ? (j) : 0)
#define RUN_GEMM(EpiT, Eobj, Aptr, Bptr, N_, K_, LDA_, LDB_, kind_, job_) do { pg8::Gemm g{Aptr, Bptr, M, N_, K_}; typedef pg8::TailOrder<M, N_, K_, (((HT_MASK) >> (kind_)) & 1) != 0> SO_; SO_ S; S.init(fresh_i(G), fresh_i(bx)); \
        pg8::gemm_phase_ht<EpiT, SO_, K_, LDA_, LDB_>(ldsl + RING_OFF, g, S, Eobj); \
        { const int job__ = (job_); if (job__ > 0) { constexpr int nwg__ = (M / 256) * ((N_) / 256); const int G__ = fresh_i(G), bx__ = fresh_i(bx), Rem__ = nwg__ - (nwg__ / G__) * G__; \
            if (bx__ >= Rem__) filler(*fresh_args(), lds, job__, bx__ - Rem__, G__ - Rem__); } } } while (0)
#ifdef XTRA_BAR
#define XTRA_BAR_STMT xcd_barrier(bb_);
#else
#define XTRA_BAR_STMT
#endif
#ifndef HT_MASK
#define HT_MASK 0
#endif
#define REP(k) for (int rep_ = 0; rep_ < ((DUP_PHASE == (k)) ? 2 : 1); ++rep_)
#ifdef PROBE_PHASE
#define STAMP(k) do { unsigned long long* tsp_ = (unsigned long long*)(fresh_args()->ws + WS_CTL + 131072); if (blockIdx.x == 0 && threadIdx.x == 0) tsp_[(k) + 1] = __builtin_amdgcn_s_memrealtime(); } while (0)
#else
#define STAMP(k) do { } while (0)
#endif
#define SEAM(k) do { if (!MK_PER_PHASE && IN(k) && IN((k) + 1)) { XcdBarrier bb_ = bar; bb_.x = (unsigned)fresh_i((int)bar.x); bb_.bar = (unsigned*)(fresh_args()->ws + WS_CTL) + CW_BAR; xcd_barrier(bb_); XTRA_BAR_STMT STAMP(k); } } while (0)

#ifndef DUPX
#define DUPX (-1)
#endif
#ifndef PROBE_G
#define PROBE_G 0
#endif
#ifndef W_PNMIX
#define W_PNMIX true
#endif
#ifndef PROBE_HIT
#define PROBE_HIT 0
#endif
#define RUN_GEMM_Q(EpiT, Eobj, Aptr, Bptr, N_, K_, LDA_, LDB_, PM0_, NML_, TYPE_, MIX_, QID_) do { pg8::Gemm g{Aptr, Bptr, M, N_, K_}; g.hit = (dry_ && PROBE_HIT) ? 1 : 0; g.hitpm = PM0_; typedef pg8::QueueOrder<N_, PM0_, NML_, TYPE_, MIX_> SO_; SO_ S; \
        S.init(fresh_i(G), fresh_i(bx), (unsigned*)(ws + WS_CTL) + CW_Q + (size_t)((QID_) + (dry_ ? 50 : 0)) * 512); pg8::gemm_phase_ht<EpiT, SO_, K_, LDA_, LDB_>(ldsl + RING_OFF, g, S, Eobj); } while (0)
#define RUN_GEMM_D(EpiT, Eobj, Aptr, Bptr, N_, K_, LDA_, LDB_, PM0_, NML_, R_, KA_, KB_) RUN_GEMM_DX(EpiT, Eobj, Aptr, Bptr, N_, K_, LDA_, LDB_, PM0_, NML_, R_, KA_, KB_, false)
#define RUN_GEMM_DX(EpiT, Eobj, Aptr, Bptr, N_, K_, LDA_, LDB_, PM0_, NML_, R_, KA_, KB_, MIX_) do { pg8::Gemm g{Aptr, Bptr, M, N_, K_}; typedef pg8::DealOrder<N_, PM0_, NML_, R_, KA_, KB_, MIX_> SO_; SO_ S; S.init(fresh_i(G), fresh_i(bx)); \
        pg8::gemm_phase_ht<EpiT, SO_, K_, LDA_, LDB_>(ldsl + RING_OFF, g, S, Eobj); } while (0)
#define NORM_C(sub_, gin_, lc) { PH_BEGIN; const bool xt_ = !((sub_) == 0 && (lc) == 0); const float* xs_ = ((sub_) == 0 && (lc) == 0) ? A_->in[0] : (const float*)P_X; const int r_ = bx >> 3, x_ = bx & 7; \
        if (G != 256) norm_phase<false>(xs_, A_->in[gin_] + (lc) * D, P_MOD + (size_t)(lc) * 3 * NMOD, sub_, P_H, nullptr, vcu, G, 0, MC, xt_); \
        else { const int lo_ = 1024 * (x_ >> 1) + 512 * (x_ & 1); norm_phase<false>(xs_, A_->in[gin_] + (lc) * D, P_MOD + (size_t)(lc) * 3 * NMOD, sub_, P_H, nullptr, r_, 32, lo_, lo_ + 512, xt_); } }
#ifndef NORM_L_RANKS
#define NORM_L_RANKS 8
#endif
#define NORM_L(sub_, gin_, ll) { PH_BEGIN; const bool xt_ = !((sub_) == 0 && (ll) == 0); const float* xs_ = ((sub_) == 0 && (ll) == 0) ? A_->in[1] - (size_t)MC * D : (const float*)P_X; const int r_ = bx >> 3, x_ = bx & 7; \
        if (G != 256) norm_phase<false>(xs_, A_->in[gin_] + (ll) * D, P_MOD + (size_t)(ll) * 3 * NMOD, sub_, P_H, nullptr, vcu, G, MC, M, xt_); \
        else { constexpr int NR_ = ((sub_) == 1) ? 16 : NORM_L_RANKS;     \
            if (r_ >= 32 - NR_) { const int lo_ = MC + 1024 * x_; norm_phase<false>(xs_, A_->in[gin_] + (ll) * D, P_MOD + (size_t)(ll) * 3 * NMOD, sub_, P_H, nullptr, r_ - (32 - NR_), NR_, lo_, lo_ + 1024, xt_); } } }
#define WLY(lx, off) ((const bf16*)(ws + WS_WT + (size_t)(lx) * WT_LAYER + (off)))
#define MODLY(lx) (P_MOD + (size_t)(lx) * 3 * NMOD)
    STAMP(-1);
    if (IN(0)) REP(0) { prologue(*fresh_args(), lds, vcu0, G0); } SEAM(0);
    if (IN(1)) NORM_C(0, 8, 0)
    SEAM(1);
    for (int l = 0; l < 2; ++l) {
        const int pb = 2 + 12 * l;
        if (IN(pb + 0)) for (int rep_ = 0; rep_ < ((DUPX == 99 || (DUPX == 0 && l == 0)) ? 2 : 1); ++rep_) { const bool dry_ = ((DUPX == 99 || (DUPX == 0 && l == 0)) && rep_ == 0); (void)dry_; NORM_L(0, 8, l)
            { PH_BEGIN; pg8::EpiSwiglu E{P_ACT, ACT_LD}; RUN_GEMM_Q(pg8::EpiSwiglu, E, P_H, WLY(l, WT_1I), 2 * DFF, D, H_LD, WK_D, 0, 16, 0, false, l * 14 + 0); } }
        SEAM(pb + 0);
        if (IN(pb + 1)) for (int rep_ = 0; rep_ < ((DUPX == 99 || (DUPX == 1 && l == 0)) ? 2 : 1); ++rep_) { const bool dry_ = ((DUPX == 99 || (DUPX == 1 && l == 0)) && rep_ == 0); (void)dry_;
            { PH_BEGIN; pg8::EpiResid E{P_X, MODLY(l) + 2 * D, l == 0 ? A_->in[0] : (const float*)P_X, dry_ ? 0.f : 0.5f, l == 0 ? 0 : 1}; RUN_GEMM_Q(pg8::EpiResid, E, P_ACT, WLY(l, WT_1O), D, DFF, ACT_LD, WK_FF, 0, 16, 0, false, l * 14 + 1); }
            { PH_BEGIN; pg8::EpiSwiglu E{P_ACT, ACT_LD}; RUN_GEMM_Q(pg8::EpiSwiglu, E, P_H, WLY(l, WT_1I), 2 * DFF, D, H_LD, WK_D, 16, 32, 1, false, l * 14 + 2); } }
        SEAM(pb + 1);
        if (IN(pb + 2)) for (int rep_ = 0; rep_ < ((DUPX == 99 || (DUPX == 2 && l == 0)) ? 2 : 1); ++rep_) { const bool dry_ = ((DUPX == 99 || (DUPX == 2 && l == 0)) && rep_ == 0); (void)dry_; NORM_C(1, 11, l)
            { PH_BEGIN; pg8::EpiResid E{P_X, MODLY(l) + 2 * D, l == 0 ? A_->in[1] - (size_t)MC * D : (const float*)P_X, dry_ ? 0.f : 0.5f, l == 0 ? 0 : 1}; RUN_GEMM_Q(pg8::EpiResid, E, P_ACT, WLY(l, WT_1O), D, DFF, ACT_LD, WK_FF, 16, 32, 0, false, l * 14 + 3); } }
        SEAM(pb + 2);
        if (IN(pb + 3)) for (int rep_ = 0; rep_ < ((DUPX == 99 || (DUPX == 3 && l == 0)) ? 2 : 1); ++rep_) { const bool dry_ = ((DUPX == 99 || (DUPX == 3 && l == 0)) && rep_ == 0); (void)dry_; NORM_L(1, 11, l)
#if defined(PROBE_W)
            if (l == 0) {
#if PROBE_W == 1
                { PH_BEGIN; pg8::EpiSwiglu E{P_ACT, ACT_LD}; RUN_GEMM_Q(pg8::EpiSwiglu, E, P_H, WLY(l, WT_IN), INC, D, H_LD, WK_D, 0, 16, 0, true, 40); }
#else
                { PH_BEGIN; pg8::EpiWin E{ws, A_->out, l}; RUN_GEMM_Q(pg8::EpiWin, E, P_H, WLY(l, WT_IN), INC, D, H_LD, WK_D, 0, 16, 0, true, 40); }
#endif
            }
#endif
            { PH_BEGIN; pg8::EpiWin E{ws, A_->out, l}; RUN_GEMM_Q(pg8::EpiWin, E, P_H, WLY(l, WT_IN), INC, D, H_LD, WK_D, 0, 16, 0, W_PNMIX, l * 14 + 4); } }
        SEAM(pb + 3);
        if (IN(pb + 4)) for (int rep_ = 0; rep_ < ((DUPX == 99 || (DUPX == 4 && l == 0)) ? 2 : 1); ++rep_) { const bool dry_ = ((DUPX == 99 || (DUPX == 4 && l == 0)) && rep_ == 0); (void)dry_;
            { PH_BEGIN; attn_ctx_phase(P_Q, P_K, P_V, A_->in[13] + l * 16, P_ATT, vcu, G, lds); }
            { PH_BEGIN; conv_a_phase(P_GLU, A_->in[15] + (size_t)l * 31 * DCA, A_->in[16] + l * DCA, A_->in[17] + l * DCA, P_CA, lds, vcu, (MC / 16 - vcu + G - 1) / G, G); }
            { PH_BEGIN; conv_b_phase(P_BG, P_CX, A_->in[19] + (size_t)l * 3 * DCA, P_CB, vcu, G, 0, MC); } }
        SEAM(pb + 4);
        if (IN(pb + 5)) for (int rep_ = 0; rep_ < ((DUPX == 99 || (DUPX == 5 && l == 0)) ? 2 : 1); ++rep_) { const bool dry_ = ((DUPX == 99 || (DUPX == 5 && l == 0)) && rep_ == 0); (void)dry_;
            { PH_BEGIN; pg8::EpiMixK E{P_MIX, P_GATES}; RUN_GEMM_Q(pg8::EpiMixK, E, P_ABR, WLY(l, WT_MIXB), D, ABR_K, ABR_LD, WK_MIX, 0, 16, 0, false, l * 14 + 5); }
            { PH_BEGIN; pg8::EpiWin E{ws, A_->out, l}; RUN_GEMM_Q(pg8::EpiWin, E, P_H, WLY(l, WT_IN), INC, D, H_LD, WK_D, 16, 32, 1, W_PNMIX, l * 14 + 6); } }
        SEAM(pb + 5);
        if (IN(pb + 6)) for (int rep_ = 0; rep_ < ((DUPX == 99 || (DUPX == 6 && l == 0)) ? 2 : 1); ++rep_) { const bool dry_ = ((DUPX == 99 || (DUPX == 6 && l == 0)) && rep_ == 0); (void)dry_;
            if (!((PROBE_G & 4) && dry_)) { PH_BEGIN; pg8::EpiResid E{P_X, MODLY(l) + 5 * D, P_X, dry_ ? 0.f : 1.0f, 1}; RUN_GEMM_Q(pg8::EpiResid, E, P_MIX, WLY(l, WT_OUT), D, D, MIX_LD, WK_D, 0, 16, 0, false, l * 14 + 7); }
#ifdef ATT_DUP
            for (int rep_ = 0; rep_ < 2; ++rep_)
#endif
            if (!((PROBE_G & 1) && dry_)) { PH_BEGIN; attn_lat_phase(P_Q, P_K, P_V, P_CK, P_CV, A_->in[13] + l * 16, P_ATT, l, bx, vcu, G, lds); }
#ifdef CONV_DUP
            for (int crep_ = 0; crep_ < 2; ++crep_)
#endif
            if (!((PROBE_G & 2) && dry_)) { PH_BEGIN; const int r_ = bx >> 3, x_ = bx & 7; const int nu = (M - MC) / 16, u0 = MC / 16;
              if (G != 256) conv_a_phase(P_GLU, A_->in[15] + (size_t)l * 31 * DCA, A_->in[16] + l * DCA, A_->in[17] + l * DCA, P_CA, lds, u0 + vcu, (nu - vcu + G - 1) / G, G);
              else if (r_ < 16) conv_a_phase(P_GLU, A_->in[15] + (size_t)l * 31 * DCA, A_->in[16] + l * DCA, A_->in[17] + l * DCA, P_CA, lds, u0 + r_ * 8 + x_, CONV_LO, 128);
              else conv_a_phase(P_GLU, A_->in[15] + (size_t)l * 31 * DCA, A_->in[16] + l * DCA, A_->in[17] + l * DCA, P_CA, lds, u0 + 128 * CONV_LO + (r_ - 16) * 8 + x_, 4 - CONV_LO, 128); }
            if (!((PROBE_G & 8) && dry_)) { PH_BEGIN; conv_b_phase(P_BG, P_CX, A_->in[19] + (size_t)l * 3 * DCA, P_CB, vcu, G, MC, M); } }
        SEAM(pb + 6);
        if (IN(pb + 7)) for (int rep_ = 0; rep_ < ((DUPX == 99 || (DUPX == 7 && l == 0)) ? 2 : 1); ++rep_) { const bool dry_ = ((DUPX == 99 || (DUPX == 7 && l == 0)) && rep_ == 0); (void)dry_; PH_BEGIN; pg8::EpiMixK E{P_MIX, P_GATES}; RUN_GEMM_Q(pg8::EpiMixK, E, P_ABR, WLY(l, WT_MIXB), D, ABR_K, ABR_LD, WK_MIX, 16, 32, 0, false, l * 14 + 8); }
        SEAM(pb + 7);
        if (IN(pb + 8)) for (int rep_ = 0; rep_ < ((DUPX == 99 || (DUPX == 8 && l == 0)) ? 2 : 1); ++rep_) { const bool dry_ = ((DUPX == 99 || (DUPX == 8 && l == 0)) && rep_ == 0); (void)dry_; NORM_C(2, 22, l)
            { PH_BEGIN; pg8::EpiResid E{P_X, MODLY(l) + 5 * D, P_X, dry_ ? 0.f : 1.0f, 1}; RUN_GEMM_Q(pg8::EpiResid, E, P_MIX, WLY(l, WT_OUT), D, D, MIX_LD, WK_D, 16, 32, 0, false, l * 14 + 9); } }
        SEAM(pb + 8);
        if (IN(pb + 9)) for (int rep_ = 0; rep_ < ((DUPX == 99 || (DUPX == 9 && l == 0)) ? 2 : 1); ++rep_) { const bool dry_ = ((DUPX == 99 || (DUPX == 9 && l == 0)) && rep_ == 0); (void)dry_; NORM_L(2, 22, l)
            { PH_BEGIN; pg8::EpiSwiglu E{P_ACT, ACT_LD}; RUN_GEMM_Q(pg8::EpiSwiglu, E, P_H, WLY(l, WT_2I), 2 * DFF, D, H_LD, WK_D, 0, 16, 0, false, l * 14 + 10); } }
        SEAM(pb + 9);
        if (IN(pb + 10)) for (int rep_ = 0; rep_ < ((DUPX == 99 || (DUPX == 10 && l == 0)) ? 2 : 1); ++rep_) { const bool dry_ = ((DUPX == 99 || (DUPX == 10 && l == 0)) && rep_ == 0); (void)dry_;
            { PH_BEGIN; pg8::EpiResid E{P_X, MODLY(l) + 8 * D, P_X, dry_ ? 0.f : 0.5f, 1}; RUN_GEMM_Q(pg8::EpiResid, E, P_ACT, WLY(l, WT_2O), D, DFF, ACT_LD, WK_FF, 0, 16, 0, false, l * 14 + 11); }
            { PH_BEGIN; pg8::EpiSwiglu E{P_ACT, ACT_LD}; RUN_GEMM_Q(pg8::EpiSwiglu, E, P_H, WLY(l, WT_2I), 2 * DFF, D, H_LD, WK_D, 16, 32, 1, false, l * 14 + 12); } }
        SEAM(pb + 10);
        if (IN(pb + 11)) for (int rep_ = 0; rep_ < ((DUPX == 99 || (DUPX == 11 && l == 0)) ? 2 : 1); ++rep_) { const bool dry_ = ((DUPX == 99 || (DUPX == 11 && l == 0)) && rep_ == 0); (void)dry_;
            if (l == 0) NORM_C(0, 8, 1)
            else { PH_BEGIN; norm_phase<true>(P_X, A_->in[25], nullptr, 0, nullptr, A_->out, vcu, G, 0, MC, true); }
            { PH_BEGIN; pg8::EpiResid E{P_X, MODLY(l) + 8 * D, P_X, dry_ ? 0.f : 0.5f, 1}; RUN_GEMM_Q(pg8::EpiResid, E, P_ACT, WLY(l, WT_2O), D, DFF, ACT_LD, WK_FF, 16, 32, 0, false, l * 14 + 13); } }
        SEAM(pb + 11);
    }
#ifdef PROBE_PHASE
    { XcdBarrier bb_ = bar; bb_.x = (unsigned)fresh_i((int)bar.x); bb_.bar = (unsigned*)(fresh_args()->ws + WS_CTL) + CW_BAR; xcd_barrier(bb_); }
    { PH_BEGIN; const unsigned long long* ts = (const unsigned long long*)(ws + WS_CTL + 131072);
      const unsigned long long t1 = __hip_atomic_load(ts + (PROBE_PHASE >= 100 ? 26 : PROBE_PHASE + 1), __ATOMIC_RELAXED, __HIP_MEMORY_SCOPE_AGENT), t0 = __hip_atomic_load(ts + (PROBE_PHASE >= 100 ? 0 : PROBE_PHASE), __ATOMIC_RELAXED, __HIP_MEMORY_SCOPE_AGENT);
      const float us = (float)(t1 - t0) * 0.01f, fac = 1.f + us * (PROBE_PHASE >= 100 ? 1e-4f : 1e-3f);
      norm_phase<true>(P_X, A_->in[25], nullptr, 0, nullptr, A_->out, vcu, G, MC, M, true);
      __syncthreads(); asm volatile("s_waitcnt vmcnt(0)" ::: "memory");
      const int tid_ = fresh_tid(), wv_ = tid_ >> 6, ln_ = tid_ & 63;
      for (int m = MC + vcu * NWAVES + wv_; m < M; m += G * NWAVES) { f32x4* o = (f32x4*)(A_->out + (size_t)m * D) + ln_;
#pragma unroll
          for (int j = 0; j < 8; ++j) o[64 * j] = o[64 * j] * fac; } }
#else
#ifdef DUP26
    if (IN(26)) for (int rep_ = 0; rep_ < DUP26; ++rep_) { PH_BEGIN; norm_phase<true>(P_X, A_->in[25], nullptr, 0, nullptr, A_->out, fresh_i(vcu), fresh_i(G) + fresh_i(rep_) * 0, MC, M, true); }
#else
    if (IN(26)) { PH_BEGIN; norm_phase<true>(P_X, A_->in[25], nullptr, 0, nullptr, A_->out, vcu, G, MC, M, true); }
#endif
#endif
#undef IN
#undef SEAM
}

extern "C" void kernel_launch(void* const* d_in, const int* in_sizes, int n_in, void* d_out, int out_size, void* d_ws, size_t ws_size, hipStream_t stream) {
    static int grid = 0;
    if (grid == 0) {
        if (n_in != 26 || ws_size < WS_END) { fprintf(stderr, "kernel_launch: built for 26 inputs and >= %zu bytes of workspace; got n_in %d, ws %zu; nothing launched\n", (size_t)WS_END, n_in, ws_size); grid = -1; return; }
        int dev = 0, cus = 0, per_cu = 0;
        if (hipGetDevice(&dev) != hipSuccess || hipDeviceGetAttribute(&cus, hipDeviceAttributeMultiprocessorCount, dev) != hipSuccess) { fprintf(stderr, "kernel_launch: device query failed\n"); grid = -1; return; }
        if (hipFuncSetAttribute((const void*)fwd, hipFuncAttributeMaxDynamicSharedMemorySize, LDS_BYTES) != hipSuccess) { fprintf(stderr, "kernel_launch: hipFuncSetAttribute failed\n"); grid = -1; return; }
        if (hipOccupancyMaxActiveBlocksPerMultiprocessor(&per_cu, (const void*)fwd, NTHR, LDS_BYTES) != hipSuccess || per_cu < 1)
            fprintf(stderr, "kernel_launch: note: occupancy query reports %d workgroups per CU\n", per_cu);
        (void)hipGetLastError();
        grid = cus;
    }
    if (grid < 0) return;
    if (hipMemsetAsync((char*)d_ws + WS_CTL, 0, CTL_ZERO_BYTES, stream) != hipSuccess) { fprintf(stderr, "kernel_launch: hipMemsetAsync failed\n"); return; }
    Args a{};
    for (int i = 0; i < 26; ++i) a.in[i] = (const float*)d_in[i];
    a.out = (float*)d_out; a.ws = (unsigned char*)d_ws;
#if MK_PER_PHASE
    for (int p = 0; p < N_PHASES; ++p) { a.ph_lo = p; a.ph_hi = p + 1; hipLaunchKernelGGL(fwd, dim3(grid), dim3(NTHR), LDS_BYTES, stream, a); }
#else
    a.ph_lo = 0; a.ph_hi = N_PHASES; hipLaunchKernelGGL(fwd, dim3(grid), dim3(NTHR), LDS_BYTES, stream, a);
#endif
    const hipError_t le = hipPeekAtLastError();
    if (le != hipSuccess) fprintf(stderr, "kernel_launch: launch failed: %s\n", hipGetErrorName(le));
}
```

```cpp
#include <hip/hip_runtime.h>
#include <cstdio>
#include <cstdint>

#ifndef MK_PER_PHASE
#define MK_PER_PHASE 0
#endif
constexpr int D = 2048, MC = 4096, ML = 8192, M = MC + ML, DFF = 5632, NMOD = 9 * D, INC = 14336;
constexpr int SEQC = 256, SEQL = 4096, PAST = 512, KVD = 512, DCA = 1024;
constexpr float EPS = 1e-6f;
constexpr size_t MiB = 1u << 20;
#ifndef ROW_PAD
#define ROW_PAD 64
#endif
constexpr int PADE = ROW_PAD;
constexpr int H_LD = D + PADE, ACT_LD = DFF + PADE, MIX_LD = D + PADE, ABR_K = 4096, ABR_LD = ABR_K + PADE, ABR_CA = 0, ABR_CB = 1024, ABR_ATT = 2048;
constexpr int WK_D = D + PADE, WK_FF = DFF + PADE, WK_MIX = ABR_K + PADE;
constexpr size_t WS_CTL = 0, CTL_ZERO_BYTES = 1 * MiB;
constexpr size_t WS_MOD = 1 * MiB, WS_ROPE = 2 * MiB, WS_CK = 3 * MiB, WS_CV = 5 * MiB, WS_X = 8 * MiB, WS_H = 104 * MiB;
constexpr size_t WS_ACT = 154 * MiB;
constexpr size_t WS_Q = 154 * MiB, WS_K = 202 * MiB, WS_V = 214 * MiB, WS_GLU = 226 * MiB, WS_BG = 250 * MiB, WS_CX = 274 * MiB, WS_GATES = 298 * MiB;
constexpr size_t WS_ABR = 442 * MiB, WS_MIX = 540 * MiB;
constexpr size_t WS_WT = 590 * MiB, WT_LAYER = 222 * MiB;
constexpr size_t WT_1I = 0, WT_1O = 46 * MiB, WT_IN = 69 * MiB, WT_MIXB = 127 * MiB  , WT_OUT = 144 * MiB, WT_2I = 153 * MiB, WT_2O = 199 * MiB;
constexpr size_t WS_END = WS_WT + 2 * WT_LAYER;
static_assert((size_t)M * H_LD * 2 <= 50 * MiB && (size_t)M * ACT_LD * 2 <= 134 * MiB && (size_t)M * ABR_LD * 2 <= 98 * MiB && (size_t)M * MIX_LD * 2 <= 50 * MiB, "activation map");
static_assert((size_t)2 * DFF * WK_D * 2 <= 46 * MiB && (size_t)D * WK_FF * 2 <= 23 * MiB && (size_t)INC * WK_D * 2 <= 58 * MiB && (size_t)D * WK_MIX * 2 <= 17 * MiB && (size_t)D * WK_D * 2 <= 9 * MiB, "weight map");
constexpr int CW_Q = 32768;
constexpr int CW_BAR = 4096;

__device__ __forceinline__ size_t xt_off(int row, int col) { return ((size_t)((row >> 8) * (D / 256) + (col >> 8)) << 16) + (size_t)(((row & 255) << 8) + (col & 255)); }

__device__ __forceinline__ int fresh_tid() { int t = threadIdx.x; asm volatile("" : "+v"(t)); return t; }

__device__ __forceinline__ int fresh_i(int v) { asm volatile("" : "+s"(v)); return v; }
struct Args { const float* in[26]; float* out; unsigned char* ws; int ph_lo, ph_hi; };
__device__ __forceinline__ const Args* fresh_args() { auto p = __builtin_amdgcn_kernarg_segment_ptr(); asm volatile("" : "+s"(p)); return (const Args*)p; }

namespace pg8 {
#define PG8_LAS __attribute__((address_space(3)))
typedef unsigned short bf16_t;
typedef short bf16x8 __attribute__((ext_vector_type(8)));
typedef float f32x4 __attribute__((ext_vector_type(4)));
typedef unsigned u32x4 __attribute__((ext_vector_type(4)));
constexpr int BM = 256, BK = 64, HALF = 128, HTB = HALF * BK * 2  , STAGE_BYTES = 8 * HTB, NXCD = 8, WGM = 8;

__host__ __device__ __forceinline__ int lds_byte(int r, int c) { const int st = (r >> 4) * 2 + (c >> 5), rr = r & 15, cc = c & 31, ob = rr * 64 + cc * 2; return st * 1024 + (ob ^ (((ob >> 9) & 1) << 5)); }
__host__ __device__ __forceinline__ void stage_rc(int b, int& R, int& C) { const int st = b / 1024, sb = b % 1024, swz = sb ^ (((sb >> 9) & 1) << 5); R = (st >> 1) * 16 + swz / 64; C = (st & 1) * 32 + (swz % 64) / 2; }
__host__ __device__ __forceinline__ int perm32(int rho) { const int n = rho >> 4, i = rho & 15; return 8 * (i >> 2) + 4 * n + (i & 3); }

struct Unit { int pm, pn; };
struct Gemm { const bf16_t* A; const bf16_t* Bt; int M, N, K; int hit = 0, hitpm = 0; };

struct StaticOrder {
    int nM, nN, nwg, G, c;
    __host__ __device__ void init(int M, int N, int G_, int c_) { nM = M / BM; nN = N / BM; nwg = nM * nN; G = G_; c = c_; }
    __host__ __device__ bool next(int i, Unit& u) const {
        const long L = (long)i * G + c; if (L >= nwg) return false;
        int wgid = (int)L; { const int q = nwg / NXCD, r = nwg % NXCD, xcd = wgid % NXCD, off = wgid / NXCD; wgid = (xcd < r ? xcd * (q + 1) : r * (q + 1) + (xcd - r) * q) + off; }
        const int nig = WGM * nN, gid = wgid / nig, fm = gid * WGM, gsz = (nM - fm) < WGM ? (nM - fm) : WGM;
        u.pm = fm + ((wgid % nig) % gsz); u.pn = (wgid % nig) / gsz; return true;
    }
    __device__ __forceinline__ void a_ready(const Unit&) const {}
    __device__ __forceinline__ void done(const Unit&) const {}
};

__device__ __forceinline__ unsigned cvt_pk_bf16(float lo, float hi) { unsigned r; asm volatile("v_cvt_pk_bf16_f32 %0, %1, %2" : "=v"(r) : "v"(lo), "v"(hi)); return r; }
typedef float f32x2 __attribute__((ext_vector_type(2)));
__device__ __forceinline__ f32x2 gelu_pk(f32x2 v) {
    const f32x2 av = __builtin_elementwise_abs(v), d = av * 0.2316418882f + 1.0f;
    f32x2 t; t.x = __builtin_amdgcn_rcpf(d.x); t.y = __builtin_amdgcn_rcpf(d.y);
    f32x2 q = t * 0.5307027145f + (-0.7265760135f); q = q * t + 0.7107068705f; q = q * t + (-0.142248368f); q = q * t + 0.127414796f; q = q * t;
    const f32x2 s = (v * v) * (-0.72134752044f);
    f32x2 e; e.x = __builtin_amdgcn_exp2f(s.x); e.y = __builtin_amdgcn_exp2f(s.y);
    const f32x2 m = v * (q * e), r = v - m;
    f32x2 o; o.x = v.x < 0.f ? m.x : r.x; o.y = v.y < 0.f ? m.y : r.y; return o;
}

struct UnitK : Unit { int half, rofs; };
__device__ __forceinline__ float fsigm(float x) { return __builtin_amdgcn_rcpf(1.f + __builtin_amdgcn_exp2f(-1.4426950408889634f * x)); }
__device__ __forceinline__ float fsilu(float x) { return x * fsigm(x); }
__device__ __forceinline__ u32x4 pack8(f32x4 a, f32x4 b) { u32x4 w; w.x = cvt_pk_bf16(a[0], a[1]); w.y = cvt_pk_bf16(a[2], a[3]); w.z = cvt_pk_bf16(b[0], b[1]); w.w = cvt_pk_bf16(b[2], b[3]); return w; }
__device__ __forceinline__ void unpack8(u32x4 w, f32x4& a, f32x4& b) {
    a[0] = __builtin_bit_cast(float, w.x << 16); a[1] = __builtin_bit_cast(float, w.x & 0xffff0000u); a[2] = __builtin_bit_cast(float, w.y << 16); a[3] = __builtin_bit_cast(float, w.y & 0xffff0000u);
    b[0] = __builtin_bit_cast(float, w.z << 16); b[1] = __builtin_bit_cast(float, w.z & 0xffff0000u); b[2] = __builtin_bit_cast(float, w.w << 16); b[3] = __builtin_bit_cast(float, w.w & 0xffff0000u);
}
enum { PO_SWIGLU = 0, PO_GLU = 1, PO_MUL = 2 };
template <int OP> __device__ __forceinline__ f32x4 pair_op(f32x4 a, f32x4 b) {
    f32x4 o;
#pragma unroll
    for (int e = 0; e < 4; ++e) o[e] = OP == PO_SWIGLU ? fsilu(a[e]) * b[e] : (OP == PO_GLU ? a[e] * fsigm(b[e]) : a[e] * b[e]);
    return o;
}
__device__ __forceinline__ int gt_reg(int wr, int wc, int fr, int fq, int ai, int m, int bj) { return ((((((wr * 4 + wc) * 2 + ai) * 4 + m) * 2 + bj) << 6) + ((fq << 4) | fr)) << 3; }
__device__ __forceinline__ size_t gt_off(int stage, int pm, int pn) { return (size_t)((stage * (::M / 256) + pm) * 8 + pn) << 16; }
struct EpiSwiglu {
    static constexpr bool PERM = true, AFTER_DRAIN = false, RESCALE = false, PREFETCH = false;
    bf16_t* O; int ldc;
    __device__ __forceinline__ void operator()(const f32x4 (&acc)[2][2][4][2], const UnitK& u, int wr, int wc, int fr, int fq, PG8_LAS unsigned char* ldsb) const {
        const int row0 = u.pm * BM + u.rofs + wr * 64 + fr, col0 = u.pn * HALF + wc * 32 + 8 * fq;
#pragma unroll
        for (int ai = 0; ai < 2; ++ai) { if (ai == 1 && u.half) break;
#pragma unroll
            for (int m = 0; m < 4; ++m) {
                bf16_t* rowp = O + (size_t)(row0 + ai * HALF + m * 16) * ldc + col0;
                *(u32x4*)rowp = pack8(pair_op<PO_SWIGLU>(acc[ai][0][m][0], acc[ai][1][m][0]), pair_op<PO_SWIGLU>(acc[ai][0][m][1], acc[ai][1][m][1]));
            } }
    }
};
#ifndef RESID_BATCH
#define RESID_BATCH 4
#endif
#if defined(PROBE_HIT) && PROBE_HIT >= 2
#define RESID_PROBE 1
#else
#define RESID_PROBE 0
#endif
constexpr int EPI_T_OFF_ = 133120;
struct EpiResid {
    static constexpr bool PERM = true, AFTER_DRAIN = false, RESCALE = false, PREFETCH = false;
    float* X; const float* gate; const float* Xs; float coef; int xs_tiled;
    __device__ __forceinline__ void operator()(const f32x4 (&acc)[2][2][4][2], const UnitK& u, int wr, int wc, int fr, int fq, PG8_LAS unsigned char* ldsb) const {
        const int lane = (fq << 4) | fr, wv = wr * 4 + wc;
        PG8_LAS float* tw = (PG8_LAS float*)(ldsb + EPI_T_OFF_) + wv * 576;
        PG8_LAS float* twr = tw + fr * 36 + 8 * fq;
        const PG8_LAS float* trd = tw + (lane >> 3) * 36 + 4 * (lane & 7);
        const int cond = u.pm < 16 ? 0 : (u.pm < 32 ? 1 : 2);
        const int colT = u.pn * BM + wc * 32 + 4 * (lane & 7);
        f32x4 gT[2];
#pragma unroll
        for (int bj = 0; bj < 2; ++bj) gT[bj] = *(const f32x4*)(gate + (size_t)cond * NMOD + colT + bj * HALF) * coef;
        const int rloc = u.rofs + wr * 64 + (lane >> 3), cloc = wc * 32 + 4 * (lane & 7);
        const unsigned offX0 = (unsigned)(((((u.pm * (D / 256) + u.pn) << 16) + (rloc << 8) + cloc)) * 4);
        const unsigned offS0 = xs_tiled ? offX0 : (unsigned)(((u.pm * BM + rloc) * D + u.pn * BM + cloc) * 4);
        const unsigned rsS = xs_tiled ? 1024u : (unsigned)(D * 4); constexpr unsigned tsS = (unsigned)(HALF * 4);
        const char* Xsb = (const char*)Xs; char* Xb = (char*)X;
        f32x4 xq[2][2][2];
#define RESID_LD(q, gi) do { _Pragma("unroll") for (int bj = 0; bj < 2; ++bj) _Pragma("unroll") for (int h = 0; h < 2; ++h) \
            xq[q][bj][h] = *(const f32x4*)(Xsb + (size_t)(offS0 + (unsigned)(((gi) >> 2) * HALF + ((gi) & 3) * 16 + 8 * h) * rsS + (unsigned)bj * tsS)); } while (0)
        const int ngrp = u.half ? 4 : 8;
        RESID_LD(0, 0);
#pragma unroll
        for (int gi = 0; gi < 8; ++gi) { if (gi >= ngrp) break;
            const int ai = gi >> 2, m = gi & 3, q = gi & 1;
            if (gi + 1 < ngrp) RESID_LD(q ^ 1, gi + 1);
#pragma unroll
            for (int bj = 0; bj < 2; ++bj) {
                *(PG8_LAS f32x4*)twr = acc[ai][bj][m][0]; *(PG8_LAS f32x4*)(twr + 4) = acc[ai][bj][m][1];
                asm volatile("" ::: "memory");
                f32x4 t0 = *(const PG8_LAS f32x4*)trd, t1 = *(const PG8_LAS f32x4*)(trd + 8 * 36);
                asm volatile("" ::: "memory");
                if (RESID_PROBE && coef == 0.f) { t0 = (f32x4){0.f, 0.f, 0.f, 0.f}; t1 = t0; }
                const f32x4 y0 = xq[q][bj][0] + gT[bj] * t0, y1 = xq[q][bj][1] + gT[bj] * t1;
                *(f32x4*)(Xb + (size_t)(offX0 + (unsigned)(((ai * HALF + m * 16) * 256 + bj * HALF) * 4))) = y0;
                *(f32x4*)(Xb + (size_t)(offX0 + (unsigned)(((ai * HALF + m * 16 + 8) * 256 + bj * HALF) * 4))) = y1; }
        }
#undef RESID_LD
    }
};
struct EpiWin {
    static constexpr bool PERM = true, AFTER_DRAIN = false, RESCALE = false, PREFETCH = false;
    unsigned char* ws; float* out; int layer;
    __device__ __forceinline__ void operator()(const f32x4 (&acc)[2][2][4][2], const UnitK& u, int wr, int wc, int fr, int fq, PG8_LAS unsigned char* ldsb) const {
        bf16_t* const Qb = (bf16_t*)(ws + WS_Q); bf16_t* const Kb = (bf16_t*)(ws + WS_K); bf16_t* const Vb = (bf16_t*)(ws + WS_V); bf16_t* const GLU = (bf16_t*)(ws + WS_GLU); bf16_t* const BG = (bf16_t*)(ws + WS_BG);
        bf16_t* const CX = (bf16_t*)(ws + WS_CX); bf16_t* const GATES = (bf16_t*)(ws + WS_GATES); const float* const rope = (const float*)(ws + WS_ROPE);
        float* const nk = out + (size_t)M * D; float* const nv = nk + (size_t)16 * 2 * SEQC * KVD;
        const int pn = u.pn, row0 = u.pm * BM + u.rofs + wr * 64 + fr, cw = wc * 32 + 8 * fq;
        const bool latent = u.pm >= 16;
        if (pn < 10) {
            const bool isq = pn < 8; const int hp = isq ? pn : pn - 8;
            const int ocol = (2 * hp + (wc >> 1)) * 128 + 64 * (wc & 1) + 8 * fq;
            bf16_t* base = isq ? Qb : Kb; const int ld = isq ? D : KVD;
#pragma unroll
            for (int ai = 0; ai < 2; ++ai) { if (ai == 1 && u.half) break;
#pragma unroll
                for (int m = 0; m < 4; ++m) {
                    const int row = row0 + ai * HALF + m * 16;
                    const f32x4 x1a = acc[ai][0][m][0], x1b = acc[ai][0][m][1], x2a = acc[ai][1][m][0], x2b = acc[ai][1][m][1];
                    f32x4 o1a = x1a, o1b = x1b, o2a = x2a, o2b = x2b;
                    if (latent) {
                        const int t = (row - MC) & (SEQL - 1), pos = (wc & 1) ? (t & 63) : (t >> 6);
                        const f32x4* rp = (const f32x4*)(rope + ((size_t)pos * 32 + 8 * fq) * 2);
                        const f32x4 r0 = rp[0], r1 = rp[1], r2 = rp[2], r3 = rp[3];
                        o1a[0] = x1a[0] * r0[0] - x2a[0] * r0[1]; o2a[0] = x2a[0] * r0[0] + x1a[0] * r0[1];
                        o1a[1] = x1a[1] * r0[2] - x2a[1] * r0[3]; o2a[1] = x2a[1] * r0[2] + x1a[1] * r0[3];
                        o1a[2] = x1a[2] * r1[0] - x2a[2] * r1[1]; o2a[2] = x2a[2] * r1[0] + x1a[2] * r1[1];
                        o1a[3] = x1a[3] * r1[2] - x2a[3] * r1[3]; o2a[3] = x2a[3] * r1[2] + x1a[3] * r1[3];
                        o1b[0] = x1b[0] * r2[0] - x2b[0] * r2[1]; o2b[0] = x2b[0] * r2[0] + x1b[0] * r2[1];
                        o1b[1] = x1b[1] * r2[2] - x2b[1] * r2[3]; o2b[1] = x2b[1] * r2[2] + x1b[1] * r2[3];
                        o1b[2] = x1b[2] * r3[0] - x2b[2] * r3[1]; o2b[2] = x2b[2] * r3[0] + x1b[2] * r3[1];
                        o1b[3] = x1b[3] * r3[2] - x2b[3] * r3[3]; o2b[3] = x2b[3] * r3[2] + x1b[3] * r3[3];
                    }
                    bf16_t* op = base + (size_t)row * ld + ocol;
                    *(u32x4*)op = pack8(o1a, o1b); *(u32x4*)(op + 32) = pack8(o2a, o2b);
                    if (!isq && !latent) { float* p = nk + ((size_t)((row >> 8) * 2 + layer) * SEQC + (row & 255)) * KVD + ocol;
                        *(f32x4*)p = x1a; *(f32x4*)(p + 4) = x1b; *(f32x4*)(p + 32) = x2a; *(f32x4*)(p + 36) = x2b; }
                } }
        } else if (pn < 12) {
#pragma unroll
            for (int ai = 0; ai < 2; ++ai) { if (ai == 1 && u.half) break;
#pragma unroll
                for (int m = 0; m < 4; ++m) {
                    const int row = row0 + ai * HALF + m * 16;
#pragma unroll
                    for (int bj = 0; bj < 2; ++bj) { const int col = (pn - 10) * BM + bj * HALF + cw;
                        *(u32x4*)(Vb + (size_t)row * KVD + col) = pack8(acc[ai][bj][m][0], acc[ai][bj][m][1]);
                        if (!latent) { float* p = nv + ((size_t)((row >> 8) * 2 + layer) * SEQC + (row & 255)) * KVD + col; *(f32x4*)p = acc[ai][bj][m][0]; *(f32x4*)(p + 4) = acc[ai][bj][m][1]; } }
                } }
        } else if (pn < 20 || (pn >= 24 && pn < 32)) {
            const bool glu = pn < 20; bf16_t* base = glu ? GLU : CX; const int col = (glu ? pn - 12 : pn - 24) * HALF + cw;
#pragma unroll
            for (int ai = 0; ai < 2; ++ai) { if (ai == 1 && u.half) break;
#pragma unroll
                for (int m = 0; m < 4; ++m) {
                    bf16_t* op = base + (size_t)(row0 + ai * HALF + m * 16) * DCA + col;
                    if (glu) *(u32x4*)op = pack8(pair_op<PO_GLU>(acc[ai][0][m][0], acc[ai][1][m][0]), pair_op<PO_GLU>(acc[ai][0][m][1], acc[ai][1][m][1]));
                    else     *(u32x4*)op = pack8(pair_op<PO_MUL>(acc[ai][0][m][0], acc[ai][1][m][0]), pair_op<PO_MUL>(acc[ai][0][m][1], acc[ai][1][m][1]));
                } }
        } else if (pn < 24) {
#pragma unroll
            for (int ai = 0; ai < 2; ++ai) { if (ai == 1 && u.half) break;
#pragma unroll
                for (int m = 0; m < 4; ++m)
#pragma unroll
                    for (int bj = 0; bj < 2; ++bj)
                        *(u32x4*)(BG + (size_t)(row0 + ai * HALF + m * 16) * DCA + (pn - 20) * BM + bj * HALF + cw) = pack8(acc[ai][bj][m][0], acc[ai][bj][m][1]); }
        } else {
#pragma unroll
            for (int ai = 0; ai < 2; ++ai) { if (ai == 1 && u.half) break;
#pragma unroll
                for (int m = 0; m < 4; ++m)
#pragma unroll
                    for (int bj = 0; bj < 2; ++bj) { f32x4 a = acc[ai][bj][m][0], b = acc[ai][bj][m][1];
#pragma unroll
                        for (int e = 0; e < 4; ++e) { a[e] = fmaxf(fsigm(a[e]), 1e-20f); b[e] = fmaxf(fsigm(b[e]), 1e-20f); }
                        *(u32x4*)(GATES + gt_off((pn - 32) >> 3, u.pm, (pn - 32) & 7) + gt_reg(wr, wc, fr, fq, ai, m, bj)) = pack8(a, b); } }
        }
    }
};
struct EpiMixK {
    static constexpr bool PERM = true, AFTER_DRAIN = false, RESCALE = true, PREFETCH = false;
    bf16_t* MIX; const bf16_t* GATES;
    __device__ __forceinline__ void rescale(f32x4 (&acc)[2][2][4][2], const UnitK& u, int stage, int wr, int wc, int fr, int fq) const {
        const int row0 = u.pm * BM + u.rofs + wr * 64 + fr, col0 = u.pn * BM + wc * 32 + 8 * fq;
#pragma unroll
        for (int ai = 0; ai < 2; ++ai) { if (ai == 1 && u.half) break;
            u32x4 gn[4][2], gd[4][2];
#pragma unroll
            for (int m = 0; m < 4; ++m) {
                const bf16_t* gp = GATES + gt_off(stage, u.pm, u.pn);
#pragma unroll
                for (int bj = 0; bj < 2; ++bj) { gn[m][bj] = *(const u32x4*)(gp + gt_reg(wr, wc, fr, fq, ai, m, bj)); gd[m][bj] = *(const u32x4*)(gp + gt_off(1, 0, 0) + gt_reg(wr, wc, fr, fq, ai, m, bj)); } }
            __builtin_amdgcn_sched_barrier(0);
#pragma unroll
            for (int m = 0; m < 4; ++m)
#pragma unroll
                for (int bj = 0; bj < 2; ++bj) { f32x4 na, nb, da, db; unpack8(gn[m][bj], na, nb); unpack8(gd[m][bj], da, db);
#pragma unroll
                    for (int e_ = 0; e_ < 4; ++e_) { acc[ai][bj][m][0][e_] *= na[e_] * __builtin_amdgcn_rcpf(da[e_]); acc[ai][bj][m][1][e_] *= nb[e_] * __builtin_amdgcn_rcpf(db[e_]); } }
        }
    }
    __device__ __forceinline__ void operator()(const f32x4 (&acc)[2][2][4][2], const UnitK& u, int wr, int wc, int fr, int fq, PG8_LAS unsigned char* ldsb) const {
        const int row0 = u.pm * BM + u.rofs + wr * 64 + fr, col0 = u.pn * BM + wc * 32 + 8 * fq;
#pragma unroll
        for (int ai = 0; ai < 2; ++ai) { if (ai == 1 && u.half) break;
            u32x4 gc[4][2];
#pragma unroll
            for (int m = 0; m < 4; ++m)
#pragma unroll
                for (int bj = 0; bj < 2; ++bj) gc[m][bj] = *(const u32x4*)(GATES + gt_off(2, u.pm, u.pn) + gt_reg(wr, wc, fr, fq, ai, m, bj));
            __builtin_amdgcn_sched_barrier(0);
#pragma unroll
            for (int m = 0; m < 4; ++m) {
                const size_t row = (size_t)(row0 + ai * HALF + m * 16);
#pragma unroll
                for (int bj = 0; bj < 2; ++bj) { const int col = col0 + bj * HALF;
                    f32x4 ga, gb; unpack8(gc[m][bj], ga, gb);
                    *(u32x4*)(MIX + row * MIX_LD + col) = pack8(ga * acc[ai][bj][m][0], gb * acc[ai][bj][m][1]); }
            } }
    }
};

template <int MM, int NN, int KK, bool HT> struct TailOrder {
    static constexpr bool QUEUE = false;
    static constexpr int nM = MM / BM, nN = NN / BM, nwg = nM * nN;
    int G, c;
    __device__ __forceinline__ void init(int G_, int c_) { G = G_; c = c_; }
    __device__ __forceinline__ void map(int L, UnitK& u) const {
        int wgid = L; { constexpr int q = nwg / NXCD, r = nwg % NXCD; const int xcd = wgid % NXCD, off = wgid / NXCD; wgid = (xcd < r ? xcd * (q + 1) : r * (q + 1) + (xcd - r) * q) + off; }
        constexpr int nig = WGM * nN; const int gid = wgid / nig, fm = gid * WGM, gsz = (nM - fm) < WGM ? (nM - fm) : WGM;
        u.pm = fm + ((wgid % nig) % gsz); u.pn = (wgid % nig) / gsz; }
    __device__ __forceinline__ bool next(int i, UnitK& u) const {
        const int F = nwg / G, Rem = nwg - F * G;
        const int s0 = Rem > 0 ? G / Rem : 1; const int s = (HT && Rem > 0 && (G % 8 == 0) && (G % Rem == 0) && ((G / 8) % s0 == 0) && s0 >= 2) ? s0 : 1;
        const bool ht = s > 1; const int x = c & 7, y = c >> 3, q = ht ? y % s : 0;
        const bool tail = i == F;
        const bool has = i < F || (tail && (ht ? q < 2 : c < Rem));
        if (i > F || !has) return false;
        const int L = (tail && ht) ? F * G + x + 8 * (y / s) : i * G + c;
        map(L, u); u.half = (tail && ht) ? 1 : 0; u.rofs = (tail && ht) ? 128 * q : 0;
        return true; }
    __device__ __forceinline__ void a_ready(const Unit&) const {}
    __device__ __forceinline__ void done(const Unit&) const {}
};

template <int NN, int PM0, int NML, int R, int KA, int KB, bool PNMIX = false> struct DealOrder {
    static constexpr bool QUEUE = false;
    static constexpr int nN = NN / BM, U = NML * nN, Q = U / 8;
    static_assert(NML % 8 == 0 && R * KA + (32 - R) * KB == Q, "DealOrder: the per-rank counts must cover the XCD chunk exactly");
    int G, c;
    __device__ __forceinline__ void init(int G_, int c_) { G = G_; c = c_; }
    __device__ __forceinline__ bool next(int i, UnitK& u) const {
        const bool grid_ok = G == 256; const int x = c & 7, r = c >> 3;
        const int cnt = grid_ok ? (r < R ? KA : KB) : (U - c + G - 1) / G;
        if (i >= cnt) return false;
        constexpr int lo = KA < KB ? KA : KB;
        const int idx = i < lo ? i * 32 + r : (KA > KB ? lo * 32 + (i - lo) * R + r : lo * 32 + (i - lo) * (32 - R) + (r - R));
        const int L = grid_ok ? x * Q + idx : i * G + c;
        constexpr int nig = 8 * nN; const int gid = L / nig, rem = L % nig;
        const int pj = rem >> 3;
        u.pm = PM0 + gid * 8 + (rem & 7); u.pn = PNMIX ? ((pj & 1) ? nN / 2 + (pj >> 1) : (pj >> 1)) : pj; u.half = 0; u.rofs = 0;
        return true; }
    __device__ __forceinline__ void a_ready(const Unit&) const {}
    __device__ __forceinline__ void done(const Unit&) const {}
};

#ifndef B_AUX
#define B_AUX 0
#endif
#define QGRP_C_DEFAULT 4
#ifndef QGRP_C
#define QGRP_C QGRP_C_DEFAULT
#endif
#ifndef QGRP
#define QGRP 4
#endif
template <int NN, int PM0, int NML, int TYPE, bool PNMIX = false> struct QueueOrder {
    static constexpr bool QUEUE = true;
    static constexpr int nN = NN / BM, U = NML * nN, Q = U / 8;
    static_assert(NML % 8 == 0 && NML % QGRP == 0 && 16 % QGRP_C == 0, "QueueOrder: whole panel groups");
    int G, c; unsigned* head;
    __device__ __forceinline__ void init(int G_, int c_, unsigned* head_) { G = G_; c = c_; head = head_; }
    __device__ __forceinline__ bool dynamic() const { return G == 256 && Q > 32; }
    __device__ __forceinline__ void decode(int L, UnitK& u) const {
        constexpr int GRP = (NML == 16) ? QGRP_C : QGRP; constexpr int nig = GRP * nN; const int gid = L / nig, rem = L % nig; int pj = rem / GRP;
#ifdef USE_STAGGER
        if (Q % nig == 0) { pj += (c & 7) * (nN / 8); if (pj >= nN) pj -= nN; }
#endif
        u.pm = PM0 + gid * GRP + (rem % GRP); u.pn = PNMIX ? ((pj & 1) ? nN / 2 + (pj >> 1) : (pj >> 1)) : pj; u.half = 0; u.rofs = 0; }
    __device__ __forceinline__ bool first(UnitK& u) const {
        if (G != 256) { if (c >= U) return false; decode(c, u); return true; }
        const int x = c & 7, r = c >> 3, idx = TYPE == 0 ? r : (r >= 16 ? r - 16 : r + 16);
        if (idx >= Q) return false; decode(x * Q + idx, u); return true; }
    __device__ __forceinline__ unsigned* ticket_word() const { return head + 64 * (c & 7); }
    __device__ __forceinline__ bool later(int i, unsigned ticket, UnitK& u) const {
        if (G != 256) { const long L = (long)i * G + c; if (L >= U) return false; decode((int)L, u); return true; }
        if (!dynamic()) return false;
        const int idx = 32 + (int)ticket; if (idx >= Q) return false; decode((c & 7) * Q + idx, u); return true; }
    __device__ __forceinline__ void a_ready(const Unit&) const {}
    __device__ __forceinline__ void done(const Unit&) const {}
};
template <class Epi, class Sched, int KK, int LDA, int LDB>
__device__ __forceinline__ void gemm_phase_ht(PG8_LAS unsigned char* lds, const Gemm g, const Sched& S, const Epi& E) {
#ifdef NO_SP2
    constexpr bool ALIGN_EPI = true, SP2 = false;
#else
    constexpr bool ALIGN_EPI = true, SP2 = true;
#endif
    const int tid = fresh_tid(), wid = __builtin_amdgcn_readfirstlane(tid >> 6), lane = tid & 63, wr = wid >> 2, wc = wid & 3, fr = lane & 15, fq = lane >> 4;
    constexpr int K = KK, nt = K / BK, NKB = KK / 32;
    unsigned voffA[2], voffB[2];
#pragma unroll
    for (int i = 0; i < 2; ++i) { int R, C; stage_rc(tid * 16 + i * 8192, R, C); const int Rb = Epi::PERM ? ((R & ~31) + perm32(R & 31)) : R;
        voffA[i] = (unsigned)(R * LDA + C) * 2u; voffB[i] = (unsigned)((((Rb >> 4) * NKB + (C >> 5)) << 9) + ((Rb & 15) << 5) + (C & 31)) * 2u; }
    constexpr size_t kstep = (size_t)(BK * 2), kstepB = 2048;
    constexpr size_t hstepA = (size_t)HALF * LDA * 2, hstepB = (size_t)(HALF / 16) * NKB * 1024;
    constexpr size_t tstepA = 2 * hstepA, tstepB = 2 * hstepB;
    const unsigned ldsb32 = (unsigned)(__UINTPTR_TYPE__)lds; (void)ldsb32;
    const unsigned ldsw = (unsigned)wid * 1024u;
    const int aoff = lds_byte(wr * 64 + fr, fq * 8), boff = lds_byte(wc * 32 + fr, fq * 8);
#define PG8_SA(b, h) (((b) * 2 + (h)) * HTB)
#define PG8_SB(b, h) ((4 + (b) * 2 + (h)) * HTB)
#ifndef PROBE_HIT
#define PROBE_HIT 0
#endif
#ifdef KNOB_NOPRIO
#define PG8_PRIO_HI
#define PG8_PRIO_LO
#else
#define PG8_PRIO_HI __builtin_amdgcn_s_setprio(1)
#define PG8_PRIO_LO __builtin_amdgcn_s_setprio(0)
#endif
#ifdef KNOB_SADDR
#define PG8_STAGE(bufoff, gbase, voff) do { if ((PROBE_HIT == 2 || PROBE_HIT == 5) && g.hit) break; _Pragma("unroll") for (int _i = 0; _i < 2; ++_i) { \
        const unsigned la_ = ldsb32 + (unsigned)(bufoff) + ldsw + (unsigned)_i * 8192u; const char* gb_ = (const char*)(gbase); \
        asm volatile("s_mov_b32 m0, %2\n\ts_nop 0\n\tglobal_load_lds_dwordx4 %0, %1" :: "v"((voff)[_i]), "s"(gb_), "s"(la_) : "memory"); } } while (0)
#define PG8_STAGEB(bufoff, gbase, voff) PG8_STAGE(bufoff, gbase, voff)
#else
#define PG8_STAGE(bufoff, gbase, voff) do { if ((PROBE_HIT == 2 || PROBE_HIT == 5) && g.hit) break; _Pragma("unroll") for (int _i = 0; _i < 2; ++_i) \
        __builtin_amdgcn_global_load_lds((const unsigned*)((const char*)(gbase) + (voff)[_i]), (PG8_LAS unsigned*)(lds + (bufoff) + ldsw + _i * 8192), 16, 0, 0); } while (0)
#define PG8_STAGEB(bufoff, gbase, voff) do { if ((PROBE_HIT == 2 || PROBE_HIT == 5) && g.hit) break; _Pragma("unroll") for (int _i = 0; _i < 2; ++_i) \
        __builtin_amdgcn_global_load_lds((const unsigned*)((const char*)(gbase) + (voff)[_i]), (PG8_LAS unsigned*)(lds + (bufoff) + ldsw + _i * 8192), 16, 0, B_AUX); } while (0)
#endif
#define PG8_LDA(dst, b, h) do { if ((PROBE_HIT == 4 || PROBE_HIT == 5) && g.hit) break; _Pragma("unroll") for (int m = 0; m < 4; ++m) _Pragma("unroll") for (int k = 0; k < 2; ++k) dst[m][k] = *(const PG8_LAS bf16x8*)(lds + PG8_SA(b, h) + aoff + m * 2048 + k * 1024); } while (0)
#define PG8_LDB(dst, b, h) do { if ((PROBE_HIT == 4 || PROBE_HIT == 5) && g.hit) break; _Pragma("unroll") for (int n = 0; n < 2; ++n) _Pragma("unroll") for (int k = 0; k < 2; ++k) dst[n][k] = *(const PG8_LAS bf16x8*)(lds + PG8_SB(b, h) + boff + n * 2048 + k * 1024); } while (0)
#define PG8_MMA(ai, bj, At, Bt) do { if (PROBE_HIT == 3 && g.hit) break; PG8_PRIO_HI; _Pragma("unroll") for (int m = 0; m < 4; ++m) _Pragma("unroll") for (int n = 0; n < 2; ++n) _Pragma("unroll") for (int k = 0; k < 2; ++k) \
        acc[ai][bj][m][n] = __builtin_amdgcn_mfma_f32_16x16x32_bf16(Bt[n][k], At[m][k], acc[ai][bj][m][n], 0, 0, 0); PG8_PRIO_LO; } while (0)
#define PG8_WAIT_V(n) asm volatile("s_waitcnt vmcnt(" #n ")" ::: "memory")
#define PG8_WAIT_L(n) asm volatile("s_waitcnt lgkmcnt(" #n ")" ::: "memory")
#define PG8_BAR __builtin_amdgcn_s_barrier()
#define PG8_SCHED __builtin_amdgcn_sched_barrier(0)
    UnitK cur, nxt; int ui = 0;
    if constexpr (Sched::QUEUE) { if (!S.first(cur)) return; } else { if (!S.next(0, cur)) return; }
    volatile PG8_LAS unsigned* tkw = (volatile PG8_LAS unsigned*)(lds + STAGE_BYTES + 1024);
    f32x4 acc[2][2][4][2];
#pragma unroll
    for (int a = 0; a < 2; ++a)
#pragma unroll
        for (int b = 0; b < 2; ++b)
#pragma unroll
            for (int m = 0; m < 4; ++m)
#pragma unroll
                for (int n = 0; n < 2; ++n) acc[a][b][m][n] = (f32x4){0.f, 0.f, 0.f, 0.f};
    bf16x8 At[4][2], B0[2][2], B1[2][2];
    const char* cA = (const char*)g.A + (size_t)(g.hit ? g.hitpm : cur.pm) * tstepA + (size_t)cur.rofs * (LDA * 2); const char* cB = (const char*)g.Bt + (size_t)(g.hit ? 0 : cur.pn) * tstepB;
    S.a_ready(cur);
    if constexpr (SP2) {
        PG8_STAGEB(PG8_SB(0, 0), cB, voffB); PG8_STAGEB(PG8_SB(0, 1), cB + hstepB, voffB); PG8_STAGE(PG8_SA(0, 0), cA, voffA); PG8_STAGE(PG8_SA(0, 1), cA + hstepA, voffA);
        if (wr == 1) PG8_BAR;
        PG8_WAIT_V(2); PG8_BAR;
        PG8_STAGEB(PG8_SB(1, 0), cB + kstepB, voffB); PG8_STAGE(PG8_SA(1, 0), cA + kstep, voffA); PG8_STAGEB(PG8_SB(1, 1), cB + hstepB + kstepB, voffB);
        PG8_WAIT_V(6); PG8_BAR;
#ifdef KNOB_ASYM
        if (wr == 1) PG8_STAGE(PG8_SA(1, 1), cA + kstep + hstepA, voffA);
#endif
    } else {
        PG8_STAGEB(PG8_SB(0, 0), cB, voffB); PG8_STAGE(PG8_SA(0, 0), cA, voffA); PG8_STAGEB(PG8_SB(0, 1), cB + hstepB, voffB); PG8_STAGE(PG8_SA(0, 1), cA + hstepA, voffA);
        if (wr == 1) PG8_BAR;
        PG8_WAIT_V(4); PG8_BAR;
        PG8_STAGEB(PG8_SB(1, 0), cB + kstepB, voffB); PG8_STAGE(PG8_SA(1, 0), cA + kstep, voffA); PG8_STAGEB(PG8_SB(1, 1), cB + hstepB + kstepB, voffB);
        PG8_WAIT_V(6); PG8_BAR;
    }
    for (;;) {
        bool has_next = false; const char* nA = cA; const char* nB = cB; unsigned tk_ = 0u;
        if constexpr (Sched::QUEUE) { if (S.dynamic() && tid == 0) tk_ = __hip_atomic_fetch_add(S.ticket_word(), 1u, __ATOMIC_RELAXED, __HIP_MEMORY_SCOPE_AGENT); }
        else { has_next = S.next(ui + 1, nxt);
            nA = has_next ? (const char*)g.A + (size_t)(g.hit ? g.hitpm : nxt.pm) * tstepA + (size_t)nxt.rofs * (LDA * 2) : cA; nB = has_next ? (const char*)g.Bt + (size_t)(g.hit ? 0 : nxt.pn) * tstepB : cB; }
        for (int t = 0; t < nt; t += 2) {
            if constexpr (Epi::RESCALE) { if (t == 16 || t == 32) { const int tid_r = fresh_tid(); E.rescale(acc, cur, t == 16 ? 0 : 1, wr, wc, tid_r & 15, (tid_r & 63) >> 4); } }
            if constexpr (Epi::PREFETCH) { if (nt >= 32 && t == nt - 16) { const int tid_p = fresh_tid(); E.prefetch(cur, wid, tid_p & 63); } }
            const bool last = (t == nt - 2);
            if constexpr (Sched::QUEUE) {
                if (t == 4 && tid == 0) *tkw = tk_;
                if (last) { const unsigned tkv = S.dynamic() ? (unsigned)__builtin_amdgcn_readfirstlane((int)*tkw) : 0u; has_next = S.later(ui + 1, tkv, nxt);
                    nA = has_next ? (const char*)g.A + (size_t)(g.hit ? g.hitpm : nxt.pm) * tstepA + (size_t)nxt.rofs * (LDA * 2) : cA; nB = has_next ? (const char*)g.Bt + (size_t)(g.hit ? 0 : nxt.pn) * tstepB : cB; } }
            const char* a1 = cA + (size_t)(t + 1) * kstep;
            const char* a2 = last ? nA : cA + (size_t)(t + 2) * kstep; const char* b2 = last ? nB : cB + (size_t)(t + 2) * kstepB;
            const char* a3 = a2 + kstep; const char* b3 = b2 + kstepB;
            if (last && has_next) S.a_ready(nxt);
            if constexpr (SP2) {
#ifdef KNOB_ASYM
            PG8_LDB(B0, 0, 0); PG8_LDB(B1, 0, 1); PG8_SCHED; PG8_LDA(At, 0, 0);
            if (wr == 0) { PG8_STAGE(PG8_SA(1, 1), a1 + hstepA, voffA); }
            PG8_WAIT_V(8);
            PG8_WAIT_L(0); PG8_BAR;
            if (wr == 1) { PG8_STAGEB(PG8_SB(0, 0), b2, voffB); PG8_STAGEB(PG8_SB(0, 1), b2 + hstepB, voffB); PG8_STAGE(PG8_SA(0, 0), a2, voffA); }
            PG8_MMA(0, 0, At, B0); PG8_MMA(0, 1, At, B1); PG8_BAR; PG8_SCHED;
            PG8_LDA(At, 0, 1);
            if (wr == 0) { PG8_STAGEB(PG8_SB(0, 0), b2, voffB); PG8_STAGEB(PG8_SB(0, 1), b2 + hstepB, voffB); PG8_STAGE(PG8_SA(0, 0), a2, voffA); }
            PG8_WAIT_V(8);
            PG8_WAIT_L(0); PG8_BAR;
            if (wr == 1) { PG8_STAGE(PG8_SA(0, 1), a2 + hstepA, voffA); }
            if (!cur.half) { PG8_MMA(1, 0, At, B0); PG8_MMA(1, 1, At, B1); } PG8_BAR; PG8_SCHED;
            PG8_LDB(B0, 1, 0); PG8_LDB(B1, 1, 1); PG8_SCHED; PG8_LDA(At, 1, 0);
            if (wr == 0) { PG8_STAGE(PG8_SA(0, 1), a2 + hstepA, voffA); }
            PG8_WAIT_V(8);
            PG8_WAIT_L(0); PG8_BAR;
            if (wr == 1) { PG8_STAGEB(PG8_SB(1, 0), b3, voffB); PG8_STAGEB(PG8_SB(1, 1), b3 + hstepB, voffB); PG8_STAGE(PG8_SA(1, 0), a3, voffA); }
            PG8_MMA(0, 0, At, B0); PG8_MMA(0, 1, At, B1); PG8_BAR; PG8_SCHED;
            PG8_LDA(At, 1, 1);
            if (wr == 0) { PG8_STAGEB(PG8_SB(1, 0), b3, voffB); PG8_STAGEB(PG8_SB(1, 1), b3 + hstepB, voffB); PG8_STAGE(PG8_SA(1, 0), a3, voffA); }
            PG8_WAIT_V(8);
            PG8_WAIT_L(0); PG8_BAR;
            if (wr == 1) { PG8_STAGE(PG8_SA(1, 1), a3 + hstepA, voffA); }
            if (!cur.half) { PG8_MMA(1, 0, At, B0); PG8_MMA(1, 1, At, B1); } PG8_BAR; PG8_SCHED;
#else
#ifdef KNOB_FILLFIRST
            PG8_STAGE(PG8_SA(1, 1), a1 + hstepA, voffA); PG8_SCHED; PG8_LDB(B0, 0, 0); PG8_LDB(B1, 0, 1); PG8_SCHED; PG8_LDA(At, 0, 0);
#else
            PG8_LDB(B0, 0, 0); PG8_LDB(B1, 0, 1); PG8_SCHED; PG8_LDA(At, 0, 0); PG8_STAGE(PG8_SA(1, 1), a1 + hstepA, voffA);
#endif
            PG8_WAIT_V(8); PG8_WAIT_L(0); PG8_BAR; PG8_MMA(0, 0, At, B0); PG8_MMA(0, 1, At, B1); PG8_BAR; PG8_SCHED;
#ifdef KNOB_FILLFIRST
            PG8_STAGEB(PG8_SB(0, 0), b2, voffB); PG8_STAGEB(PG8_SB(0, 1), b2 + hstepB, voffB); PG8_STAGE(PG8_SA(0, 0), a2, voffA); PG8_SCHED; PG8_LDA(At, 0, 1);
#else
            PG8_LDA(At, 0, 1); PG8_STAGEB(PG8_SB(0, 0), b2, voffB); PG8_STAGEB(PG8_SB(0, 1), b2 + hstepB, voffB); PG8_STAGE(PG8_SA(0, 0), a2, voffA);
#endif
            PG8_WAIT_V(8); PG8_WAIT_L(0); PG8_BAR; if (!cur.half) { PG8_MMA(1, 0, At, B0); PG8_MMA(1, 1, At, B1); } PG8_BAR; PG8_SCHED;
#ifdef KNOB_FILLFIRST
            PG8_STAGE(PG8_SA(0, 1), a2 + hstepA, voffA); PG8_SCHED; PG8_LDB(B0, 1, 0); PG8_LDB(B1, 1, 1); PG8_SCHED; PG8_LDA(At, 1, 0);
#else
            PG8_LDB(B0, 1, 0); PG8_LDB(B1, 1, 1); PG8_SCHED; PG8_LDA(At, 1, 0); PG8_STAGE(PG8_SA(0, 1), a2 + hstepA, voffA);
#endif
            PG8_WAIT_V(8); PG8_WAIT_L(0); PG8_BAR; PG8_MMA(0, 0, At, B0); PG8_MMA(0, 1, At, B1); PG8_BAR; PG8_SCHED;
#ifdef KNOB_FILLFIRST
            PG8_STAGEB(PG8_SB(1, 0), b3, voffB); PG8_STAGEB(PG8_SB(1, 1), b3 + hstepB, voffB); PG8_STAGE(PG8_SA(1, 0), a3, voffA); PG8_SCHED; PG8_LDA(At, 1, 1);
#else
            PG8_LDA(At, 1, 1); PG8_STAGEB(PG8_SB(1, 0), b3, voffB); PG8_STAGEB(PG8_SB(1, 1), b3 + hstepB, voffB); PG8_STAGE(PG8_SA(1, 0), a3, voffA);
#endif
            PG8_WAIT_V(8); PG8_WAIT_L(0); PG8_BAR; if (!cur.half) { PG8_MMA(1, 0, At, B0); PG8_MMA(1, 1, At, B1); } PG8_BAR; PG8_SCHED;
#endif
            } else {
            PG8_LDB(B0, 0, 0); PG8_SCHED; PG8_LDA(At, 0, 0); PG8_STAGE(PG8_SA(1, 1), a1 + hstepA, voffA);
            PG8_WAIT_L(8); PG8_BAR; PG8_WAIT_L(0); PG8_MMA(0, 0, At, B0); PG8_BAR; PG8_SCHED;
            PG8_LDB(B1, 0, 1); PG8_STAGEB(PG8_SB(0, 0), b2, voffB);
            PG8_BAR; PG8_WAIT_L(0); PG8_MMA(0, 1, At, B1); PG8_BAR;
            PG8_LDA(At, 0, 1); PG8_STAGE(PG8_SA(0, 0), a2, voffA);
            PG8_BAR; PG8_WAIT_L(0); PG8_MMA(1, 0, At, B0); PG8_BAR; PG8_SCHED;
            PG8_STAGEB(PG8_SB(0, 1), b2 + hstepB, voffB);
            PG8_WAIT_V(6); PG8_BAR; PG8_MMA(1, 1, At, B1); PG8_BAR;
            PG8_LDB(B0, 1, 0); PG8_SCHED; PG8_LDA(At, 1, 0); PG8_STAGE(PG8_SA(0, 1), a2 + hstepA, voffA);
            PG8_WAIT_L(8); PG8_BAR; PG8_WAIT_L(0); PG8_MMA(0, 0, At, B0); PG8_BAR; PG8_SCHED;
            PG8_LDB(B1, 1, 1); PG8_STAGEB(PG8_SB(1, 0), b3, voffB);
            PG8_BAR; PG8_WAIT_L(0); PG8_MMA(0, 1, At, B1); PG8_BAR;
            PG8_LDA(At, 1, 1); PG8_STAGE(PG8_SA(1, 0), a3, voffA);
            PG8_BAR; PG8_WAIT_L(0); PG8_MMA(1, 0, At, B0); PG8_BAR; PG8_SCHED;
            PG8_STAGEB(PG8_SB(1, 1), b3 + hstepB, voffB);
            PG8_WAIT_V(6); PG8_BAR; PG8_MMA(1, 1, At, B1); PG8_BAR;
            }
        }
        if constexpr (ALIGN_EPI) { if (wr == 0) PG8_BAR; }
        if (!(PROBE_HIT == 6 && g.hit)) { const int tid_e = fresh_tid(); E(acc, cur, wr, wc, tid_e & 15, (tid_e & 63) >> 4, lds); }
        if (!has_next) break;
#pragma unroll
        for (int a = 0; a < 2; ++a)
#pragma unroll
            for (int b = 0; b < 2; ++b)
#pragma unroll
                for (int m = 0; m < 4; ++m)
#pragma unroll
                    for (int n = 0; n < 2; ++n) acc[a][b][m][n] = (f32x4){0.f, 0.f, 0.f, 0.f};
        cur = nxt; cA = nA; cB = nB; ++ui;
        if constexpr (ALIGN_EPI) { if (wr == 1) PG8_BAR; }
    }
    PG8_WAIT_V(0);
    if constexpr (!ALIGN_EPI) { if (wr == 0) PG8_BAR; }
    PG8_BAR;
#undef PG8_SA
#undef PG8_SB
#undef PG8_STAGE
#undef PG8_STAGEB
#undef PG8_LDA
#undef PG8_LDB
#undef PG8_MMA
#undef PG8_WAIT_V
#undef PG8_WAIT_L
#undef PG8_BAR
#undef PG8_SCHED
}
}

namespace att {
typedef unsigned short bf16;
typedef short bf16x8 __attribute__((ext_vector_type(8)));
typedef short s16x4 __attribute__((ext_vector_type(4)));
typedef float f32x16 __attribute__((ext_vector_type(16)));
typedef unsigned u32x4 __attribute__((ext_vector_type(4)));
constexpr float SCALE = 0.08838834764831845f, THR = 8.f;
constexpr int SHM_V = 16384, SHM_K = 16384, NW = 8;
constexpr int LDS_BYTES = 2 * SHM_V + 2 * SHM_K + NW * 64 * 4;
#define KSWZ(row, colB) ((row) * 256 + ((colB) ^ (((row) & 7) << 4)))
#define SBAR() __builtin_amdgcn_sched_barrier(0)
__device__ __forceinline__ int v_st(int k, int c) { const int kk = (k & ~0xC) | ((k & 4) << 1) | ((k & 8) >> 1); return ((kk >> 3) * 4 + (c >> 5)) * 512 + ((kk & 7) * 32 + (c & 31)) * 2; }
__device__ __forceinline__ int v_rd_base(int lane) { return ((lane & 3) << 3) | (((lane >> 2) & 3) << 6) | (((lane >> 4) & 1) << 5) | (((lane >> 5) & 1) << 8); }
constexpr int v_rd_off(int d0, int ks, int half) { return d0 * 512 + ks * 4096 + half * 2048; }
__device__ __forceinline__ int crow(int r, int hi) { return (r & 3) + 8 * (r >> 2) + 4 * hi; }
__device__ __forceinline__ unsigned cvtpk(float lo, float hi) { unsigned r; asm volatile("v_cvt_pk_bf16_f32 %0, %1, %2" : "=v"(r) : "v"(lo), "v"(hi)); return r; }
__device__ __forceinline__ void mask_tile(f32x16& p0, f32x16& p1, int d, int type) {
    const float NEG = -__builtin_inff();
#pragma unroll
    for (int r = 0; r < 16; ++r) {
        const int c = (r & 3) + 8 * (r >> 2);
        if (type == 1) { if (c < d) p0[r] = NEG; if (c + 32 < d) p1[r] = NEG; }
        else           { if (c > d) p0[r] = NEG; if (c + 32 > d) p1[r] = NEG; }
    }
}
__device__ __forceinline__ void partialSM(f32x16& p0, f32x16& p1, float& m_reg, float& mn, float& alpha) {
    float pmax = p0[0]; for (int r = 1; r < 16; ++r) pmax = fmaxf(pmax, p0[r]); for (int r = 0; r < 16; ++r) pmax = fmaxf(pmax, p1[r]);
    { auto rr = __builtin_amdgcn_permlane32_swap(__float_as_uint(pmax), __float_as_uint(pmax), false, false);
      pmax = fmaxf(__uint_as_float(rr[0]), __uint_as_float(rr[1])); }
    constexpr float C2 = 1.4426950408889634f * SCALE;
    if (__builtin_expect(__all((pmax - m_reg) * SCALE <= THR), 1)) { mn = m_reg; alpha = 1.f; }
    else { mn = fmaxf(m_reg, pmax); alpha = __builtin_amdgcn_exp2f((m_reg - mn) * C2); m_reg = mn; }
    const float mnL = -mn * C2;
    for (int r = 0; r < 16; ++r) p0[r] = fmaf(p0[r], C2, mnL); for (int r = 0; r < 16; ++r) p1[r] = fmaf(p1[r], C2, mnL);
    for (int r = 0; r < 16; ++r) p0[r] = __builtin_amdgcn_exp2f(p0[r]);
}
__device__ __forceinline__ void finishSM(f32x16& p0, f32x16& p1, float alpha, float& l_reg, bf16x8& pa0, bf16x8& pa1, bf16x8& pa2, bf16x8& pa3) {
    for (int r = 0; r < 16; ++r) p1[r] = __builtin_amdgcn_exp2f(p1[r]);
    float ps = 0; for (int r = 0; r < 16; ++r) ps += p0[r]; for (int r = 0; r < 16; ++r) ps += p1[r];
    { auto rr = __builtin_amdgcn_permlane32_swap(__float_as_uint(ps), __float_as_uint(ps), false, false);
      ps = __uint_as_float(rr[0]) + __uint_as_float(rr[1]); }
    l_reg = l_reg * alpha + ps;
#define PK4(P, B_, OUT) do { unsigned a0 = cvtpk(P[B_+0], P[B_+1]), a1 = cvtpk(P[B_+2], P[B_+3]);                          \
        unsigned b0 = cvtpk(P[B_+4], P[B_+5]), b1 = cvtpk(P[B_+6], P[B_+7]);                                             \
        auto r0 = __builtin_amdgcn_permlane32_swap(a0, b0, false, false); auto r1 = __builtin_amdgcn_permlane32_swap(a1, b1, false, false); \
        u32x4 w = {r0[0], r1[0], r0[1], r1[1]}; OUT = *reinterpret_cast<bf16x8*>(&w); } while (0)
    PK4(p0, 0, pa0); PK4(p0, 8, pa1); PK4(p1, 0, pa2); PK4(p1, 8, pa3);
#undef PK4
}
template <int KB>
__device__ __forceinline__ void qkt(f32x16& p0, f32x16& p1, const char* K_lds, int r32, int hi, const bf16x8* qr) {
    p0 = f32x16{}; p1 = f32x16{};
    const char* kb[4];
#pragma unroll
    for (int dd = 0; dd < 4; ++dd) kb[dd] = K_lds + KB * SHM_K + KSWZ(r32, (dd * 16 + hi * 8) * 2);
#pragma unroll
    for (int d0 = 0; d0 < 8; ++d0) { const char* a = kb[d0 & 3] + (d0 >> 2) * 128;
        bf16x8 b0 = *reinterpret_cast<const bf16x8*>(a);
        bf16x8 b1 = *reinterpret_cast<const bf16x8*>(a + 32 * 256);
        p0 = __builtin_amdgcn_mfma_f32_32x32x16_bf16(b0, qr[d0], p0, 0, 0, 0);
        p1 = __builtin_amdgcn_mfma_f32_32x32x16_bf16(b1, qr[d0], p1, 0, 0, 0); }
}
template <int VB>
__device__ __forceinline__ void pv_tile(f32x16* o, int vb0, bf16x8 pa0, bf16x8 pa1, bf16x8 pa2, bf16x8 pa3) {
#define TRRD(dst, off) asm volatile("ds_read_b64_tr_b16 %0, %1 offset:%2" : "=&v"(dst) : "v"(vb0), "i"(off) : "memory")
#define PV_RD(S, d0) do { constexpr int b_ = VB * SHM_V + v_rd_off(d0, 0, 0); \
        TRRD(l0##S, b_); TRRD(h0##S, b_ + 2048); TRRD(l1##S, b_ + 4096); TRRD(h1##S, b_ + 6144); TRRD(l2##S, b_ + 8192); TRRD(h2##S, b_ + 10240); TRRD(l3##S, b_ + 12288); TRRD(h3##S, b_ + 14336); } while (0)
#define PV_MM(S, d0) do { \
        o[d0] = __builtin_amdgcn_mfma_f32_32x32x16_bf16(pa0, (bf16x8){l0##S[0], l0##S[1], l0##S[2], l0##S[3], h0##S[0], h0##S[1], h0##S[2], h0##S[3]}, o[d0], 0, 0, 0);   \
        o[d0] = __builtin_amdgcn_mfma_f32_32x32x16_bf16(pa1, (bf16x8){l1##S[0], l1##S[1], l1##S[2], l1##S[3], h1##S[0], h1##S[1], h1##S[2], h1##S[3]}, o[d0], 0, 0, 0);   \
        o[d0] = __builtin_amdgcn_mfma_f32_32x32x16_bf16(pa2, (bf16x8){l2##S[0], l2##S[1], l2##S[2], l2##S[3], h2##S[0], h2##S[1], h2##S[2], h2##S[3]}, o[d0], 0, 0, 0);   \
        o[d0] = __builtin_amdgcn_mfma_f32_32x32x16_bf16(pa3, (bf16x8){l3##S[0], l3##S[1], l3##S[2], l3##S[3], h3##S[0], h3##S[1], h3##S[2], h3##S[3]}, o[d0], 0, 0, 0); } while (0)
    s16x4 l0a, l1a, l2a, l3a, h0a, h1a, h2a, h3a, l0b, l1b, l2b, l3b, h0b, h1b, h2b, h3b;
    PV_RD(a, 0); PV_RD(b, 1);
    asm volatile("s_waitcnt lgkmcnt(8)" ::: "memory"); SBAR(); PV_MM(a, 0); SBAR();
    PV_RD(a, 2);
    asm volatile("s_waitcnt lgkmcnt(8)" ::: "memory"); SBAR(); PV_MM(b, 1); SBAR();
    PV_RD(b, 3);
    asm volatile("s_waitcnt lgkmcnt(8)" ::: "memory"); SBAR(); PV_MM(a, 2); SBAR();
    asm volatile("s_waitcnt lgkmcnt(0)" ::: "memory"); SBAR(); PV_MM(b, 3);
#undef PV_RD
#undef PV_MM
#undef TRRD
}
__device__ __forceinline__ void attn_unit(const bf16* Qw, const bf16* cK, const bf16* cV, const bf16* wK, const bf16* wV, int nctx, int NT, int tm1, int tm2, const float* sinkp, bf16* Ow, int ldo, char* lds) {
    const int tid = fresh_tid(), wid = __builtin_amdgcn_readfirstlane(tid >> 6), lane = tid & 63, r32 = lane & 31, hi = lane >> 5;
    char* V_lds = lds; char* K_lds = lds + 2 * SHM_V;
    float* wsf = (float*)(lds + 2 * SHM_V + 2 * SHM_K) + wid * 64; float* li_l = wsf, * al_l = wsf + 32;
    float m_reg = -1e30f, l_reg = 0; f32x16 o[4] = {};
    const int sr = tid >> 4, sc = (tid & 15) * 8, vst0 = v_st(sr, sc), vst1 = v_st(32 + sr, sc), kws = KSWZ(sr, sc * 2);
    const int vb0 = (int)(uintptr_t)V_lds + v_rd_base(lane);
    const int qrow = 32 * (wid & 1) + r32, hq = wid >> 1, dmask = qrow - 4 * hi;
    bf16x8 qr[8];
#pragma unroll
    for (int d0 = 0; d0 < 8; ++d0) qr[d0] = *(const bf16x8*)(Qw + (size_t)qrow * D + hq * 128 + d0 * 16 + hi * 8);
    bf16x8 st_v0a, st_v1a, st_k0a, st_k1a, st_v0b, st_v1b, st_k0b, st_k1b;
#define TILEP(t, kp, vp) const bf16* kp = (t) < nctx ? cK + (size_t)(t) * 64 * KVD : wK + (size_t)((t) - nctx) * 64 * KVD; const bf16* vp = (t) < nctx ? cV + (size_t)(t) * 64 * KVD : wV + (size_t)((t) - nctx) * 64 * KVD
#define SLOAD(t, S) do { TILEP(t, kp_, vp_); st_v0##S = *(const bf16x8*)(vp_ + (size_t)sr * KVD + sc); st_v1##S = *(const bf16x8*)(vp_ + (size_t)(32 + sr) * KVD + sc); \
                      st_k0##S = *(const bf16x8*)(kp_ + (size_t)sr * KVD + sc); st_k1##S = *(const bf16x8*)(kp_ + (size_t)(32 + sr) * KVD + sc); } while (0)
#define SWRITE(bf, S) do { *(bf16x8*)(V_lds + (bf) * SHM_V + vst0) = st_v0##S; *(bf16x8*)(V_lds + (bf) * SHM_V + vst1) = st_v1##S; \
                        *(bf16x8*)(K_lds + (bf) * SHM_K + kws) = st_k0##S; *(bf16x8*)(K_lds + (bf) * SHM_K + kws + 32 * 256) = st_k1##S; } while (0)
#define VMW() asm volatile("s_waitcnt vmcnt(0)" ::: "memory")
#define RESC(a) do { if (__any((a) < 1.f)) { if (hi == 0) al_l[r32] = (a); asm volatile("s_waitcnt lgkmcnt(0)" ::: "memory");              \
                     for (int d_ = 0; d_ < 4; ++d_) for (int r = 0; r < 16; ++r) o[d_][r] *= al_l[crow(r, hi)]; } } while (0)
    f32x16 p0, p1; float mn, al; bf16x8 pa0, pa1, pa2, pa3;
#define STEP(t, B, SN, SW) do { if ((t) + 2 < NT) SLOAD((t) + 2, SN); SBAR();     \
        qkt<B>(p0, p1, K_lds, r32, hi, qr);                                                                           \
        if ((t) == tm1) mask_tile(p0, p1, dmask, 1); else if ((t) == tm2) mask_tile(p0, p1, dmask, 2);                \
        partialSM(p0, p1, m_reg, mn, al); RESC(al); finishSM(p0, p1, al, l_reg, pa0, pa1, pa2, pa3); SBAR();          \
        pv_tile<B>(o, vb0, pa0, pa1, pa2, pa3);                                                                       \
        if ((t) + 1 < NT) { SWRITE((B) ^ 1, SW); }          \
        __syncthreads(); } while (0)
    SLOAD(0, a); if (NT > 1) SLOAD(1, b); SWRITE(0, a); __syncthreads();
    for (int t = 0; t < NT; t += 2) { STEP(t, 0, a, b); if (t + 1 < NT) STEP(t + 1, 1, b, a); }
    { constexpr float C2 = 1.4426950408889634f * SCALE; const float sk = sinkp[hq];
      l_reg += __builtin_amdgcn_exp2f(sk * 1.4426950408889634f - m_reg * C2); }
    if (hi == 0) li_l[r32] = l_reg; asm volatile("s_waitcnt lgkmcnt(0)" ::: "memory");
    float rli[16];
#pragma unroll
    for (int r = 0; r < 16; ++r) rli[r] = __builtin_amdgcn_rcpf(li_l[crow(r, hi)]);
    typedef unsigned ou4 __attribute__((ext_vector_type(4)));
    char* Ost = lds + wid * 8192;
#pragma unroll
    for (int r = 0; r < 16; ++r) { const int orow = crow(r, hi);
#pragma unroll
        for (int d0 = 0; d0 < 4; ++d0) { const float v = o[d0][r] * rli[r]; const float vn = __shfl_xor(v, 1);
            if ((r32 & 1) == 0) *(unsigned*)(Ost + orow * 256 + (d0 * 32 + r32) * 2) = cvtpk(v, vn); } }
    asm volatile("s_waitcnt lgkmcnt(0)" ::: "memory");
    bf16* Op = Ow + (size_t)(32 * (wid & 1)) * ldo + hq * 128;
    ou4 ov[8];
#pragma unroll
    for (int j = 0; j < 8; ++j) { const int c = j * 64 + lane; ov[j] = *(const ou4*)(Ost + (c >> 4) * 256 + (c & 15) * 16); }
#pragma unroll
    for (int j = 0; j < 8; ++j) { const int c = j * 64 + lane; *(ou4*)(Op + (size_t)(c >> 4) * ldo + (c & 15) * 8) = ov[j]; }
    __syncthreads();
#undef TILEP
#undef SLOAD
#undef SWRITE
#undef VMW
#undef RESC
#undef STEP
}
#undef KSWZ
#undef SBAR
}

#define GAS __attribute__((address_space(1)))
#define LAS __attribute__((address_space(3)))
typedef unsigned short bf16;
typedef unsigned v4u __attribute__((ext_vector_type(4)));
typedef float f32x4 __attribute__((ext_vector_type(4)));
typedef short bf16x8 __attribute__((ext_vector_type(8)));
typedef GAS unsigned gu32;
#define RLX_AGENT __ATOMIC_RELAXED, __HIP_MEMORY_SCOPE_AGENT
#define LDS_WAIT() asm volatile("s_waitcnt lgkmcnt(0)" ::: "memory")
#define VM_WAIT() asm volatile("s_waitcnt vmcnt(0)" ::: "memory")
__device__ __forceinline__ unsigned f2bf(float f) { unsigned u = __builtin_bit_cast(unsigned, f); return (u + 0x7fffu + ((u >> 16) & 1u)) >> 16; }
__device__ __forceinline__ unsigned pk2(float lo, float hi) { return f2bf(lo) | (f2bf(hi) << 16); }
__device__ __forceinline__ float bflo(unsigned w) { return __builtin_bit_cast(float, w << 16); }
__device__ __forceinline__ float bfhi(unsigned w) { return __builtin_bit_cast(float, w & 0xffff0000u); }
__device__ __forceinline__ float wave_sum(float v) {
#pragma unroll
    for (int o = 1; o < 64; o <<= 1) v += __shfl_xor(v, o);
    return v;
}
__device__ __forceinline__ float silu_acc(float x) { return x / (1.f + __expf(-x)); }
#define XB_TMO      128
#define XB_XCNT(j)  (256  + 64 * (j))
#define XB_XSUB(j)  (1280 + 64 * (j))
#define XB_XGEN(j)  (2304 + 64 * (j))
#define XB_TOP      3328
#define XB_TOPGEN   3392
#define XCD_BAR_WORDS 3456
#define XB_SPIN_CAP (1u << 18)

__device__ __forceinline__ unsigned xb_ld(unsigned* p)              { return __hip_atomic_load(p, __ATOMIC_RELAXED, __HIP_MEMORY_SCOPE_AGENT); }
__device__ __forceinline__ unsigned xb_add(unsigned* p, unsigned v) { return __hip_atomic_fetch_add(p, v, __ATOMIC_RELAXED, __HIP_MEMORY_SCOPE_AGENT); }
__device__ __forceinline__ unsigned xb_xcc_id() { return (unsigned)__builtin_amdgcn_s_getreg((3 << 11) | 20) & 0xFu; }
#define XB_SPIN(cond, bar) do { unsigned _sp = 0; while (cond) { __builtin_amdgcn_s_sleep(1); \
    if ((++_sp & 255u) == 0u) { if (xb_ld(&(bar)[XB_TMO])) break; if (_sp > XB_SPIN_CAP) { atomicAdd(&(bar)[XB_TMO], 1u); break; } } } } while (0)

struct XcdBarrier {
    unsigned* bar; unsigned x;
    volatile LAS unsigned* st;
};

__device__ __forceinline__ XcdBarrier xcd_barrier_post(unsigned* bar, volatile LAS unsigned* st) {
    XcdBarrier b; b.bar = bar; b.x = xb_xcc_id(); b.st = st;
    if (threadIdx.x == 0) (void)xb_add(&bar[XB_XCNT(b.x)], 1u);
    return b;
}
__device__ __forceinline__ void xcd_barrier_complete(unsigned* bar, unsigned x, unsigned& nloc, unsigned& nx) {
    const unsigned G = gridDim.x * gridDim.y * gridDim.z;
    unsigned sum, cnt, mine, sp = 0u;
    for (;;) {
        sum = 0u; cnt = 0u; mine = 0u;
#pragma unroll
        for (unsigned j = 0; j < 16; ++j) { const unsigned c = xb_ld(&bar[XB_XCNT(j)]); sum += c; cnt += (c > 0u) ? 1u : 0u; mine = (j == x) ? c : mine; }
        if (sum == G) break;
        __builtin_amdgcn_s_sleep(1);
        if ((++sp & 255u) == 0u) { if (xb_ld(&bar[XB_TMO])) break; if (sp > XB_SPIN_CAP) { atomicAdd(&bar[XB_TMO], 1u); break; } }
    }
    nloc = mine > 0u ? mine : 1u; nx = cnt > 0u ? cnt : 1u;
}

__device__ __forceinline__ void xcd_barrier(const XcdBarrier& b) {
    asm volatile("s_waitcnt vmcnt(0)" ::: "memory");
    __syncthreads();
    if (threadIdx.x == 0) {
        unsigned* bar = b.bar;
        __builtin_amdgcn_s_waitcnt(0);
        unsigned nloc = b.st[0], nx = b.st[1];
        if (nloc == 0u) { xcd_barrier_complete(bar, b.x, nloc, nx); b.st[0] = nloc; b.st[1] = nx; }
        const unsigned old = xb_add(&bar[XB_XSUB(b.x)], 1u);
        const unsigned gen = old / nloc;
        if (old + 1u == (gen + 1u) * nloc) {
            __builtin_amdgcn_fence(__ATOMIC_RELEASE, "agent");
            asm volatile("s_waitcnt vmcnt(0)" ::: "memory");
            const unsigned og = xb_add(&bar[XB_TOP], 1u);
            const unsigned tg = og / nx;
            if (og + 1u == (tg + 1u) * nx) xb_add(&bar[XB_TOPGEN], 1u);
            else XB_SPIN(xb_ld(&bar[XB_TOPGEN]) == tg, bar);
            __builtin_amdgcn_fence(__ATOMIC_ACQUIRE, "agent");
            xb_add(&bar[XB_XGEN(b.x)], 1u);
            asm volatile("s_waitcnt vmcnt(0)" ::: "memory");
        } else {
            XB_SPIN(xb_ld(&bar[XB_XGEN(b.x)]) == gen, bar);
            __builtin_amdgcn_fence(__ATOMIC_ACQUIRE, "agent");
            asm volatile("s_waitcnt vmcnt(0)" ::: "memory");
        }
    }
    __syncthreads();
}


constexpr int NWAVES = 8, NTHR = NWAVES * 64;
constexpr int RING_OFF = 0, RING_BYTES = 131072;
constexpr int LDSCTL_OFF = RING_BYTES, MISC_OFF = LDSCTL_OFF + 320;
static_assert(pg8::EPI_T_OFF_ == 133120, "slab offset");
constexpr int EPI_T_OFF = 133120, EPI_T_BYTES = 8 * 2304;
constexpr int LDS_BYTES = 155648;
static_assert(att::LDS_BYTES <= RING_BYTES && MISC_OFF + 128 <= EPI_T_OFF && RING_BYTES + 1024 + 64 <= EPI_T_OFF && EPI_T_OFF + EPI_T_BYTES <= LDS_BYTES && LDS_BYTES <= 163840, "LDS map");
constexpr int N_PHASES = 27;

__device__ __forceinline__ int dest_row(int kind, int n0) {
    if (kind == 1) { const int uv = n0 / DFF, j = n0 % DFF; return 256 * (j >> 7) + 128 * uv + (j & 127); }
    if (kind == 2) {
        if (n0 < 2560) { const int isk = n0 >= 2048, nn = isk ? n0 - 2048 : n0, head = nn >> 7, d = nn & 127, part = d >> 6, x = (d >> 5) & 1;
                         return 256 * ((isk ? 8 : 0) + (head >> 1)) + 128 * x + 64 * (head & 1) + 32 * part; }
        if (n0 < 3072) return n0;
        if (n0 < 5120) { const int nn = n0 - 3072, ag = nn >> 10, j = nn & 1023; return 256 * (12 + (j >> 7)) + 128 * ag + (j & 127); }
        if (n0 < 6144) return n0;
        if (n0 < 8192) { const int nn = n0 - 6144, xv = nn >> 10, j = nn & 1023; return 256 * (24 + (j >> 7)) + 128 * xv + (j & 127); }
        return n0;
    }
    return n0;
}
__device__ __forceinline__ void p0_transpose_item(const float* W, int K, int N, bf16* WT, int kind, LAS float* scr, int item, int lane, int ldk = 0, int koff = 0) {
    if (ldk == 0) ldk = K;
    const int nblk = N / 32, kb = item / nblk, nb = item % nblk, k0 = 64 * kb, n0 = 32 * nb, drow = dest_row(kind, n0);
    { float wv_[32];
#pragma unroll
      for (int i = 0; i < 32; ++i) wv_[i] = __builtin_nontemporal_load(W + (size_t)(k0 + 2 * i + (lane >> 5)) * N + n0 + (lane & 31));
#pragma unroll
      for (int i = 0; i < 32; ++i) scr[(2 * i + (lane >> 5)) * 33 + (lane & 31)] = wv_[i]; }
    LDS_WAIT(); asm volatile("" ::: "memory");
    const int c = lane & 7;
#pragma unroll
    for (int j = 0; j < 4; ++j) { const int n = (lane >> 3) + 8 * j; const LAS float* s = scr + (8 * c) * 33 + n;
        v4u o; o.x = pk2(s[0 * 33], s[1 * 33]); o.y = pk2(s[2 * 33], s[3 * 33]); o.z = pk2(s[4 * 33], s[5 * 33]); o.w = pk2(s[6 * 33], s[7 * 33]);
        const int r_ = drow + n, c_ = koff + k0 + 8 * c, nkb_ = (ldk - PADE) / 32;
        __builtin_nontemporal_store(o, (GAS v4u*)(WT + ((size_t)((r_ >> 4) * nkb_ + (c_ >> 5)) << 9) + ((r_ & 15) << 5) + (c_ & 31))); }
    LDS_WAIT(); asm volatile("" ::: "memory");
}
constexpr int I_FI = (D / 64) * (2 * DFF / 32), I_FO = (DFF / 64) * (D / 32), I_IN = (D / 64) * (INC / 32), I_DD = (D / 64) * (D / 32), I_HD = (DCA / 64) * (D / 32);
constexpr int I_LAYER = 2 * I_FI + 2 * I_FO + I_IN + 2 * I_DD + 2 * I_HD;

constexpr int R_1I = 0, R_1O = I_FI, R_IN = R_1O + I_FO, R_AO = R_IN + I_IN, R_OUT = R_AO + I_DD + 2 * I_HD, R_2I = R_OUT + I_DD, R_2O = R_2I + I_FI, R_END = R_2O + I_FO;
static_assert(R_END == I_LAYER, "item map");
__device__ __forceinline__ void convert_range(const Args& a, unsigned char* lds, int l, int r_lo, int r_hi, int wi, int nw) {
    const int tid = fresh_tid(), lane = tid & 63, wave = __builtin_amdgcn_readfirstlane(tid >> 6);
    LAS float* scr = (LAS float*)((LAS unsigned char*)lds + wave * 16384);
    unsigned char* wl = a.ws + WS_WT + (size_t)l * WT_LAYER;
    for (int it = r_lo + wi; it < r_hi; it += nw) {
        int r = it;
        if (r < I_FI) { p0_transpose_item(a.in[9] + (size_t)l * D * 2 * DFF, D, 2 * DFF, (bf16*)(wl + WT_1I), 1, scr, r, lane, WK_D, 0); continue; } r -= I_FI;
        if (r < I_FO) { p0_transpose_item(a.in[10] + (size_t)l * DFF * D, DFF, D, (bf16*)(wl + WT_1O), 0, scr, r, lane, WK_FF, 0); continue; } r -= I_FO;
        if (r < I_IN) { p0_transpose_item(a.in[12] + (size_t)l * D * INC, D, INC, (bf16*)(wl + WT_IN), 2, scr, r, lane, WK_D, 0); continue; } r -= I_IN;
        if (r < I_DD) { p0_transpose_item(a.in[14] + (size_t)l * D * D, D, D, (bf16*)(wl + WT_MIXB), 0, scr, r, lane, WK_MIX, 2048); continue; } r -= I_DD;
        if (r < I_HD) { p0_transpose_item(a.in[18] + (size_t)l * DCA * D, DCA, D, (bf16*)(wl + WT_MIXB), 0, scr, r, lane, WK_MIX, 0); continue; } r -= I_HD;
        if (r < I_HD) { p0_transpose_item(a.in[20] + (size_t)l * DCA * D, DCA, D, (bf16*)(wl + WT_MIXB), 0, scr, r, lane, WK_MIX, 1024); continue; } r -= I_HD;
        if (r < I_DD) { p0_transpose_item(a.in[21] + (size_t)l * D * D, D, D, (bf16*)(wl + WT_OUT), 0, scr, r, lane, WK_D, 0); continue; } r -= I_DD;
        if (r < I_FI) { p0_transpose_item(a.in[23] + (size_t)l * D * 2 * DFF, D, 2 * DFF, (bf16*)(wl + WT_2I), 1, scr, r, lane, WK_D, 0); continue; } r -= I_FI;
        p0_transpose_item(a.in[24] + (size_t)l * DFF * D, DFF, D, (bf16*)(wl + WT_2O), 0, scr, r, lane, WK_FF, 0);
    }
}
__device__ __forceinline__ void ada_layer(const Args& a, unsigned char* lds, int l, int bi, int nb, int item_lo = 0, int item_hi = NMOD / 64) {
    const int tid = fresh_tid(), lane = tid & 63, wave = __builtin_amdgcn_readfirstlane(tid >> 6);
    const float* c = a.in[4]; const float* c_ctx = a.in[5]; const float* w_ada = a.in[6]; const float* b_ada = a.in[7];
    float* sv = (float*)lds;
    float* part = (float*)(lds + 24576);
    __syncthreads();
    for (int i = tid; i < D; i += NTHR) { sv[i] = silu_acc(c_ctx[i]); sv[D + i] = silu_acc(c[i]); sv[2 * D + i] = silu_acc(c[D + i]); }
    __syncthreads();
    float* MOD = (float*)(a.ws + WS_MOD);
    for (int item = item_lo + bi; item < item_hi; item += nb) {
        const int j0 = item * 64;
        const float* w = w_ada + ((size_t)l * D + wave * 256) * NMOD + j0 + lane;
        const float* s0 = sv + wave * 256;
        float a0 = 0.f, a1 = 0.f, a2 = 0.f;
#pragma unroll 16
        for (int k = 0; k < 256; ++k) { const float x = w[(size_t)k * NMOD]; a0 += s0[k] * x; a1 += s0[D + k] * x; a2 += s0[2 * D + k] * x; }
        part[(wave * 3 + 0) * 64 + lane] = a0; part[(wave * 3 + 1) * 64 + lane] = a1; part[(wave * 3 + 2) * 64 + lane] = a2;
        __syncthreads();
        if (tid < 192) { const int cc = tid >> 6, j = tid & 63; float s = b_ada[l * NMOD + j0 + j];
#pragma unroll
            for (int wv = 0; wv < 8; ++wv) s += part[(wv * 3 + cc) * 64 + j];
            MOD[(size_t)(l * 3 + cc) * NMOD + j0 + j] = s; }
        __syncthreads();
    }
}
#ifndef CVT_CHUNK
#define CVT_CHUNK 2
#endif
constexpr int CW_CVT = 16384;
__device__ __forceinline__ void convert_item(const Args& a, LAS float* scr, int gi, int lane) {
    const int l = gi < I_LAYER ? 1 : 0; int r = gi < I_LAYER ? gi : gi - I_LAYER;
    unsigned char* wl = a.ws + WS_WT + (size_t)l * WT_LAYER;
    if (r < I_FI) { p0_transpose_item(a.in[9] + (size_t)l * D * 2 * DFF, D, 2 * DFF, (bf16*)(wl + WT_1I), 1, scr, r, lane, WK_D, 0); return; } r -= I_FI;
    if (r < I_FO) { p0_transpose_item(a.in[10] + (size_t)l * DFF * D, DFF, D, (bf16*)(wl + WT_1O), 0, scr, r, lane, WK_FF, 0); return; } r -= I_FO;
    if (r < I_IN) { p0_transpose_item(a.in[12] + (size_t)l * D * INC, D, INC, (bf16*)(wl + WT_IN), 2, scr, r, lane, WK_D, 0); return; } r -= I_IN;
    if (r < I_DD) { p0_transpose_item(a.in[14] + (size_t)l * D * D, D, D, (bf16*)(wl + WT_MIXB), 0, scr, r, lane, WK_MIX, 2048); return; } r -= I_DD;
    if (r < I_HD) { p0_transpose_item(a.in[18] + (size_t)l * DCA * D, DCA, D, (bf16*)(wl + WT_MIXB), 0, scr, r, lane, WK_MIX, 0); return; } r -= I_HD;
    if (r < I_HD) { p0_transpose_item(a.in[20] + (size_t)l * DCA * D, DCA, D, (bf16*)(wl + WT_MIXB), 0, scr, r, lane, WK_MIX, 1024); return; } r -= I_HD;
    if (r < I_DD) { p0_transpose_item(a.in[21] + (size_t)l * D * D, D, D, (bf16*)(wl + WT_OUT), 0, scr, r, lane, WK_D, 0); return; } r -= I_DD;
    if (r < I_FI) { p0_transpose_item(a.in[23] + (size_t)l * D * 2 * DFF, D, 2 * DFF, (bf16*)(wl + WT_2I), 1, scr, r, lane, WK_D, 0); return; } r -= I_FI;
    p0_transpose_item(a.in[24] + (size_t)l * DFF * D, DFF, D, (bf16*)(wl + WT_2O), 0, scr, r, lane, WK_FF, 0);
}
__device__ __forceinline__ void convert_all(const Args& a, unsigned char* lds, int vcu, int G) {
    const int tid = fresh_tid(), lane = tid & 63, wave = __builtin_amdgcn_readfirstlane(tid >> 6);
    LAS float* scr = (LAS float*)((LAS unsigned char*)lds + wave * 16384);
    constexpr int TOT = 2 * I_LAYER, PER = TOT / 8, CH = CVT_CHUNK, NCH = PER / CH;
    static_assert(TOT % 8 == 0 && PER % CH == 0, "conversion chunks");
    if (G != 256) { for (int gi = vcu * NWAVES + wave; gi < TOT; gi += G * NWAVES) convert_item(a, scr, gi, lane); return; }
    const int x = vcu >> 5, r = vcu & 31;
    unsigned* cnt = (unsigned*)(a.ws + WS_CTL) + CW_CVT + 64 * x;
    int ch = r * NWAVES + wave;
    while (ch < NCH) {
        unsigned nx = 0u; if (lane == 0) nx = __hip_atomic_fetch_add(cnt, 1u, __ATOMIC_RELAXED, __HIP_MEMORY_SCOPE_AGENT);
#pragma unroll 1
        for (int j = 0; j < CH; ++j) convert_item(a, scr, x * PER + ch * CH + j, lane);
        ch = 256 + __builtin_amdgcn_readfirstlane((int)nx);
    }
}
__device__ __forceinline__ void ada_all(const Args& a, unsigned char* lds, int bi, int nb) {
    const int tid = fresh_tid(), lane = tid & 63, wave = __builtin_amdgcn_readfirstlane(tid >> 6);
    const float* c = a.in[4]; const float* c_ctx = a.in[5]; const float* w_ada = a.in[6]; const float* b_ada = a.in[7];
    float* sv = (float*)lds;
    float* part = (float*)(lds + 24576);
    __syncthreads();
    for (int i = tid; i < D; i += NTHR) { sv[i] = silu_acc(c_ctx[i]); sv[D + i] = silu_acc(c[i]); sv[2 * D + i] = silu_acc(c[D + i]); }
    __syncthreads();
    float* MOD = (float*)(a.ws + WS_MOD);
    constexpr int NI = NMOD / 64;
    for (int it = bi; it < 2 * NI; it += nb) {
        const int l = it / NI, j0 = (it - l * NI) * 64;
        const float* w = w_ada + ((size_t)l * D + wave * 256) * NMOD + j0 + lane;
        const float* s0 = sv + wave * 256;
        float a0 = 0.f, a1 = 0.f, a2 = 0.f;
#pragma unroll 1
        for (int kk = 0; kk < 256; kk += 32) { float xw[32];
#pragma unroll
            for (int i = 0; i < 32; ++i) xw[i] = __builtin_nontemporal_load(w + (size_t)(kk + i) * NMOD);
#pragma unroll
            for (int i = 0; i < 32; ++i) { a0 += s0[kk + i] * xw[i]; a1 += s0[D + kk + i] * xw[i]; a2 += s0[2 * D + kk + i] * xw[i]; } }
        part[(wave * 3 + 0) * 64 + lane] = a0; part[(wave * 3 + 1) * 64 + lane] = a1; part[(wave * 3 + 2) * 64 + lane] = a2;
        __syncthreads();
        if (tid < 192) { const int cc = tid >> 6, j = tid & 63; float s = b_ada[l * NMOD + j0 + j];
#pragma unroll
            for (int wv = 0; wv < 8; ++wv) s += part[(wv * 3 + cc) * 64 + j];
            MOD[(size_t)(l * 3 + cc) * NMOD + j0 + j] = s; }
        __syncthreads();
    }
}
#ifndef FILL_MASK
#define FILL_MASK 0
#endif
__device__ __forceinline__ void filler(const Args& a, unsigned char* lds, int job, int idle, int nidle) {
    const int wave = __builtin_amdgcn_readfirstlane(fresh_tid() >> 6), wi = idle * NWAVES + wave, nw = nidle * NWAVES;
    if (job == 1) convert_range(a, lds, 0, R_IN, R_AO, wi, nw);
    else if (job == 2) convert_range(a, lds, 0, R_AO, R_END, wi, nw);
    else if (job == 3) ada_layer(a, lds, 1, idle, nidle, 0, NMOD / 128);
    else if (job == 7) ada_layer(a, lds, 1, idle, nidle, NMOD / 128, NMOD / 64);
    else if (job == 4) convert_range(a, lds, 1, R_1I, R_IN, wi, nw);
    else if (job == 5) convert_range(a, lds, 1, R_IN, R_AO, wi, nw);
    else if (job == 6) convert_range(a, lds, 1, R_AO, R_END, wi, nw);
}
__device__ __forceinline__ void prologue(const Args& a, unsigned char* lds, int vcu, int G) {
    const int tid = fresh_tid(), wave = __builtin_amdgcn_readfirstlane(tid >> 6);
    unsigned char* ws = a.ws;
#ifdef PROLOGUE_STATIC
    ada_layer(a, lds, 0, vcu, G); ada_layer(a, lds, 1, vcu, G);
    convert_range(a, lds, 1, 0, R_END, vcu * NWAVES + wave, G * NWAVES); convert_range(a, lds, 0, 0, R_END, vcu * NWAVES + wave, G * NWAVES);
#else
    ada_all(a, lds, vcu, G);
    convert_all(a, lds, vcu, G);
#endif
    {
        const int gt = vcu * NTHR + tid, NT = G * NTHR;
        const int n8 = 2 * 2 * PAST * KVD / 8;
        for (int i = gt; i < 2 * n8; i += NT) { const bool isk = i < n8; const int j = isk ? i : i - n8;
            const f32x4* s = (const f32x4*)((isk ? a.in[2] : a.in[3]) + (size_t)j * 8); const f32x4 x = s[0], y = s[1];
            v4u o; o.x = pk2(x[0], x[1]); o.y = pk2(x[2], x[3]); o.z = pk2(y[0], y[1]); o.w = pk2(y[2], y[3]);
            *(v4u*)(ws + (isk ? WS_CK : WS_CV) + (size_t)j * 16) = o; }
        if (gt < 64 * 32) { const int pos = gt >> 5, i = gt & 31; const float inv = powf(10000.f, -(float)i / 32.f), ang = (float)pos * inv;
            float* rp = (float*)(ws + WS_ROPE) + (size_t)gt * 2; rp[0] = cosf(ang); rp[1] = sinf(ang); }
    }
}
template <bool FINAL>
__device__ __forceinline__ void norm_phase(const float* X, const float* g, const float* MODl, int sub, bf16* H, float* out, int vcu, int G, int row_lo, int row_hi, bool xt) {
    const int tid = fresh_tid(), lane = tid & 63, gw = vcu * NWAVES + __builtin_amdgcn_readfirstlane(tid >> 6), NGW = G * NWAVES;
    int m = row_lo + gw;
    if (m >= row_hi) return;
    f32x4 gv[8], scv[8], shv[8]; int cur = -1;
    const f32x4* gr = (const f32x4*)g + lane;
#pragma unroll
    for (int j = 0; j < 8; ++j) gv[j] = gr[64 * j];
    f32x4 v[8];
    {
#pragma unroll
      for (int j = 0; j < 8; ++j) v[j] = *(const f32x4*)(X + (xt ? xt_off(m, 256 * j) : (size_t)m * D + 256 * j) + 4 * lane); }
    for (; m < row_hi; m += NGW) {
        f32x4 vn[8];
        const int mn = m + NGW;
        if (mn < row_hi) {
#pragma unroll
            for (int j = 0; j < 8; ++j) vn[j] = *(const f32x4*)(X + (xt ? xt_off(mn, 256 * j) : (size_t)mn * D + 256 * j) + 4 * lane); }
        else {
#pragma unroll
            for (int j = 0; j < 8; ++j) vn[j] = v[j]; }
        if (!FINAL) { const int cond = m < MC ? 0 : (m < MC + SEQL ? 1 : 2);
            if (cond != cur) { cur = cond; const float* mod = MODl + (size_t)cond * NMOD + (size_t)sub * 3 * D;
                const f32x4* sh = (const f32x4*)mod + lane; const f32x4* sc = (const f32x4*)(mod + D) + lane;
#pragma unroll
                for (int j = 0; j < 8; ++j) { scv[j] = sc[64 * j] + 1.f; shv[j] = sh[64 * j]; } } }
        __builtin_amdgcn_sched_barrier(0);
        float ss = 0.f;
#pragma unroll
        for (int j = 0; j < 8; ++j) ss += (v[j][0] * v[j][0] + v[j][1] * v[j][1]) + (v[j][2] * v[j][2] + v[j][3] * v[j][3]);
        const float r = rsqrtf(wave_sum(ss) * (1.f / D) + EPS);
        if (FINAL) { f32x4* o = (f32x4*)(out + (size_t)m * D) + lane;
#pragma unroll
            for (int j = 0; j < 8; ++j) o[64 * j] = v[j] * r * gv[j];
        } else {
            unsigned long long* o8 = (unsigned long long*)(H + (size_t)m * H_LD) + lane;
#pragma unroll
            for (int j = 0; j < 8; ++j) { const f32x4 h = v[j] * r * gv[j] * scv[j] + shv[j];
                o8[64 * j] = (unsigned long long)pk2(h[0], h[1]) | ((unsigned long long)pk2(h[2], h[3]) << 32); }
        }
#pragma unroll
        for (int j = 0; j < 8; ++j) v[j] = vn[j];
    }
}
__device__ __forceinline__ void conv_a_phase(const bf16* GLU, const float* w, const float* bias, const float* g, bf16* CA, unsigned char* lds, int u_first, int u_count, int u_stride) {
    typedef float f32x2 __attribute__((ext_vector_type(2)));
    const int tid = fresh_tid(), wid = tid >> 6, lane = tid & 63;
    float* part = (float*)lds;
    float* rs = (float*)(lds + 32768);
    f32x2 wv[31];
#pragma unroll
    for (int t = 0; t < 31; ++t) wv[t] = *(const f32x2*)(w + t * DCA + 2 * tid);
    const f32x2 bb = *(const f32x2*)(bias + 2 * tid), gg = *(const f32x2*)(g + 2 * tid);
    for (int ui_ = 0; ui_ < u_count; ++ui_) { const int u = u_first + ui_ * u_stride;
        const int row0 = u * 16, s0 = row0 < MC ? (row0 & ~(SEQC - 1)) : MC + ((row0 - MC) & ~(SEQL - 1)), L = row0 < MC ? SEQC : SEQL, p0 = row0 - s0;
        f32x2 xv[46];
#pragma unroll
        for (int q = 0; q < 46; ++q) { const int p = p0 - 15 + q; unsigned xw = 0u; if (p >= 0 && p < L) xw = *(const unsigned*)(GLU + (size_t)(s0 + p) * DCA + 2 * tid); xv[q] = (f32x2){bflo(xw), bfhi(xw)}; }
        f32x2 acc[16];
#pragma unroll
        for (int r = 0; r < 16; ++r) { f32x2 s_ = bb;
#pragma unroll
            for (int t = 0; t < 31; ++t) s_ = s_ + xv[r + t] * wv[t];
            acc[r] = s_; part[r * 512 + tid] = s_.x * s_.x + s_.y * s_.y; }
        __syncthreads();
#pragma unroll
        for (int h = 0; h < 2; ++h) { const int r = wid + 8 * h; float v = 0.f;
#pragma unroll
            for (int k = 0; k < 8; ++k) v += part[r * 512 + lane + 64 * k];
            v = wave_sum(v); if (lane == 0) rs[r] = rsqrtf(v * (1.f / DCA) + EPS); }
        __syncthreads();
#pragma unroll
        for (int r = 0; r < 16; ++r) { const float rr = rs[r]; const f32x2 y = acc[r] * rr * gg;
            *(unsigned*)(CA + (size_t)(row0 + r) * ABR_LD + 2 * tid) = pk2(silu_acc(y.x), silu_acc(y.y)); }
    }
    __syncthreads();
}
__device__ __forceinline__ void conv_b_phase(const bf16* BG, const bf16* CX, const float* w, bf16* CB, int vcu, int G, int row_lo, int row_hi) {
    const int gt = vcu * NTHR + fresh_tid(), NT = G * NTHR;
    const int c8 = (gt & 127) * 8;
    f32x4 wa[3], wb[3];
#pragma unroll
    for (int t = 0; t < 3; ++t) { wa[t] = *(const f32x4*)(w + t * DCA + c8); wb[t] = *(const f32x4*)(w + t * DCA + c8 + 4); }
    const int end = row_hi * (DCA / 8);
    constexpr int QB = 4;
    for (int idx0 = row_lo * (DCA / 8) + gt; idx0 < end; idx0 += QB * NT) {
        v4u xw[QB][3], bw[QB];
#pragma unroll
        for (int q = 0; q < QB; ++q) { const int idx = idx0 + q * NT; const int m = idx >> 7;
            const int s0 = m < MC ? (m & ~(SEQC - 1)) : MC + ((m - MC) & ~(SEQL - 1)), L = m < MC ? SEQC : SEQL, pos = m - s0;
#pragma unroll
            for (int t = 0; t < 3; ++t) { const int p = pos + t - 1; xw[q][t] = (v4u){0u, 0u, 0u, 0u};
                if (idx < end && p >= 0 && p < L) xw[q][t] = *(const v4u*)(CX + (size_t)(s0 + p) * DCA + c8); }
            bw[q] = (v4u){0u, 0u, 0u, 0u}; if (idx < end) bw[q] = *(const v4u*)(BG + (size_t)m * DCA + c8); }
        __builtin_amdgcn_sched_barrier(0);
#pragma unroll
        for (int q = 0; q < QB; ++q) { const int idx = idx0 + q * NT; const int m = idx >> 7;
            f32x4 aa = {0.f, 0.f, 0.f, 0.f}, ab = {0.f, 0.f, 0.f, 0.f};
#pragma unroll
            for (int t = 0; t < 3; ++t) { const v4u x = xw[q][t];
                aa[0] += bflo(x.x) * wa[t][0]; aa[1] += bfhi(x.x) * wa[t][1]; aa[2] += bflo(x.y) * wa[t][2]; aa[3] += bfhi(x.y) * wa[t][3];
                ab[0] += bflo(x.z) * wb[t][0]; ab[1] += bfhi(x.z) * wb[t][1]; ab[2] += bflo(x.w) * wb[t][2]; ab[3] += bfhi(x.w) * wb[t][3]; }
            const v4u b = bw[q];
            v4u o; o.x = pk2(bflo(b.x) * aa[0], bfhi(b.x) * aa[1]); o.y = pk2(bflo(b.y) * aa[2], bfhi(b.y) * aa[3]); o.z = pk2(bflo(b.z) * ab[0], bfhi(b.z) * ab[1]); o.w = pk2(bflo(b.w) * ab[2], bfhi(b.w) * ab[3]);
            if (idx < end) *(v4u*)(CB + (size_t)m * ABR_LD + c8) = o; }
    }
}
#ifndef ATT_LO
#define ATT_LO 1
#endif
#ifndef CONV_LO
#define CONV_LO 2
#endif
__device__ __forceinline__ void attn_lat_phase(const bf16* Qb, const bf16* Kb, const bf16* Vb, const bf16* CK, const bf16* CV, const float* sink, bf16* ATT, int layer, int bx, int vcu, int G, unsigned char* lds) {
    const bool deal = G == 256; const int x = bx & 7, r = bx >> 3;
    const int cnt = deal ? (r >= 16 ? 4 - ATT_LO : ATT_LO) : (512 - vcu + G - 1) / G;
    for (int i = 0; i < cnt; ++i) {
        const int u = deal ? x * 64 + (r >= 16 ? 16 * ATT_LO + (r - 16) * (4 - ATT_LO) + i : r * ATT_LO + i) : vcu + i * G;
        const int b = u >> 8, kvh = (u >> 6) & 3, tb = u & 63;
        const int lo = tb < 2 ? -tb : -2, hi = tb > 61 ? 63 - tb : 2, NT = 8 + (hi - lo + 1);
        const size_t seq0 = (size_t)MC + (size_t)b * SEQL, q0 = seq0 + 64 * tb, c0 = (size_t)(b * 2 + layer) * PAST;
        att::attn_unit(Qb + q0 * D + kvh * 512, CK + c0 * KVD + kvh * 128, CV + c0 * KVD + kvh * 128,
                       Kb + (seq0 + 64 * (tb + lo)) * KVD + kvh * 128, Vb + (seq0 + 64 * (tb + lo)) * KVD + kvh * 128,
                       8, NT, lo == -2 ? 8 : -1, hi == 2 ? NT - 1 : -1, sink + kvh * 4, ATT + q0 * ABR_LD + kvh * 512, ABR_LD, (char*)lds);
    }
}
__device__ __forceinline__ void attn_ctx_phase(const bf16* Qb, const bf16* Kb, const bf16* Vb, const float* sink, bf16* ATT, int vcu, int G, unsigned char* lds) {
    for (int u = vcu; u < 256; u += G) {
        const int b = u >> 4, kvh = (u >> 2) & 3, qb = u & 3;
        const size_t seq0 = (size_t)b * SEQC, q0 = seq0 + 64 * qb;
        att::attn_unit(Qb + q0 * D + kvh * 512, Kb, Vb, Kb + seq0 * KVD + kvh * 128, Vb + seq0 * KVD + kvh * 128, 0, 4, -1, -1, sink + kvh * 4, ATT + q0 * ABR_LD + kvh * 512, ABR_LD, (char*)lds);
    }
}

#define P_MOD   ((float*)(ws + WS_MOD))
#define P_CK    ((bf16*)(ws + WS_CK))
#define P_CV    ((bf16*)(ws + WS_CV))
#define P_X     ((float*)(ws + WS_X))
#define P_H     ((bf16*)(ws + WS_H))
#define P_ACT   ((bf16*)(ws + WS_ACT))
#define P_Q     ((bf16*)(ws + WS_Q))
#define P_K     ((bf16*)(ws + WS_K))
#define P_V     ((bf16*)(ws + WS_V))
#define P_GLU   ((bf16*)(ws + WS_GLU))
#define P_BG    ((bf16*)(ws + WS_BG))
#define P_CX    ((bf16*)(ws + WS_CX))
#define P_GATES ((bf16*)(ws + WS_GATES))
#define P_ABR   ((bf16*)(ws + WS_ABR))
#define P_ATT   (P_ABR + ABR_ATT)
#define P_CA    (P_ABR + ABR_CA)
#define P_CB    (P_ABR + ABR_CB)
#define P_MIX   ((bf16*)(ws + WS_MIX))
#define P_MODL  (P_MOD + (size_t)l * 3 * NMOD)
#define P_WL(off) ((const bf16*)(ws + WS_WT + (size_t)l * WT_LAYER + (off)))
__global__ void __launch_bounds__(NTHR, 2) fwd(Args args) {
    extern __shared__ __attribute__((aligned(16))) unsigned char lds[];
    const int tid = threadIdx.x;
    const int G0 = gridDim.x, bx = blockIdx.x, vcu0 = (G0 % 8 == 0) ? (bx % 8) * (G0 / 8) + bx / 8 : bx;
    LAS unsigned char* ldsl = (LAS unsigned char*)lds;
    volatile LAS unsigned* MISC = (volatile LAS unsigned*)(ldsl + MISC_OFF);
    for (int u = tid; u < (LDS_BYTES - LDSCTL_OFF) / 4; u += NTHR) ((LAS unsigned*)(ldsl + LDSCTL_OFF))[u] = 0u;
    __syncthreads();
    unsigned* barw = (unsigned*)(args.ws + WS_CTL) + CW_BAR;
    XcdBarrier bar; bar.bar = barw; bar.x = 0; bar.st = nullptr;
    if (!MK_PER_PHASE) bar = xcd_barrier_post(barw, MISC + 8);
#if MK_PER_PHASE
    const int lo = args.ph_lo, hi = args.ph_hi;
#define IN(k) (lo <= (k) && (k) < hi)
#else
#define IN(k) true
#endif
#ifndef DUP_PHASE
#define DUP_PHASE (-1)
#endif
#define EPI_T 0
#define PH_BEGIN const Args* A_ = fresh_args(); unsigned char* ws = A_->ws; (void)ws; const int vcu = fresh_i(vcu0), G = fresh_i(G0); (void)vcu; (void)G
#define FILL_JOB(j) ((l == 0 && (((FILL_MASK) >> (j)) & 1)) ? (j) : 0)
#define RUN_GEMM(EpiT, Eobj, Aptr, Bptr, N_, K_, LDA_, LDB_, kind_, job_) do { pg8::Gemm g{Aptr, Bptr, M, N_, K_}; typedef pg8::TailOrder<M, N_, K_, (((HT_MASK) >> (kind_)) & 1) != 0> SO_; SO_ S; S.init(fresh_i(G), fresh_i(bx)); \
        pg8::gemm_phase_ht<EpiT, SO_, K_, LDA_, LDB_>(ldsl + RING_OFF, g, S, Eobj); \
        { const int job__ = (job_); if (job__ > 0) { constexpr int nwg__ = (M / 256) * ((N_) / 256); const int G__ = fresh_i(G), bx__ = fresh_i(bx), Rem__ = nwg__ - (nwg__ / G__) * G__; \
            if (bx__ >= Rem__) filler(*fresh_args(), lds, job__, bx__ - Rem__, G__ - Rem__); } } } while (0)
#ifdef XTRA_BAR
#define XTRA_BAR_STMT xcd_barrier(bb_);
#else
#define XTRA_BAR_STMT
#endif
#ifndef HT_MASK
#define HT_MASK 0
#endif
#define REP(k) for (int rep_ = 0; rep_ < ((DUP_PHASE == (k)) ? 2 : 1); ++rep_)
#ifdef PROBE_PHASE
#define STAMP(k) do { unsigned long long* tsp_ = (unsigned long long*)(fresh_args()->ws + WS_CTL + 131072); if (blockIdx.x == 0 && threadIdx.x == 0) tsp_[(k) + 1] = __builtin_amdgcn_s_memrealtime(); } while (0)
#else
#define STAMP(k) do { } while (0)
#endif
#define SEAM(k) do { if (!MK_PER_PHASE && IN(k) && IN((k) + 1)) { XcdBarrier bb_ = bar; bb_.x = (unsigned)fresh_i((int)bar.x); bb_.bar = (unsigned*)(fresh_args()->ws + WS_CTL) + CW_BAR; xcd_barrier(bb_); XTRA_BAR_STMT STAMP(k); } } while (0)

#ifndef DUPX
#define DUPX (-1)
#endif
#ifndef PROBE_G
#define PROBE_G 0
#endif
#ifndef W_PNMIX
#define W_PNMIX true
#endif
#ifndef PROBE_HIT
#define PROBE_HIT 0
#endif
#define RUN_GEMM_Q(EpiT, Eobj, Aptr, Bptr, N_, K_, LDA_, LDB_, PM0_, NML_, TYPE_, MIX_, QID_) do { pg8::Gemm g{Aptr, Bptr, M, N_, K_}; g.hit = (dry_ && PROBE_HIT) ? 1 : 0; g.hitpm = PM0_; typedef pg8::QueueOrder<N_, PM0_, NML_, TYPE_, MIX_> SO_; SO_ S; \
        S.init(fresh_i(G), fresh_i(bx), (unsigned*)(ws + WS_CTL) + CW_Q + (size_t)((QID_) + (dry_ ? 50 : 0)) * 512); pg8::gemm_phase_ht<EpiT, SO_, K_, LDA_, LDB_>(ldsl + RING_OFF, g, S, Eobj); } while (0)
#define RUN_GEMM_D(EpiT, Eobj, Aptr, Bptr, N_, K_, LDA_, LDB_, PM0_, NML_, R_, KA_, KB_) RUN_GEMM_DX(EpiT, Eobj, Aptr, Bptr, N_, K_, LDA_, LDB_, PM0_, NML_, R_, KA_, KB_, false)
#define RUN_GEMM_DX(EpiT, Eobj, Aptr, Bptr, N_, K_, LDA_, LDB_, PM0_, NML_, R_, KA_, KB_, MIX_) do { pg8::Gemm g{Aptr, Bptr, M, N_, K_}; typedef pg8::DealOrder<N_, PM0_, NML_, R_, KA_, KB_, MIX_> SO_; SO_ S; S.init(fresh_i(G), fresh_i(bx)); \
        pg8::gemm_phase_ht<EpiT, SO_, K_, LDA_, LDB_>(ldsl + RING_OFF, g, S, Eobj); } while (0)
#define NORM_C(sub_, gin_, lc) { PH_BEGIN; const bool xt_ = !((sub_) == 0 && (lc) == 0); const float* xs_ = ((sub_) == 0 && (lc) == 0) ? A_->in[0] : (const float*)P_X; const int r_ = bx >> 3, x_ = bx & 7; \
        if (G != 256) norm_phase<false>(xs_, A_->in[gin_] + (lc) * D, P_MOD + (size_t)(lc) * 3 * NMOD, sub_, P_H, nullptr, vcu, G, 0, MC, xt_); \
        else { const int lo_ = 1024 * (x_ >> 1) + 512 * (x_ & 1); norm_phase<false>(xs_, A_->in[gin_] + (lc) * D, P_MOD + (size_t)(lc) * 3 * NMOD, sub_, P_H, nullptr, r_, 32, lo_, lo_ + 512, xt_); } }
#ifndef NORM_L_RANKS
#define NORM_L_RANKS 8
#endif
#define NORM_L(sub_, gin_, ll) { PH_BEGIN; const bool xt_ = !((sub_) == 0 && (ll) == 0); const float* xs_ = ((sub_) == 0 && (ll) == 0) ? A_->in[1] - (size_t)MC * D : (const float*)P_X; const int r_ = bx >> 3, x_ = bx & 7; \
        if (G != 256) norm_phase<false>(xs_, A_->in[gin_] + (ll) * D, P_MOD + (size_t)(ll) * 3 * NMOD, sub_, P_H, nullptr, vcu, G, MC, M, xt_); \
        else { constexpr int NR_ = ((sub_) == 1) ? 16 : NORM_L_RANKS;     \
            if (r_ >= 32 - NR_) { const int lo_ = MC + 1024 * x_; norm_phase<false>(xs_, A_->in[gin_] + (ll) * D, P_MOD + (size_t)(ll) * 3 * NMOD, sub_, P_H, nullptr, r_ - (32 - NR_), NR_, lo_, lo_ + 1024, xt_); } } }
#define WLY(lx, off) ((const bf16*)(ws + WS_WT + (size_t)(lx) * WT_LAYER + (off)))
#define MODLY(lx) (P_MOD + (size_t)(lx) * 3 * NMOD)
    STAMP(-1);
    if (IN(0)) REP(0) { prologue(*fresh_args(), lds, vcu0, G0); } SEAM(0);
    if (IN(1)) NORM_C(0, 8, 0)
    SEAM(1);
    for (int l = 0; l < 2; ++l) {
        const int pb = 2 + 12 * l;
        if (IN(pb + 0)) for (int rep_ = 0; rep_ < ((DUPX == 99 || (DUPX == 0 && l == 0)) ? 2 : 1); ++rep_) { const bool dry_ = ((DUPX == 99 || (DUPX == 0 && l == 0)) && rep_ == 0); (void)dry_; NORM_L(0, 8, l)
            { PH_BEGIN; pg8::EpiSwiglu E{P_ACT, ACT_LD}; RUN_GEMM_Q(pg8::EpiSwiglu, E, P_H, WLY(l, WT_1I), 2 * DFF, D, H_LD, WK_D, 0, 16, 0, false, l * 14 + 0); } }
        SEAM(pb + 0);
        if (IN(pb + 1)) for (int rep_ = 0; rep_ < ((DUPX == 99 || (DUPX == 1 && l == 0)) ? 2 : 1); ++rep_) { const bool dry_ = ((DUPX == 99 || (DUPX == 1 && l == 0)) && rep_ == 0); (void)dry_;
            { PH_BEGIN; pg8::EpiResid E{P_X, MODLY(l) + 2 * D, l == 0 ? A_->in[0] : (const float*)P_X, dry_ ? 0.f : 0.5f, l == 0 ? 0 : 1}; RUN_GEMM_Q(pg8::EpiResid, E, P_ACT, WLY(l, WT_1O), D, DFF, ACT_LD, WK_FF, 0, 16, 0, false, l * 14 + 1); }
            { PH_BEGIN; pg8::EpiSwiglu E{P_ACT, ACT_LD}; RUN_GEMM_Q(pg8::EpiSwiglu, E, P_H, WLY(l, WT_1I), 2 * DFF, D, H_LD, WK_D, 16, 32, 1, false, l * 14 + 2); } }
        SEAM(pb + 1);
        if (IN(pb + 2)) for (int rep_ = 0; rep_ < ((DUPX == 99 || (DUPX == 2 && l == 0)) ? 2 : 1); ++rep_) { const bool dry_ = ((DUPX == 99 || (DUPX == 2 && l == 0)) && rep_ == 0); (void)dry_; NORM_C(1, 11, l)
            { PH_BEGIN; pg8::EpiResid E{P_X, MODLY(l) + 2 * D, l == 0 ? A_->in[1] - (size_t)MC * D : (const float*)P_X, dry_ ? 0.f : 0.5f, l == 0 ? 0 : 1}; RUN_GEMM_Q(pg8::EpiResid, E, P_ACT, WLY(l, WT_1O), D, DFF, ACT_LD, WK_FF, 16, 32, 0, false, l * 14 + 3); } }
        SEAM(pb + 2);
        if (IN(pb + 3)) for (int rep_ = 0; rep_ < ((DUPX == 99 || (DUPX == 3 && l == 0)) ? 2 : 1); ++rep_) { const bool dry_ = ((DUPX == 99 || (DUPX == 3 && l == 0)) && rep_ == 0); (void)dry_; NORM_L(1, 11, l)
#if defined(PROBE_W)
            if (l == 0) {
#if PROBE_W == 1
                { PH_BEGIN; pg8::EpiSwiglu E{P_ACT, ACT_LD}; RUN_GEMM_Q(pg8::EpiSwiglu, E, P_H, WLY(l, WT_IN), INC, D, H_LD, WK_D, 0, 16, 0, true, 40); }
#else
                { PH_BEGIN; pg8::EpiWin E{ws, A_->out, l}; RUN_GEMM_Q(pg8::EpiWin, E, P_H, WLY(l, WT_IN), INC, D, H_LD, WK_D, 0, 16, 0, true, 40); }
#endif
            }
#endif
            { PH_BEGIN; pg8::EpiWin E{ws, A_->out, l}; RUN_GEMM_Q(pg8::EpiWin, E, P_H, WLY(l, WT_IN), INC, D, H_LD, WK_D, 0, 16, 0, W_PNMIX, l * 14 + 4); } }
        SEAM(pb + 3);
        if (IN(pb + 4)) for (int rep_ = 0; rep_ < ((DUPX == 99 || (DUPX == 4 && l == 0)) ? 2 : 1); ++rep_) { const bool dry_ = ((DUPX == 99 || (DUPX == 4 && l == 0)) && rep_ == 0); (void)dry_;
            { PH_BEGIN; attn_ctx_phase(P_Q, P_K, P_V, A_->in[13] + l * 16, P_ATT, vcu, G, lds); }
            { PH_BEGIN; conv_a_phase(P_GLU, A_->in[15] + (size_t)l * 31 * DCA, A_->in[16] + l * DCA, A_->in[17] + l * DCA, P_CA, lds, vcu, (MC / 16 - vcu + G - 1) / G, G); }
            { PH_BEGIN; conv_b_phase(P_BG, P_CX, A_->in[19] + (size_t)l * 3 * DCA, P_CB, vcu, G, 0, MC); } }
        SEAM(pb + 4);
        if (IN(pb + 5)) for (int rep_ = 0; rep_ < ((DUPX == 99 || (DUPX == 5 && l == 0)) ? 2 : 1); ++rep_) { const bool dry_ = ((DUPX == 99 || (DUPX == 5 && l == 0)) && rep_ == 0); (void)dry_;
            { PH_BEGIN; pg8::EpiMixK E{P_MIX, P_GATES}; RUN_GEMM_Q(pg8::EpiMixK, E, P_ABR, WLY(l, WT_MIXB), D, ABR_K, ABR_LD, WK_MIX, 0, 16, 0, false, l * 14 + 5); }
            { PH_BEGIN; pg8::EpiWin E{ws, A_->out, l}; RUN_GEMM_Q(pg8::EpiWin, E, P_H, WLY(l, WT_IN), INC, D, H_LD, WK_D, 16, 32, 1, W_PNMIX, l * 14 + 6); } }
        SEAM(pb + 5);
        if (IN(pb + 6)) for (int rep_ = 0; rep_ < ((DUPX == 99 || (DUPX == 6 && l == 0)) ? 2 : 1); ++rep_) { const bool dry_ = ((DUPX == 99 || (DUPX == 6 && l == 0)) && rep_ == 0); (void)dry_;
            if (!((PROBE_G & 4) && dry_)) { PH_BEGIN; pg8::EpiResid E{P_X, MODLY(l) + 5 * D, P_X, dry_ ? 0.f : 1.0f, 1}; RUN_GEMM_Q(pg8::EpiResid, E, P_MIX, WLY(l, WT_OUT), D, D, MIX_LD, WK_D, 0, 16, 0, false, l * 14 + 7); }
#ifdef ATT_DUP
            for (int rep_ = 0; rep_ < 2; ++rep_)
#endif
            if (!((PROBE_G & 1) && dry_)) { PH_BEGIN; attn_lat_phase(P_Q, P_K, P_V, P_CK, P_CV, A_->in[13] + l * 16, P_ATT, l, bx, vcu, G, lds); }
#ifdef CONV_DUP
            for (int crep_ = 0; crep_ < 2; ++crep_)
#endif
            if (!((PROBE_G & 2) && dry_)) { PH_BEGIN; const int r_ = bx >> 3, x_ = bx & 7; const int nu = (M - MC) / 16, u0 = MC / 16;
              if (G != 256) conv_a_phase(P_GLU, A_->in[15] + (size_t)l * 31 * DCA, A_->in[16] + l * DCA, A_->in[17] + l * DCA, P_CA, lds, u0 + vcu, (nu - vcu + G - 1) / G, G);
              else if (r_ < 16) conv_a_phase(P_GLU, A_->in[15] + (size_t)l * 31 * DCA, A_->in[16] + l * DCA, A_->in[17] + l * DCA, P_CA, lds, u0 + r_ * 8 + x_, CONV_LO, 128);
              else conv_a_phase(P_GLU, A_->in[15] + (size_t)l * 31 * DCA, A_->in[16] + l * DCA, A_->in[17] + l * DCA, P_CA, lds, u0 + 128 * CONV_LO + (r_ - 16) * 8 + x_, 4 - CONV_LO, 128); }
            if (!((PROBE_G & 8) && dry_)) { PH_BEGIN; conv_b_phase(P_BG, P_CX, A_->in[19] + (size_t)l * 3 * DCA, P_CB, vcu, G, MC, M); } }
        SEAM(pb + 6);
        if (IN(pb + 7)) for (int rep_ = 0; rep_ < ((DUPX == 99 || (DUPX == 7 && l == 0)) ? 2 : 1); ++rep_) { const bool dry_ = ((DUPX == 99 || (DUPX == 7 && l == 0)) && rep_ == 0); (void)dry_; PH_BEGIN; pg8::EpiMixK E{P_MIX, P_GATES}; RUN_GEMM_Q(pg8::EpiMixK, E, P_ABR, WLY(l, WT_MIXB), D, ABR_K, ABR_LD, WK_MIX, 16, 32, 0, false, l * 14 + 8); }
        SEAM(pb + 7);
        if (IN(pb + 8)) for (int rep_ = 0; rep_ < ((DUPX == 99 || (DUPX == 8 && l == 0)) ? 2 : 1); ++rep_) { const bool dry_ = ((DUPX == 99 || (DUPX == 8 && l == 0)) && rep_ == 0); (void)dry_; NORM_C(2, 22, l)
            { PH_BEGIN; pg8::EpiResid E{P_X, MODLY(l) + 5 * D, P_X, dry_ ? 0.f : 1.0f, 1}; RUN_GEMM_Q(pg8::EpiResid, E, P_MIX, WLY(l, WT_OUT), D, D, MIX_LD, WK_D, 16, 32, 0, false, l * 14 + 9); } }
        SEAM(pb + 8);
        if (IN(pb + 9)) for (int rep_ = 0; rep_ < ((DUPX == 99 || (DUPX == 9 && l == 0)) ? 2 : 1); ++rep_) { const bool dry_ = ((DUPX == 99 || (DUPX == 9 && l == 0)) && rep_ == 0); (void)dry_; NORM_L(2, 22, l)
            { PH_BEGIN; pg8::EpiSwiglu E{P_ACT, ACT_LD}; RUN_GEMM_Q(pg8::EpiSwiglu, E, P_H, WLY(l, WT_2I), 2 * DFF, D, H_LD, WK_D, 0, 16, 0, false, l * 14 + 10); } }
        SEAM(pb + 9);
        if (IN(pb + 10)) for (int rep_ = 0; rep_ < ((DUPX == 99 || (DUPX == 10 && l == 0)) ? 2 : 1); ++rep_) { const bool dry_ = ((DUPX == 99 || (DUPX == 10 && l == 0)) && rep_ == 0); (void)dry_;
            { PH_BEGIN; pg8::EpiResid E{P_X, MODLY(l) + 8 * D, P_X, dry_ ? 0.f : 0.5f, 1}; RUN_GEMM_Q(pg8::EpiResid, E, P_ACT, WLY(l, WT_2O), D, DFF, ACT_LD, WK_FF, 0, 16, 0, false, l * 14 + 11); }
            { PH_BEGIN; pg8::EpiSwiglu E{P_ACT, ACT_LD}; RUN_GEMM_Q(pg8::EpiSwiglu, E, P_H, WLY(l, WT_2I), 2 * DFF, D, H_LD, WK_D, 16, 32, 1, false, l * 14 + 12); } }
        SEAM(pb + 10);
        if (IN(pb + 11)) for (int rep_ = 0; rep_ < ((DUPX == 99 || (DUPX == 11 && l == 0)) ? 2 : 1); ++rep_) { const bool dry_ = ((DUPX == 99 || (DUPX == 11 && l == 0)) && rep_ == 0); (void)dry_;
            if (l == 0) NORM_C(0, 8, 1)
            else { PH_BEGIN; norm_phase<true>(P_X, A_->in[25], nullptr, 0, nullptr, A_->out, vcu, G, 0, MC, true); }
            { PH_BEGIN; pg8::EpiResid E{P_X, MODLY(l) + 8 * D, P_X, dry_ ? 0.f : 0.5f, 1}; RUN_GEMM_Q(pg8::EpiResid, E, P_ACT, WLY(l, WT_2O), D, DFF, ACT_LD, WK_FF, 16, 32, 0, false, l * 14 + 13); } }
        SEAM(pb + 11);
    }
#ifdef PROBE_PHASE
    { XcdBarrier bb_ = bar; bb_.x = (unsigned)fresh_i((int)bar.x); bb_.bar = (unsigned*)(fresh_args()->ws + WS_CTL) + CW_BAR; xcd_barrier(bb_); }
    { PH_BEGIN; const unsigned long long* ts = (const unsigned long long*)(ws + WS_CTL + 131072);
      const unsigned long long t1 = __hip_atomic_load(ts + (PROBE_PHASE >= 100 ? 26 : PROBE_PHASE + 1), __ATOMIC_RELAXED, __HIP_MEMORY_SCOPE_AGENT), t0 = __hip_atomic_load(ts + (PROBE_PHASE >= 100 ? 0 : PROBE_PHASE), __ATOMIC_RELAXED, __HIP_MEMORY_SCOPE_AGENT);
      const float us = (float)(t1 - t0) * 0.01f, fac = 1.f + us * (PROBE_PHASE >= 100 ? 1e-4f : 1e-3f);
      norm_phase<true>(P_X, A_->in[25], nullptr, 0, nullptr, A_->out, vcu, G, MC, M, true);
      __syncthreads(); asm volatile("s_waitcnt vmcnt(0)" ::: "memory");
      const int tid_ = fresh_tid(), wv_ = tid_ >> 6, ln_ = tid_ & 63;
      for (int m = MC + vcu * NWAVES + wv_; m < M; m += G * NWAVES) { f32x4* o = (f32x4*)(A_->out + (size_t)m * D) + ln_;
#pragma unroll
          for (int j = 0; j < 8; ++j) o[64 * j] = o[64 * j] * fac; } }
#else
#ifdef DUP26
    if (IN(26)) for (int rep_ = 0; rep_ < DUP26; ++rep_) { PH_BEGIN; norm_phase<true>(P_X, A_->in[25], nullptr, 0, nullptr, A_->out, fresh_i(vcu), fresh_i(G) + fresh_i(rep_) * 0, MC, M, true); }
#else
    if (IN(26)) { PH_BEGIN; norm_phase<true>(P_X, A_->in[25], nullptr, 0, nullptr, A_->out, vcu, G, MC, M, true); }
#endif
#endif
#undef IN
#undef SEAM
}

extern "C" void kernel_launch(void* const* d_in, const int* in_sizes, int n_in, void* d_out, int out_size, void* d_ws, size_t ws_size, hipStream_t stream) {
    static int grid = 0;
    if (grid == 0) {
        if (n_in != 26 || ws_size < WS_END) { fprintf(stderr, "kernel_launch: built for 26 inputs and >= %zu bytes of workspace; got n_in %d, ws %zu; nothing launched\n", (size_t)WS_END, n_in, ws_size); grid = -1; return; }
        int dev = 0, cus = 0, per_cu = 0;
        if (hipGetDevice(&dev) != hipSuccess || hipDeviceGetAttribute(&cus, hipDeviceAttributeMultiprocessorCount, dev) != hipSuccess) { fprintf(stderr, "kernel_launch: device query failed\n"); grid = -1; return; }
        if (hipFuncSetAttribute((const void*)fwd, hipFuncAttributeMaxDynamicSharedMemorySize, LDS_BYTES) != hipSuccess) { fprintf(stderr, "kernel_launch: hipFuncSetAttribute failed\n"); grid = -1; return; }
        if (hipOccupancyMaxActiveBlocksPerMultiprocessor(&per_cu, (const void*)fwd, NTHR, LDS_BYTES) != hipSuccess || per_cu < 1)
            fprintf(stderr, "kernel_launch: note: occupancy query reports %d workgroups per CU\n", per_cu);
        (void)hipGetLastError();
        grid = cus;
    }
    if (grid < 0) return;
    if (hipMemsetAsync((char*)d_ws + WS_CTL, 0, CTL_ZERO_BYTES, stream) != hipSuccess) { fprintf(stderr, "kernel_launch: hipMemsetAsync failed\n"); return; }
    Args a{};
    for (int i = 0; i < 26; ++i) a.in[i] = (const float*)d_in[i];
    a.out = (float*)d_out; a.ws = (unsigned char*)d_ws;
#if MK_PER_PHASE
    for (int p = 0; p < N_PHASES; ++p) { a.ph_lo = p; a.ph_hi = p + 1; hipLaunchKernelGGL(fwd, dim3(grid), dim3(NTHR), LDS_BYTES, stream, a); }
#else
    a.ph_lo = 0; a.ph_hi = N_PHASES; hipLaunchKernelGGL(fwd, dim3(grid), dim3(NTHR), LDS_BYTES, stream, a);
#endif
    const hipError_t le = hipPeekAtLastError();
    if (le != hipSuccess) fprintf(stderr, "kernel_launch: launch failed: %s\n", hipGetErrorName(le));
}
```

```cpp
#include <hip/hip_runtime.h>
#include <cstdio>
#include <cstdint>

#ifndef MK_PER_PHASE
#define MK_PER_PHASE 0
#endif
constexpr int D = 2048, MC = 4096, ML = 8192, M = MC + ML, DFF = 5632, NMOD = 9 * D, INC = 14336;
constexpr int SEQC = 256, SEQL = 4096, PAST = 512, KVD = 512, DCA = 1024;
constexpr float EPS = 1e-6f;
constexpr size_t MiB = 1u << 20;
#ifndef ROW_PAD
#define ROW_PAD 64
#endif
constexpr int PADE = ROW_PAD;
constexpr int H_LD = D + PADE, ACT_LD = DFF + PADE, MIX_LD = D + PADE, ABR_K = 4096, ABR_LD = ABR_K + PADE, ABR_CA = 0, ABR_CB = 1024, ABR_ATT = 2048;
constexpr int WK_D = D + PADE, WK_FF = DFF + PADE, WK_MIX = ABR_K + PADE;
constexpr size_t WS_CTL = 0, CTL_ZERO_BYTES = 1 * MiB;
constexpr size_t WS_MOD = 1 * MiB, WS_ROPE = 2 * MiB, WS_CK = 3 * MiB, WS_CV = 5 * MiB, WS_X = 8 * MiB, WS_H = 104 * MiB;
constexpr size_t WS_ACT = 154 * MiB;
constexpr size_t WS_Q = 154 * MiB, WS_K = 202 * MiB, WS_V = 214 * MiB, WS_GLU = 226 * MiB, WS_BG = 250 * MiB, WS_CX = 274 * MiB, WS_GATES = 298 * MiB;
constexpr size_t WS_ABR = 442 * MiB, WS_MIX = 540 * MiB;
constexpr size_t WS_WT = 590 * MiB, WT_LAYER = 222 * MiB;
constexpr size_t WT_1I = 0, WT_1O = 46 * MiB, WT_IN = 69 * MiB, WT_MIXB = 127 * MiB  , WT_OUT = 144 * MiB, WT_2I = 153 * MiB, WT_2O = 199 * MiB;
constexpr size_t WS_END = WS_WT + 2 * WT_LAYER;
static_assert((size_t)M * H_LD * 2 <= 50 * MiB && (size_t)M * ACT_LD * 2 <= 134 * MiB && (size_t)M * ABR_LD * 2 <= 98 * MiB && (size_t)M * MIX_LD * 2 <= 50 * MiB, "activation map");
static_assert((size_t)2 * DFF * WK_D * 2 <= 46 * MiB && (size_t)D * WK_FF * 2 <= 23 * MiB && (size_t)INC * WK_D * 2 <= 58 * MiB && (size_t)D * WK_MIX * 2 <= 17 * MiB && (size_t)D * WK_D * 2 <= 9 * MiB, "weight map");
constexpr int CW_Q = 32768;
constexpr int CW_BAR = 4096;

__device__ __forceinline__ size_t xt_off(int row, int col) { return ((size_t)((row >> 8) * (D / 256) + (col >> 8)) << 16) + (size_t)(((row & 255) << 8) + (col & 255)); }

__device__ __forceinline__ size_t blk_off(int row, int col, int nkb) { return ((size_t)((row >> 4) * nkb + (col >> 5)) << 9) + (size_t)(((row & 15) << 5) + (col & 31)); }

__device__ __forceinline__ int fresh_tid() { int t = threadIdx.x; asm volatile("" : "+v"(t)); return t; }

__device__ __forceinline__ int fresh_i(int v) { asm volatile("" : "+s"(v)); return v; }
struct Args { const float* in[26]; float* out; unsigned char* ws; int ph_lo, ph_hi; };
__device__ __forceinline__ const Args* fresh_args() { auto p = __builtin_amdgcn_kernarg_segment_ptr(); asm volatile("" : "+s"(p)); return (const Args*)p; }

namespace pg8 {
#define PG8_LAS __attribute__((address_space(3)))
typedef unsigned short bf16_t;
typedef short bf16x8 __attribute__((ext_vector_type(8)));
typedef float f32x4 __attribute__((ext_vector_type(4)));
typedef unsigned u32x4 __attribute__((ext_vector_type(4)));
constexpr int BM = 256, BK = 64, HALF = 128, HTB = HALF * BK * 2  , STAGE_BYTES = 8 * HTB, NXCD = 8, WGM = 8;

__host__ __device__ __forceinline__ int lds_byte(int r, int c) { const int st = (r >> 4) * 2 + (c >> 5), rr = r & 15, cc = c & 31, ob = rr * 64 + cc * 2; return st * 1024 + (ob ^ (((ob >> 9) & 1) << 5)); }
__host__ __device__ __forceinline__ void stage_rc(int b, int& R, int& C) { const int st = b / 1024, sb = b % 1024, swz = sb ^ (((sb >> 9) & 1) << 5); R = (st >> 1) * 16 + swz / 64; C = (st & 1) * 32 + (swz % 64) / 2; }
__host__ __device__ __forceinline__ int perm32(int rho) { const int n = rho >> 4, i = rho & 15; return 8 * (i >> 2) + 4 * n + (i & 3); }

struct Unit { int pm, pn; };
struct Gemm { const bf16_t* A; const bf16_t* Bt; int M, N, K; int hit = 0, hitpm = 0; };

struct StaticOrder {
    int nM, nN, nwg, G, c;
    __host__ __device__ void init(int M, int N, int G_, int c_) { nM = M / BM; nN = N / BM; nwg = nM * nN; G = G_; c = c_; }
    __host__ __device__ bool next(int i, Unit& u) const {
        const long L = (long)i * G + c; if (L >= nwg) return false;
        int wgid = (int)L; { const int q = nwg / NXCD, r = nwg % NXCD, xcd = wgid % NXCD, off = wgid / NXCD; wgid = (xcd < r ? xcd * (q + 1) : r * (q + 1) + (xcd - r) * q) + off; }
        const int nig = WGM * nN, gid = wgid / nig, fm = gid * WGM, gsz = (nM - fm) < WGM ? (nM - fm) : WGM;
        u.pm = fm + ((wgid % nig) % gsz); u.pn = (wgid % nig) / gsz; return true;
    }
    __device__ __forceinline__ void a_ready(const Unit&) const {}
    __device__ __forceinline__ void done(const Unit&) const {}
};

__device__ __forceinline__ unsigned cvt_pk_bf16(float lo, float hi) { unsigned r; asm volatile("v_cvt_pk_bf16_f32 %0, %1, %2" : "=v"(r) : "v"(lo), "v"(hi)); return r; }
typedef float f32x2 __attribute__((ext_vector_type(2)));
__device__ __forceinline__ f32x2 gelu_pk(f32x2 v) {
    const f32x2 av = __builtin_elementwise_abs(v), d = av * 0.2316418882f + 1.0f;
    f32x2 t; t.x = __builtin_amdgcn_rcpf(d.x); t.y = __builtin_amdgcn_rcpf(d.y);
    f32x2 q = t * 0.5307027145f + (-0.7265760135f); q = q * t + 0.7107068705f; q = q * t + (-0.142248368f); q = q * t + 0.127414796f; q = q * t;
    const f32x2 s = (v * v) * (-0.72134752044f);
    f32x2 e; e.x = __builtin_amdgcn_exp2f(s.x); e.y = __builtin_amdgcn_exp2f(s.y);
    const f32x2 m = v * (q * e), r = v - m;
    f32x2 o; o.x = v.x < 0.f ? m.x : r.x; o.y = v.y < 0.f ? m.y : r.y; return o;
}

struct UnitK : Unit { int half, rofs; };
__device__ __forceinline__ float fsigm(float x) { return __builtin_amdgcn_rcpf(1.f + __builtin_amdgcn_exp2f(-1.4426950408889634f * x)); }
__device__ __forceinline__ float fsilu(float x) { return x * fsigm(x); }
__device__ __forceinline__ u32x4 pack8(f32x4 a, f32x4 b) { u32x4 w; w.x = cvt_pk_bf16(a[0], a[1]); w.y = cvt_pk_bf16(a[2], a[3]); w.z = cvt_pk_bf16(b[0], b[1]); w.w = cvt_pk_bf16(b[2], b[3]); return w; }
__device__ __forceinline__ void unpack8(u32x4 w, f32x4& a, f32x4& b) {
    a[0] = __builtin_bit_cast(float, w.x << 16); a[1] = __builtin_bit_cast(float, w.x & 0xffff0000u); a[2] = __builtin_bit_cast(float, w.y << 16); a[3] = __builtin_bit_cast(float, w.y & 0xffff0000u);
    b[0] = __builtin_bit_cast(float, w.z << 16); b[1] = __builtin_bit_cast(float, w.z & 0xffff0000u); b[2] = __builtin_bit_cast(float, w.w << 16); b[3] = __builtin_bit_cast(float, w.w & 0xffff0000u);
}
enum { PO_SWIGLU = 0, PO_GLU = 1, PO_MUL = 2 };
template <int OP> __device__ __forceinline__ f32x4 pair_op(f32x4 a, f32x4 b) {
    f32x4 o;
#pragma unroll
    for (int e = 0; e < 4; ++e) o[e] = OP == PO_SWIGLU ? fsilu(a[e]) * b[e] : (OP == PO_GLU ? a[e] * fsigm(b[e]) : a[e] * b[e]);
    return o;
}
__device__ __forceinline__ int gt_reg(int wr, int wc, int fr, int fq, int ai, int m, int bj) { return ((((((wr * 4 + wc) * 2 + ai) * 4 + m) * 2 + bj) << 6) + ((fq << 4) | fr)) << 3; }
__device__ __forceinline__ size_t gt_off(int stage, int pm, int pn) { return (size_t)((stage * (::M / 256) + pm) * 8 + pn) << 16; }
struct EpiSwiglu {
    static constexpr bool PERM = true, AFTER_DRAIN = false, RESCALE = false, PREFETCH = false;
    bf16_t* O; int ldc;
    __device__ __forceinline__ void operator()(const f32x4 (&acc)[2][2][4][2], const UnitK& u, int wr, int wc, int fr, int fq, PG8_LAS unsigned char* ldsb) const {
        const int row0 = u.pm * BM + u.rofs + wr * 64 + fr, col0 = u.pn * HALF + wc * 32 + 8 * fq;
#pragma unroll
        for (int ai = 0; ai < 2; ++ai) { if (ai == 1 && u.half) break;
#pragma unroll
            for (int m = 0; m < 4; ++m) {
                bf16_t* rowp = O + ::blk_off(row0 + ai * HALF + m * 16, col0, DFF / 32);
                *(u32x4*)rowp = pack8(pair_op<PO_SWIGLU>(acc[ai][0][m][0], acc[ai][1][m][0]), pair_op<PO_SWIGLU>(acc[ai][0][m][1], acc[ai][1][m][1]));
            } }
    }
};
#ifndef RESID_BATCH
#define RESID_BATCH 4
#endif
#if defined(PROBE_HIT) && PROBE_HIT >= 2
#define RESID_PROBE 1
#else
#define RESID_PROBE 0
#endif
constexpr int EPI_T_OFF_ = 133120;
struct EpiResid {
    static constexpr bool PERM = true, AFTER_DRAIN = false, RESCALE = false, PREFETCH = false;
    float* X; const float* gate; const float* Xs; float coef; int xs_tiled;
    __device__ __forceinline__ void operator()(const f32x4 (&acc)[2][2][4][2], const UnitK& u, int wr, int wc, int fr, int fq, PG8_LAS unsigned char* ldsb) const {
        const int lane = (fq << 4) | fr, wv = wr * 4 + wc;
        PG8_LAS float* tw = (PG8_LAS float*)(ldsb + EPI_T_OFF_) + wv * 576;
        PG8_LAS float* twr = tw + fr * 36 + 8 * fq;
        const PG8_LAS float* trd = tw + (lane >> 3) * 36 + 4 * (lane & 7);
        const int cond = u.pm < 16 ? 0 : (u.pm < 32 ? 1 : 2);
        const int colT = u.pn * BM + wc * 32 + 4 * (lane & 7);
        f32x4 gT[2];
#pragma unroll
        for (int bj = 0; bj < 2; ++bj) gT[bj] = *(const f32x4*)(gate + (size_t)cond * NMOD + colT + bj * HALF) * coef;
        const int rloc = u.rofs + wr * 64 + (lane >> 3), cloc = wc * 32 + 4 * (lane & 7);
        const unsigned offX0 = (unsigned)(((((u.pm * (D / 256) + u.pn) << 16) + (rloc << 8) + cloc)) * 4);
        const unsigned offS0 = xs_tiled ? offX0 : (unsigned)(((u.pm * BM + rloc) * D + u.pn * BM + cloc) * 4);
        const unsigned rsS = xs_tiled ? 1024u : (unsigned)(D * 4); constexpr unsigned tsS = (unsigned)(HALF * 4);
        const char* Xsb = (const char*)Xs; char* Xb = (char*)X;
        f32x4 xq[2][2][2];
#define RESID_LD(q, gi) do { _Pragma("unroll") for (int bj = 0; bj < 2; ++bj) _Pragma("unroll") for (int h = 0; h < 2; ++h) \
            xq[q][bj][h] = *(const f32x4*)(Xsb + (size_t)(offS0 + (unsigned)(((gi) >> 2) * HALF + ((gi) & 3) * 16 + 8 * h) * rsS + (unsigned)bj * tsS)); } while (0)
        const int ngrp = u.half ? 4 : 8;
        RESID_LD(0, 0);
#pragma unroll
        for (int gi = 0; gi < 8; ++gi) { if (gi >= ngrp) break;
            const int ai = gi >> 2, m = gi & 3, q = gi & 1;
            if (gi + 1 < ngrp) RESID_LD(q ^ 1, gi + 1);
#pragma unroll
            for (int bj = 0; bj < 2; ++bj) {
                *(PG8_LAS f32x4*)twr = acc[ai][bj][m][0]; *(PG8_LAS f32x4*)(twr + 4) = acc[ai][bj][m][1];
                asm volatile("" ::: "memory");
                f32x4 t0 = *(const PG8_LAS f32x4*)trd, t1 = *(const PG8_LAS f32x4*)(trd + 8 * 36);
                asm volatile("" ::: "memory");
                if (RESID_PROBE && coef == 0.f) { t0 = (f32x4){0.f, 0.f, 0.f, 0.f}; t1 = t0; }
                const f32x4 y0 = xq[q][bj][0] + gT[bj] * t0, y1 = xq[q][bj][1] + gT[bj] * t1;
                *(f32x4*)(Xb + (size_t)(offX0 + (unsigned)(((ai * HALF + m * 16) * 256 + bj * HALF) * 4))) = y0;
                *(f32x4*)(Xb + (size_t)(offX0 + (unsigned)(((ai * HALF + m * 16 + 8) * 256 + bj * HALF) * 4))) = y1; }
        }
#undef RESID_LD
    }
};
struct EpiWin {
    static constexpr bool PERM = true, AFTER_DRAIN = false, RESCALE = false, PREFETCH = false;
    unsigned char* ws; float* out; int layer;
    __device__ __forceinline__ void operator()(const f32x4 (&acc)[2][2][4][2], const UnitK& u, int wr, int wc, int fr, int fq, PG8_LAS unsigned char* ldsb) const {
        bf16_t* const Qb = (bf16_t*)(ws + WS_Q); bf16_t* const Kb = (bf16_t*)(ws + WS_K); bf16_t* const Vb = (bf16_t*)(ws + WS_V); bf16_t* const GLU = (bf16_t*)(ws + WS_GLU); bf16_t* const BG = (bf16_t*)(ws + WS_BG);
        bf16_t* const CX = (bf16_t*)(ws + WS_CX); bf16_t* const GATES = (bf16_t*)(ws + WS_GATES); const float* const rope = (const float*)(ws + WS_ROPE);
        float* const nk = out + (size_t)M * D; float* const nv = nk + (size_t)16 * 2 * SEQC * KVD;
        const int pn = u.pn, row0 = u.pm * BM + u.rofs + wr * 64 + fr, cw = wc * 32 + 8 * fq;
        const bool latent = u.pm >= 16;
        if (pn < 10) {
            const bool isq = pn < 8; const int hp = isq ? pn : pn - 8;
            const int ocol = (2 * hp + (wc >> 1)) * 128 + 64 * (wc & 1) + 8 * fq;
            bf16_t* base = isq ? Qb : Kb; const int ld = isq ? D : KVD;
#pragma unroll
            for (int ai = 0; ai < 2; ++ai) { if (ai == 1 && u.half) break;
#pragma unroll
                for (int m = 0; m < 4; ++m) {
                    const int row = row0 + ai * HALF + m * 16;
                    const f32x4 x1a = acc[ai][0][m][0], x1b = acc[ai][0][m][1], x2a = acc[ai][1][m][0], x2b = acc[ai][1][m][1];
                    f32x4 o1a = x1a, o1b = x1b, o2a = x2a, o2b = x2b;
                    if (latent) {
                        const int t = (row - MC) & (SEQL - 1), pos = (wc & 1) ? (t & 63) : (t >> 6);
                        const f32x4* rp = (const f32x4*)(rope + ((size_t)pos * 32 + 8 * fq) * 2);
                        const f32x4 r0 = rp[0], r1 = rp[1], r2 = rp[2], r3 = rp[3];
                        o1a[0] = x1a[0] * r0[0] - x2a[0] * r0[1]; o2a[0] = x2a[0] * r0[0] + x1a[0] * r0[1];
                        o1a[1] = x1a[1] * r0[2] - x2a[1] * r0[3]; o2a[1] = x2a[1] * r0[2] + x1a[1] * r0[3];
                        o1a[2] = x1a[2] * r1[0] - x2a[2] * r1[1]; o2a[2] = x2a[2] * r1[0] + x1a[2] * r1[1];
                        o1a[3] = x1a[3] * r1[2] - x2a[3] * r1[3]; o2a[3] = x2a[3] * r1[2] + x1a[3] * r1[3];
                        o1b[0] = x1b[0] * r2[0] - x2b[0] * r2[1]; o2b[0] = x2b[0] * r2[0] + x1b[0] * r2[1];
                        o1b[1] = x1b[1] * r2[2] - x2b[1] * r2[3]; o2b[1] = x2b[1] * r2[2] + x1b[1] * r2[3];
                        o1b[2] = x1b[2] * r3[0] - x2b[2] * r3[1]; o2b[2] = x2b[2] * r3[0] + x1b[2] * r3[1];
                        o1b[3] = x1b[3] * r3[2] - x2b[3] * r3[3]; o2b[3] = x2b[3] * r3[2] + x1b[3] * r3[3];
                    }
                    bf16_t* op = base + (size_t)row * ld + ocol;
                    *(u32x4*)op = pack8(o1a, o1b); *(u32x4*)(op + 32) = pack8(o2a, o2b);
                    if (!isq && !latent) { float* p = nk + ((size_t)((row >> 8) * 2 + layer) * SEQC + (row & 255)) * KVD + ocol;
                        *(f32x4*)p = x1a; *(f32x4*)(p + 4) = x1b; *(f32x4*)(p + 32) = x2a; *(f32x4*)(p + 36) = x2b; }
                } }
        } else if (pn < 12) {
#pragma unroll
            for (int ai = 0; ai < 2; ++ai) { if (ai == 1 && u.half) break;
#pragma unroll
                for (int m = 0; m < 4; ++m) {
                    const int row = row0 + ai * HALF + m * 16;
#pragma unroll
                    for (int bj = 0; bj < 2; ++bj) { const int col = (pn - 10) * BM + bj * HALF + cw;
                        *(u32x4*)(Vb + (size_t)row * KVD + col) = pack8(acc[ai][bj][m][0], acc[ai][bj][m][1]);
                        if (!latent) { float* p = nv + ((size_t)((row >> 8) * 2 + layer) * SEQC + (row & 255)) * KVD + col; *(f32x4*)p = acc[ai][bj][m][0]; *(f32x4*)(p + 4) = acc[ai][bj][m][1]; } }
                } }
        } else if (pn < 20 || (pn >= 24 && pn < 32)) {
            const bool glu = pn < 20; bf16_t* base = glu ? GLU : CX; const int col = (glu ? pn - 12 : pn - 24) * HALF + cw;
#pragma unroll
            for (int ai = 0; ai < 2; ++ai) { if (ai == 1 && u.half) break;
#pragma unroll
                for (int m = 0; m < 4; ++m) {
                    bf16_t* op = base + (size_t)(row0 + ai * HALF + m * 16) * DCA + col;
                    if (glu) *(u32x4*)op = pack8(pair_op<PO_GLU>(acc[ai][0][m][0], acc[ai][1][m][0]), pair_op<PO_GLU>(acc[ai][0][m][1], acc[ai][1][m][1]));
                    else     *(u32x4*)op = pack8(pair_op<PO_MUL>(acc[ai][0][m][0], acc[ai][1][m][0]), pair_op<PO_MUL>(acc[ai][0][m][1], acc[ai][1][m][1]));
                } }
        } else if (pn < 24) {
#pragma unroll
            for (int ai = 0; ai < 2; ++ai) { if (ai == 1 && u.half) break;
#pragma unroll
                for (int m = 0; m < 4; ++m)
#pragma unroll
                    for (int bj = 0; bj < 2; ++bj)
                        *(u32x4*)(BG + (size_t)(row0 + ai * HALF + m * 16) * DCA + (pn - 20) * BM + bj * HALF + cw) = pack8(acc[ai][bj][m][0], acc[ai][bj][m][1]); }
        } else {
#pragma unroll
            for (int ai = 0; ai < 2; ++ai) { if (ai == 1 && u.half) break;
#pragma unroll
                for (int m = 0; m < 4; ++m)
#pragma unroll
                    for (int bj = 0; bj < 2; ++bj) { f32x4 a = acc[ai][bj][m][0], b = acc[ai][bj][m][1];
#pragma unroll
                        for (int e = 0; e < 4; ++e) { a[e] = fmaxf(fsigm(a[e]), 1e-20f); b[e] = fmaxf(fsigm(b[e]), 1e-20f); }
                        *(u32x4*)(GATES + gt_off((pn - 32) >> 3, u.pm, (pn - 32) & 7) + gt_reg(wr, wc, fr, fq, ai, m, bj)) = pack8(a, b); } }
        }
    }
};
struct EpiMixK {
    static constexpr bool PERM = true, AFTER_DRAIN = false, RESCALE = true, PREFETCH = false;
    bf16_t* MIX; const bf16_t* GATES;
    __device__ __forceinline__ void rescale(f32x4 (&acc)[2][2][4][2], const UnitK& u, int stage, int wr, int wc, int fr, int fq) const {
        const int row0 = u.pm * BM + u.rofs + wr * 64 + fr, col0 = u.pn * BM + wc * 32 + 8 * fq;
#pragma unroll
        for (int ai = 0; ai < 2; ++ai) { if (ai == 1 && u.half) break;
            u32x4 gn[4][2], gd[4][2];
#pragma unroll
            for (int m = 0; m < 4; ++m) {
                const bf16_t* gp = GATES + gt_off(stage, u.pm, u.pn);
#pragma unroll
                for (int bj = 0; bj < 2; ++bj) { gn[m][bj] = *(const u32x4*)(gp + gt_reg(wr, wc, fr, fq, ai, m, bj)); gd[m][bj] = *(const u32x4*)(gp + gt_off(1, 0, 0) + gt_reg(wr, wc, fr, fq, ai, m, bj)); } }
            __builtin_amdgcn_sched_barrier(0);
#pragma unroll
            for (int m = 0; m < 4; ++m)
#pragma unroll
                for (int bj = 0; bj < 2; ++bj) { f32x4 na, nb, da, db; unpack8(gn[m][bj], na, nb); unpack8(gd[m][bj], da, db);
#pragma unroll
                    for (int e_ = 0; e_ < 4; ++e_) { acc[ai][bj][m][0][e_] *= na[e_] * __builtin_amdgcn_rcpf(da[e_]); acc[ai][bj][m][1][e_] *= nb[e_] * __builtin_amdgcn_rcpf(db[e_]); } }
        }
    }
    __device__ __forceinline__ void operator()(const f32x4 (&acc)[2][2][4][2], const UnitK& u, int wr, int wc, int fr, int fq, PG8_LAS unsigned char* ldsb) const {
        const int row0 = u.pm * BM + u.rofs + wr * 64 + fr, col0 = u.pn * BM + wc * 32 + 8 * fq;
#pragma unroll
        for (int ai = 0; ai < 2; ++ai) { if (ai == 1 && u.half) break;
            u32x4 gc[4][2];
#pragma unroll
            for (int m = 0; m < 4; ++m)
#pragma unroll
                for (int bj = 0; bj < 2; ++bj) gc[m][bj] = *(const u32x4*)(GATES + gt_off(2, u.pm, u.pn) + gt_reg(wr, wc, fr, fq, ai, m, bj));
            __builtin_amdgcn_sched_barrier(0);
#pragma unroll
            for (int m = 0; m < 4; ++m) {
                const size_t row = (size_t)(row0 + ai * HALF + m * 16);
#pragma unroll
                for (int bj = 0; bj < 2; ++bj) { const int col = col0 + bj * HALF;
                    f32x4 ga, gb; unpack8(gc[m][bj], ga, gb);
                    *(u32x4*)(MIX + ::blk_off((int)row, col, D / 32)) = pack8(ga * acc[ai][bj][m][0], gb * acc[ai][bj][m][1]); }
            } }
    }
};

template <int MM, int NN, int KK, bool HT> struct TailOrder {
    static constexpr bool QUEUE = false;
    static constexpr int nM = MM / BM, nN = NN / BM, nwg = nM * nN;
    int G, c;
    __device__ __forceinline__ void init(int G_, int c_) { G = G_; c = c_; }
    __device__ __forceinline__ void map(int L, UnitK& u) const {
        int wgid = L; { constexpr int q = nwg / NXCD, r = nwg % NXCD; const int xcd = wgid % NXCD, off = wgid / NXCD; wgid = (xcd < r ? xcd * (q + 1) : r * (q + 1) + (xcd - r) * q) + off; }
        constexpr int nig = WGM * nN; const int gid = wgid / nig, fm = gid * WGM, gsz = (nM - fm) < WGM ? (nM - fm) : WGM;
        u.pm = fm + ((wgid % nig) % gsz); u.pn = (wgid % nig) / gsz; }
    __device__ __forceinline__ bool next(int i, UnitK& u) const {
        const int F = nwg / G, Rem = nwg - F * G;
        const int s0 = Rem > 0 ? G / Rem : 1; const int s = (HT && Rem > 0 && (G % 8 == 0) && (G % Rem == 0) && ((G / 8) % s0 == 0) && s0 >= 2) ? s0 : 1;
        const bool ht = s > 1; const int x = c & 7, y = c >> 3, q = ht ? y % s : 0;
        const bool tail = i == F;
        const bool has = i < F || (tail && (ht ? q < 2 : c < Rem));
        if (i > F || !has) return false;
        const int L = (tail && ht) ? F * G + x + 8 * (y / s) : i * G + c;
        map(L, u); u.half = (tail && ht) ? 1 : 0; u.rofs = (tail && ht) ? 128 * q : 0;
        return true; }
    __device__ __forceinline__ void a_ready(const Unit&) const {}
    __device__ __forceinline__ void done(const Unit&) const {}
};

template <int NN, int PM0, int NML, int R, int KA, int KB, bool PNMIX = false> struct DealOrder {
    static constexpr bool QUEUE = false;
    static constexpr int nN = NN / BM, U = NML * nN, Q = U / 8;
    static_assert(NML % 8 == 0 && R * KA + (32 - R) * KB == Q, "DealOrder: the per-rank counts must cover the XCD chunk exactly");
    int G, c;
    __device__ __forceinline__ void init(int G_, int c_) { G = G_; c = c_; }
    __device__ __forceinline__ bool next(int i, UnitK& u) const {
        const bool grid_ok = G == 256; const int x = c & 7, r = c >> 3;
        const int cnt = grid_ok ? (r < R ? KA : KB) : (U - c + G - 1) / G;
        if (i >= cnt) return false;
        constexpr int lo = KA < KB ? KA : KB;
        const int idx = i < lo ? i * 32 + r : (KA > KB ? lo * 32 + (i - lo) * R + r : lo * 32 + (i - lo) * (32 - R) + (r - R));
        const int L = grid_ok ? x * Q + idx : i * G + c;
        constexpr int nig = 8 * nN; const int gid = L / nig, rem = L % nig;
        const int pj = rem >> 3;
        u.pm = PM0 + gid * 8 + (rem & 7); u.pn = PNMIX ? ((pj & 1) ? nN / 2 + (pj >> 1) : (pj >> 1)) : pj; u.half = 0; u.rofs = 0;
        return true; }
    __device__ __forceinline__ void a_ready(const Unit&) const {}
    __device__ __forceinline__ void done(const Unit&) const {}
};

#ifndef B_AUX
#define B_AUX 0
#endif
#define QGRP_C_DEFAULT 4
#ifndef QGRP_C
#define QGRP_C QGRP_C_DEFAULT
#endif
#ifndef QGRP
#define QGRP 4
#endif
template <int NN, int PM0, int NML, int TYPE, bool PNMIX = false> struct QueueOrder {
    static constexpr bool QUEUE = true;
    static constexpr int nN = NN / BM, U = NML * nN, Q = U / 8;
    static_assert(NML % 8 == 0 && NML % QGRP == 0 && 16 % QGRP_C == 0, "QueueOrder: whole panel groups");
    int G, c; unsigned* head;
    __device__ __forceinline__ void init(int G_, int c_, unsigned* head_) { G = G_; c = c_; head = head_; }
    __device__ __forceinline__ bool dynamic() const { return G == 256 && Q > 32; }
    __device__ __forceinline__ void decode(int L, UnitK& u) const {
        constexpr int GRP = (NML == 16) ? QGRP_C : QGRP; constexpr int nig = GRP * nN; const int gid = L / nig, rem = L % nig; int pj = rem / GRP;
#ifdef USE_STAGGER
        if (Q % nig == 0) { pj += (c & 7) * (nN / 8); if (pj >= nN) pj -= nN; }
#endif
        u.pm = PM0 + gid * GRP + (rem % GRP); u.pn = PNMIX ? ((pj & 1) ? nN / 2 + (pj >> 1) : (pj >> 1)) : pj; u.half = 0; u.rofs = 0; }
    __device__ __forceinline__ bool first(UnitK& u) const {
        if (G != 256) { if (c >= U) return false; decode(c, u); return true; }
        const int x = c & 7, r = c >> 3, idx = TYPE == 0 ? r : (r >= 16 ? r - 16 : r + 16);
        if (idx >= Q) return false; decode(x * Q + idx, u); return true; }
    __device__ __forceinline__ unsigned* ticket_word() const { return head + 64 * (c & 7); }
    __device__ __forceinline__ bool later(int i, unsigned ticket, UnitK& u) const {
        if (G != 256) { const long L = (long)i * G + c; if (L >= U) return false; decode((int)L, u); return true; }
        if (!dynamic()) return false;
        const int idx = 32 + (int)ticket; if (idx >= Q) return false; decode((c & 7) * Q + idx, u); return true; }
    __device__ __forceinline__ void a_ready(const Unit&) const {}
    __device__ __forceinline__ void done(const Unit&) const {}
};
template <class Epi, class Sched, int KK, int LDA, int LDB>
__device__ __forceinline__ void gemm_phase_ht(PG8_LAS unsigned char* lds, const Gemm g, const Sched& S, const Epi& E) {
#ifdef NO_SP2
    constexpr bool ALIGN_EPI = true, SP2 = false;
#else
    constexpr bool ALIGN_EPI = true, SP2 = true;
#endif
    const int tid = fresh_tid(), wid = __builtin_amdgcn_readfirstlane(tid >> 6), lane = tid & 63, wr = wid >> 2, wc = wid & 3, fr = lane & 15, fq = lane >> 4;
    constexpr int K = KK, nt = K / BK, NKB = KK / 32;
    unsigned voffA[2], voffB[2];
#pragma unroll
    for (int i = 0; i < 2; ++i) { int R, C; stage_rc(tid * 16 + i * 8192, R, C); const int Rb = Epi::PERM ? ((R & ~31) + perm32(R & 31)) : R;
        voffA[i] = (unsigned)((((R >> 4) * NKB + (C >> 5)) << 9) + ((R & 15) << 5) + (C & 31)) * 2u; voffB[i] = (unsigned)((((Rb >> 4) * NKB + (C >> 5)) << 9) + ((Rb & 15) << 5) + (C & 31)) * 2u; }
    constexpr size_t kstep = 2048, kstepB = 2048;
    constexpr size_t hstepA = (size_t)(HALF / 16) * NKB * 1024, hstepB = (size_t)(HALF / 16) * NKB * 1024;
    constexpr size_t tstepA = 2 * hstepA, tstepB = 2 * hstepB;
    const unsigned ldsb32 = (unsigned)(__UINTPTR_TYPE__)lds; (void)ldsb32;
    const unsigned ldsw = (unsigned)wid * 1024u;
    const int aoff = lds_byte(wr * 64 + fr, fq * 8), boff = lds_byte(wc * 32 + fr, fq * 8);
#define PG8_SA(b, h) (((b) * 2 + (h)) * HTB)
#define PG8_SB(b, h) ((4 + (b) * 2 + (h)) * HTB)
#ifndef PROBE_HIT
#define PROBE_HIT 0
#endif
#ifdef KNOB_NOPRIO
#define PG8_PRIO_HI
#define PG8_PRIO_LO
#else
#define PG8_PRIO_HI __builtin_amdgcn_s_setprio(1)
#define PG8_PRIO_LO __builtin_amdgcn_s_setprio(0)
#endif
#ifdef KNOB_SADDR
#define PG8_STAGE(bufoff, gbase, voff) do { if ((PROBE_HIT == 2 || PROBE_HIT == 5) && g.hit) break; _Pragma("unroll") for (int _i = 0; _i < 2; ++_i) { \
        const unsigned la_ = ldsb32 + (unsigned)(bufoff) + ldsw + (unsigned)_i * 8192u; const char* gb_ = (const char*)(gbase); \
        asm volatile("s_mov_b32 m0, %2\n\ts_nop 0\n\tglobal_load_lds_dwordx4 %0, %1" :: "v"((voff)[_i]), "s"(gb_), "s"(la_) : "memory"); } } while (0)
#define PG8_STAGEB(bufoff, gbase, voff) PG8_STAGE(bufoff, gbase, voff)
#else
#define PG8_STAGE(bufoff, gbase, voff) do { if ((PROBE_HIT == 2 || PROBE_HIT == 5) && g.hit) break; _Pragma("unroll") for (int _i = 0; _i < 2; ++_i) \
        __builtin_amdgcn_global_load_lds((const unsigned*)((const char*)(gbase) + (voff)[_i]), (PG8_LAS unsigned*)(lds + (bufoff) + ldsw + _i * 8192), 16, 0, 0); } while (0)
#define PG8_STAGEB(bufoff, gbase, voff) do { if ((PROBE_HIT == 2 || PROBE_HIT == 5) && g.hit) break; _Pragma("unroll") for (int _i = 0; _i < 2; ++_i) \
        __builtin_amdgcn_global_load_lds((const unsigned*)((const char*)(gbase) + (voff)[_i]), (PG8_LAS unsigned*)(lds + (bufoff) + ldsw + _i * 8192), 16, 0, B_AUX); } while (0)
#endif
#define PG8_LDA(dst, b, h) do { if ((PROBE_HIT == 4 || PROBE_HIT == 5) && g.hit) break; _Pragma("unroll") for (int m = 0; m < 4; ++m) _Pragma("unroll") for (int k = 0; k < 2; ++k) dst[m][k] = *(const PG8_LAS bf16x8*)(lds + PG8_SA(b, h) + aoff + m * 2048 + k * 1024); } while (0)
#define PG8_LDB(dst, b, h) do { if ((PROBE_HIT == 4 || PROBE_HIT == 5) && g.hit) break; _Pragma("unroll") for (int n = 0; n < 2; ++n) _Pragma("unroll") for (int k = 0; k < 2; ++k) dst[n][k] = *(const PG8_LAS bf16x8*)(lds + PG8_SB(b, h) + boff + n * 2048 + k * 1024); } while (0)
#define PG8_MMA(ai, bj, At, Bt) do { if (PROBE_HIT == 3 && g.hit) break; PG8_PRIO_HI; _Pragma("unroll") for (int m = 0; m < 4; ++m) _Pragma("unroll") for (int n = 0; n < 2; ++n) _Pragma("unroll") for (int k = 0; k < 2; ++k) \
        acc[ai][bj][m][n] = __builtin_amdgcn_mfma_f32_16x16x32_bf16(Bt[n][k], At[m][k], acc[ai][bj][m][n], 0, 0, 0); PG8_PRIO_LO; } while (0)
#define PG8_WAIT_V(n) asm volatile("s_waitcnt vmcnt(" #n ")" ::: "memory")
#define PG8_WAIT_L(n) asm volatile("s_waitcnt lgkmcnt(" #n ")" ::: "memory")
#define PG8_BAR __builtin_amdgcn_s_barrier()
#define PG8_SCHED __builtin_amdgcn_sched_barrier(0)
    UnitK cur, nxt; int ui = 0;
    if constexpr (Sched::QUEUE) { if (!S.first(cur)) return; } else { if (!S.next(0, cur)) return; }
    volatile PG8_LAS unsigned* tkw = (volatile PG8_LAS unsigned*)(lds + STAGE_BYTES + 1024);
    f32x4 acc[2][2][4][2];
#pragma unroll
    for (int a = 0; a < 2; ++a)
#pragma unroll
        for (int b = 0; b < 2; ++b)
#pragma unroll
            for (int m = 0; m < 4; ++m)
#pragma unroll
                for (int n = 0; n < 2; ++n) acc[a][b][m][n] = (f32x4){0.f, 0.f, 0.f, 0.f};
    bf16x8 At[4][2], B0[2][2], B1[2][2];
    const char* cA = (const char*)g.A + (size_t)(g.hit ? g.hitpm : cur.pm) * tstepA + (size_t)(cur.rofs >> 4) * NKB * 1024; const char* cB = (const char*)g.Bt + (size_t)(g.hit ? 0 : cur.pn) * tstepB;
    S.a_ready(cur);
    if constexpr (SP2) {
        PG8_STAGEB(PG8_SB(0, 0), cB, voffB); PG8_STAGEB(PG8_SB(0, 1), cB + hstepB, voffB); PG8_STAGE(PG8_SA(0, 0), cA, voffA); PG8_STAGE(PG8_SA(0, 1), cA + hstepA, voffA);
        if (wr == 1) PG8_BAR;
        PG8_WAIT_V(2); PG8_BAR;
        PG8_STAGEB(PG8_SB(1, 0), cB + kstepB, voffB); PG8_STAGE(PG8_SA(1, 0), cA + kstep, voffA); PG8_STAGEB(PG8_SB(1, 1), cB + hstepB + kstepB, voffB);
        PG8_WAIT_V(6); PG8_BAR;
#ifdef KNOB_ASYM
        if (wr == 1) PG8_STAGE(PG8_SA(1, 1), cA + kstep + hstepA, voffA);
#endif
    } else {
        PG8_STAGEB(PG8_SB(0, 0), cB, voffB); PG8_STAGE(PG8_SA(0, 0), cA, voffA); PG8_STAGEB(PG8_SB(0, 1), cB + hstepB, voffB); PG8_STAGE(PG8_SA(0, 1), cA + hstepA, voffA);
        if (wr == 1) PG8_BAR;
        PG8_WAIT_V(4); PG8_BAR;
        PG8_STAGEB(PG8_SB(1, 0), cB + kstepB, voffB); PG8_STAGE(PG8_SA(1, 0), cA + kstep, voffA); PG8_STAGEB(PG8_SB(1, 1), cB + hstepB + kstepB, voffB);
        PG8_WAIT_V(6); PG8_BAR;
    }
    for (;;) {
        bool has_next = false; const char* nA = cA; const char* nB = cB; unsigned tk_ = 0u;
        if constexpr (Sched::QUEUE) { if (S.dynamic() && tid == 0) tk_ = __hip_atomic_fetch_add(S.ticket_word(), 1u, __ATOMIC_RELAXED, __HIP_MEMORY_SCOPE_AGENT); }
        else { has_next = S.next(ui + 1, nxt);
            nA = has_next ? (const char*)g.A + (size_t)(g.hit ? g.hitpm : nxt.pm) * tstepA + (size_t)(nxt.rofs >> 4) * NKB * 1024 : cA; nB = has_next ? (const char*)g.Bt + (size_t)(g.hit ? 0 : nxt.pn) * tstepB : cB; }
        for (int t = 0; t < nt; t += 2) {
            if constexpr (Epi::RESCALE) { if (t == 16 || t == 32) { const int tid_r = fresh_tid(); E.rescale(acc, cur, t == 16 ? 0 : 1, wr, wc, tid_r & 15, (tid_r & 63) >> 4); } }
            if constexpr (Epi::PREFETCH) { if (nt >= 32 && t == nt - 16) { const int tid_p = fresh_tid(); E.prefetch(cur, wid, tid_p & 63); } }
            const bool last = (t == nt - 2);
            if constexpr (Sched::QUEUE) {
                if (t == 4 && tid == 0) *tkw = tk_;
                if (last) { const unsigned tkv = S.dynamic() ? (unsigned)__builtin_amdgcn_readfirstlane((int)*tkw) : 0u; has_next = S.later(ui + 1, tkv, nxt);
                    nA = has_next ? (const char*)g.A + (size_t)(g.hit ? g.hitpm : nxt.pm) * tstepA + (size_t)(nxt.rofs >> 4) * NKB * 1024 : cA; nB = has_next ? (const char*)g.Bt + (size_t)(g.hit ? 0 : nxt.pn) * tstepB : cB; } }
            const char* a1 = cA + (size_t)(t + 1) * kstep;
            const char* a2 = last ? nA : cA + (size_t)(t + 2) * kstep; const char* b2 = last ? nB : cB + (size_t)(t + 2) * kstepB;
            const char* a3 = a2 + kstep; const char* b3 = b2 + kstepB;
            if (last && has_next) S.a_ready(nxt);
            if constexpr (SP2) {
#ifdef KNOB_ASYM
            PG8_LDB(B0, 0, 0); PG8_LDB(B1, 0, 1); PG8_SCHED; PG8_LDA(At, 0, 0);
            if (wr == 0) { PG8_STAGE(PG8_SA(1, 1), a1 + hstepA, voffA); }
            PG8_WAIT_V(8);
            PG8_WAIT_L(0); PG8_BAR;
            if (wr == 1) { PG8_STAGEB(PG8_SB(0, 0), b2, voffB); PG8_STAGEB(PG8_SB(0, 1), b2 + hstepB, voffB); PG8_STAGE(PG8_SA(0, 0), a2, voffA); }
            PG8_MMA(0, 0, At, B0); PG8_MMA(0, 1, At, B1); PG8_BAR; PG8_SCHED;
            PG8_LDA(At, 0, 1);
            if (wr == 0) { PG8_STAGEB(PG8_SB(0, 0), b2, voffB); PG8_STAGEB(PG8_SB(0, 1), b2 + hstepB, voffB); PG8_STAGE(PG8_SA(0, 0), a2, voffA); }
            PG8_WAIT_V(8);
            PG8_WAIT_L(0); PG8_BAR;
            if (wr == 1) { PG8_STAGE(PG8_SA(0, 1), a2 + hstepA, voffA); }
            if (!cur.half) { PG8_MMA(1, 0, At, B0); PG8_MMA(1, 1, At, B1); } PG8_BAR; PG8_SCHED;
            PG8_LDB(B0, 1, 0); PG8_LDB(B1, 1, 1); PG8_SCHED; PG8_LDA(At, 1, 0);
            if (wr == 0) { PG8_STAGE(PG8_SA(0, 1), a2 + hstepA, voffA); }
            PG8_WAIT_V(8);
            PG8_WAIT_L(0); PG8_BAR;
            if (wr == 1) { PG8_STAGEB(PG8_SB(1, 0), b3, voffB); PG8_STAGEB(PG8_SB(1, 1), b3 + hstepB, voffB); PG8_STAGE(PG8_SA(1, 0), a3, voffA); }
            PG8_MMA(0, 0, At, B0); PG8_MMA(0, 1, At, B1); PG8_BAR; PG8_SCHED;
            PG8_LDA(At, 1, 1);
            if (wr == 0) { PG8_STAGEB(PG8_SB(1, 0), b3, voffB); PG8_STAGEB(PG8_SB(1, 1), b3 + hstepB, voffB); PG8_STAGE(PG8_SA(1, 0), a3, voffA); }
            PG8_WAIT_V(8);
            PG8_WAIT_L(0); PG8_BAR;
            if (wr == 1) { PG8_STAGE(PG8_SA(1, 1), a3 + hstepA, voffA); }
            if (!cur.half) { PG8_MMA(1, 0, At, B0); PG8_MMA(1, 1, At, B1); } PG8_BAR; PG8_SCHED;
#else
#ifdef KNOB_FILLFIRST
            PG8_STAGE(PG8_SA(1, 1), a1 + hstepA, voffA); PG8_SCHED; PG8_LDB(B0, 0, 0); PG8_LDB(B1, 0, 1); PG8_SCHED; PG8_LDA(At, 0, 0);
#else
            PG8_LDB(B0, 0, 0); PG8_LDB(B1, 0, 1); PG8_SCHED; PG8_LDA(At, 0, 0); PG8_STAGE(PG8_SA(1, 1), a1 + hstepA, voffA);
#endif
            PG8_WAIT_V(8); PG8_WAIT_L(0); PG8_BAR; PG8_MMA(0, 0, At, B0); PG8_MMA(0, 1, At, B1); PG8_BAR; PG8_SCHED;
#ifdef KNOB_FILLFIRST
            PG8_STAGEB(PG8_SB(0, 0), b2, voffB); PG8_STAGEB(PG8_SB(0, 1), b2 + hstepB, voffB); PG8_STAGE(PG8_SA(0, 0), a2, voffA); PG8_SCHED; PG8_LDA(At, 0, 1);
#else
            PG8_LDA(At, 0, 1); PG8_STAGEB(PG8_SB(0, 0), b2, voffB); PG8_STAGEB(PG8_SB(0, 1), b2 + hstepB, voffB); PG8_STAGE(PG8_SA(0, 0), a2, voffA);
#endif
            PG8_WAIT_V(8); PG8_WAIT_L(0); PG8_BAR; if (!cur.half) { PG8_MMA(1, 0, At, B0); PG8_MMA(1, 1, At, B1); } PG8_BAR; PG8_SCHED;
#ifdef KNOB_FILLFIRST
            PG8_STAGE(PG8_SA(0, 1), a2 + hstepA, voffA); PG8_SCHED; PG8_LDB(B0, 1, 0); PG8_LDB(B1, 1, 1); PG8_SCHED; PG8_LDA(At, 1, 0);
#else
            PG8_LDB(B0, 1, 0); PG8_LDB(B1, 1, 1); PG8_SCHED; PG8_LDA(At, 1, 0); PG8_STAGE(PG8_SA(0, 1), a2 + hstepA, voffA);
#endif
            PG8_WAIT_V(8); PG8_WAIT_L(0); PG8_BAR; PG8_MMA(0, 0, At, B0); PG8_MMA(0, 1, At, B1); PG8_BAR; PG8_SCHED;
#ifdef KNOB_FILLFIRST
            PG8_STAGEB(PG8_SB(1, 0), b3, voffB); PG8_STAGEB(PG8_SB(1, 1), b3 + hstepB, voffB); PG8_STAGE(PG8_SA(1, 0), a3, voffA); PG8_SCHED; PG8_LDA(At, 1, 1);
#else
            PG8_LDA(At, 1, 1); PG8_STAGEB(PG8_SB(1, 0), b3, voffB); PG8_STAGEB(PG8_SB(1, 1), b3 + hstepB, voffB); PG8_STAGE(PG8_SA(1, 0), a3, voffA);
#endif
            PG8_WAIT_V(8); PG8_WAIT_L(0); PG8_BAR; if (!cur.half) { PG8_MMA(1, 0, At, B0); PG8_MMA(1, 1, At, B1); } PG8_BAR; PG8_SCHED;
#endif
            } else {
            PG8_LDB(B0, 0, 0); PG8_SCHED; PG8_LDA(At, 0, 0); PG8_STAGE(PG8_SA(1, 1), a1 + hstepA, voffA);
            PG8_WAIT_L(8); PG8_BAR; PG8_WAIT_L(0); PG8_MMA(0, 0, At, B0); PG8_BAR; PG8_SCHED;
            PG8_LDB(B1, 0, 1); PG8_STAGEB(PG8_SB(0, 0), b2, voffB);
            PG8_BAR; PG8_WAIT_L(0); PG8_MMA(0, 1, At, B1); PG8_BAR;
            PG8_LDA(At, 0, 1); PG8_STAGE(PG8_SA(0, 0), a2, voffA);
            PG8_BAR; PG8_WAIT_L(0); PG8_MMA(1, 0, At, B0); PG8_BAR; PG8_SCHED;
            PG8_STAGEB(PG8_SB(0, 1), b2 + hstepB, voffB);
            PG8_WAIT_V(6); PG8_BAR; PG8_MMA(1, 1, At, B1); PG8_BAR;
            PG8_LDB(B0, 1, 0); PG8_SCHED; PG8_LDA(At, 1, 0); PG8_STAGE(PG8_SA(0, 1), a2 + hstepA, voffA);
            PG8_WAIT_L(8); PG8_BAR; PG8_WAIT_L(0); PG8_MMA(0, 0, At, B0); PG8_BAR; PG8_SCHED;
            PG8_LDB(B1, 1, 1); PG8_STAGEB(PG8_SB(1, 0), b3, voffB);
            PG8_BAR; PG8_WAIT_L(0); PG8_MMA(0, 1, At, B1); PG8_BAR;
            PG8_LDA(At, 1, 1); PG8_STAGE(PG8_SA(1, 0), a3, voffA);
            PG8_BAR; PG8_WAIT_L(0); PG8_MMA(1, 0, At, B0); PG8_BAR; PG8_SCHED;
            PG8_STAGEB(PG8_SB(1, 1), b3 + hstepB, voffB);
            PG8_WAIT_V(6); PG8_BAR; PG8_MMA(1, 1, At, B1); PG8_BAR;
            }
        }
        if constexpr (ALIGN_EPI) { if (wr == 0) PG8_BAR; }
        if (!(PROBE_HIT == 6 && g.hit)) { const int tid_e = fresh_tid(); E(acc, cur, wr, wc, tid_e & 15, (tid_e & 63) >> 4, lds); }
        if (!has_next) break;
#pragma unroll
        for (int a = 0; a < 2; ++a)
#pragma unroll
            for (int b = 0; b < 2; ++b)
#pragma unroll
                for (int m = 0; m < 4; ++m)
#pragma unroll
                    for (int n = 0; n < 2; ++n) acc[a][b][m][n] = (f32x4){0.f, 0.f, 0.f, 0.f};
        cur = nxt; cA = nA; cB = nB; ++ui;
        if constexpr (ALIGN_EPI) { if (wr == 1) PG8_BAR; }
    }
    PG8_WAIT_V(0);
    if constexpr (!ALIGN_EPI) { if (wr == 0) PG8_BAR; }
    PG8_BAR;
#undef PG8_SA
#undef PG8_SB
#undef PG8_STAGE
#undef PG8_STAGEB
#undef PG8_LDA
#undef PG8_LDB
#undef PG8_MMA
#undef PG8_WAIT_V
#undef PG8_WAIT_L
#undef PG8_BAR
#undef PG8_SCHED
}
}

namespace att {
typedef unsigned short bf16;
typedef short bf16x8 __attribute__((ext_vector_type(8)));
typedef short s16x4 __attribute__((ext_vector_type(4)));
typedef float f32x16 __attribute__((ext_vector_type(16)));
typedef unsigned u32x4 __attribute__((ext_vector_type(4)));
constexpr float SCALE = 0.08838834764831845f, THR = 8.f;
constexpr int SHM_V = 16384, SHM_K = 16384, NW = 8;
constexpr int LDS_BYTES = 2 * SHM_V + 2 * SHM_K + NW * 64 * 4;
#define KSWZ(row, colB) ((row) * 256 + ((colB) ^ (((row) & 7) << 4)))
#define SBAR() __builtin_amdgcn_sched_barrier(0)
__device__ __forceinline__ int v_st(int k, int c) { const int kk = (k & ~0xC) | ((k & 4) << 1) | ((k & 8) >> 1); return ((kk >> 3) * 4 + (c >> 5)) * 512 + ((kk & 7) * 32 + (c & 31)) * 2; }
__device__ __forceinline__ int v_rd_base(int lane) { return ((lane & 3) << 3) | (((lane >> 2) & 3) << 6) | (((lane >> 4) & 1) << 5) | (((lane >> 5) & 1) << 8); }
constexpr int v_rd_off(int d0, int ks, int half) { return d0 * 512 + ks * 4096 + half * 2048; }
__device__ __forceinline__ int crow(int r, int hi) { return (r & 3) + 8 * (r >> 2) + 4 * hi; }
__device__ __forceinline__ unsigned cvtpk(float lo, float hi) { unsigned r; asm volatile("v_cvt_pk_bf16_f32 %0, %1, %2" : "=v"(r) : "v"(lo), "v"(hi)); return r; }
__device__ __forceinline__ void mask_tile(f32x16& p0, f32x16& p1, int d, int type) {
    const float NEG = -__builtin_inff();
#pragma unroll
    for (int r = 0; r < 16; ++r) {
        const int c = (r & 3) + 8 * (r >> 2);
        if (type == 1) { if (c < d) p0[r] = NEG; if (c + 32 < d) p1[r] = NEG; }
        else           { if (c > d) p0[r] = NEG; if (c + 32 > d) p1[r] = NEG; }
    }
}
__device__ __forceinline__ void partialSM(f32x16& p0, f32x16& p1, float& m_reg, float& mn, float& alpha) {
    float pmax = p0[0]; for (int r = 1; r < 16; ++r) pmax = fmaxf(pmax, p0[r]); for (int r = 0; r < 16; ++r) pmax = fmaxf(pmax, p1[r]);
    { auto rr = __builtin_amdgcn_permlane32_swap(__float_as_uint(pmax), __float_as_uint(pmax), false, false);
      pmax = fmaxf(__uint_as_float(rr[0]), __uint_as_float(rr[1])); }
    constexpr float C2 = 1.4426950408889634f * SCALE;
    if (__builtin_expect(__all((pmax - m_reg) * SCALE <= THR), 1)) { mn = m_reg; alpha = 1.f; }
    else { mn = fmaxf(m_reg, pmax); alpha = __builtin_amdgcn_exp2f((m_reg - mn) * C2); m_reg = mn; }
    const float mnL = -mn * C2;
    for (int r = 0; r < 16; ++r) p0[r] = fmaf(p0[r], C2, mnL); for (int r = 0; r < 16; ++r) p1[r] = fmaf(p1[r], C2, mnL);
    for (int r = 0; r < 16; ++r) p0[r] = __builtin_amdgcn_exp2f(p0[r]);
}
__device__ __forceinline__ void finishSM(f32x16& p0, f32x16& p1, float alpha, float& l_reg, bf16x8& pa0, bf16x8& pa1, bf16x8& pa2, bf16x8& pa3) {
    for (int r = 0; r < 16; ++r) p1[r] = __builtin_amdgcn_exp2f(p1[r]);
    float ps = 0; for (int r = 0; r < 16; ++r) ps += p0[r]; for (int r = 0; r < 16; ++r) ps += p1[r];
    { auto rr = __builtin_amdgcn_permlane32_swap(__float_as_uint(ps), __float_as_uint(ps), false, false);
      ps = __uint_as_float(rr[0]) + __uint_as_float(rr[1]); }
    l_reg = l_reg * alpha + ps;
#define PK4(P, B_, OUT) do { unsigned a0 = cvtpk(P[B_+0], P[B_+1]), a1 = cvtpk(P[B_+2], P[B_+3]);                          \
        unsigned b0 = cvtpk(P[B_+4], P[B_+5]), b1 = cvtpk(P[B_+6], P[B_+7]);                                             \
        auto r0 = __builtin_amdgcn_permlane32_swap(a0, b0, false, false); auto r1 = __builtin_amdgcn_permlane32_swap(a1, b1, false, false); \
        u32x4 w = {r0[0], r1[0], r0[1], r1[1]}; OUT = *reinterpret_cast<bf16x8*>(&w); } while (0)
    PK4(p0, 0, pa0); PK4(p0, 8, pa1); PK4(p1, 0, pa2); PK4(p1, 8, pa3);
#undef PK4
}
template <int KB>
__device__ __forceinline__ void qkt(f32x16& p0, f32x16& p1, const char* K_lds, int r32, int hi, const bf16x8* qr) {
    p0 = f32x16{}; p1 = f32x16{};
    const char* kb[4];
#pragma unroll
    for (int dd = 0; dd < 4; ++dd) kb[dd] = K_lds + KB * SHM_K + KSWZ(r32, (dd * 16 + hi * 8) * 2);
#pragma unroll
    for (int d0 = 0; d0 < 8; ++d0) { const char* a = kb[d0 & 3] + (d0 >> 2) * 128;
        bf16x8 b0 = *reinterpret_cast<const bf16x8*>(a);
        bf16x8 b1 = *reinterpret_cast<const bf16x8*>(a + 32 * 256);
        p0 = __builtin_amdgcn_mfma_f32_32x32x16_bf16(b0, qr[d0], p0, 0, 0, 0);
        p1 = __builtin_amdgcn_mfma_f32_32x32x16_bf16(b1, qr[d0], p1, 0, 0, 0); }
}
template <int VB>
__device__ __forceinline__ void pv_tile(f32x16* o, int vb0, bf16x8 pa0, bf16x8 pa1, bf16x8 pa2, bf16x8 pa3) {
#define TRRD(dst, off) asm volatile("ds_read_b64_tr_b16 %0, %1 offset:%2" : "=&v"(dst) : "v"(vb0), "i"(off) : "memory")
#define PV_RD(S, d0) do { constexpr int b_ = VB * SHM_V + v_rd_off(d0, 0, 0); \
        TRRD(l0##S, b_); TRRD(h0##S, b_ + 2048); TRRD(l1##S, b_ + 4096); TRRD(h1##S, b_ + 6144); TRRD(l2##S, b_ + 8192); TRRD(h2##S, b_ + 10240); TRRD(l3##S, b_ + 12288); TRRD(h3##S, b_ + 14336); } while (0)
#define PV_MM(S, d0) do { \
        o[d0] = __builtin_amdgcn_mfma_f32_32x32x16_bf16(pa0, (bf16x8){l0##S[0], l0##S[1], l0##S[2], l0##S[3], h0##S[0], h0##S[1], h0##S[2], h0##S[3]}, o[d0], 0, 0, 0);   \
        o[d0] = __builtin_amdgcn_mfma_f32_32x32x16_bf16(pa1, (bf16x8){l1##S[0], l1##S[1], l1##S[2], l1##S[3], h1##S[0], h1##S[1], h1##S[2], h1##S[3]}, o[d0], 0, 0, 0);   \
        o[d0] = __builtin_amdgcn_mfma_f32_32x32x16_bf16(pa2, (bf16x8){l2##S[0], l2##S[1], l2##S[2], l2##S[3], h2##S[0], h2##S[1], h2##S[2], h2##S[3]}, o[d0], 0, 0, 0);   \
        o[d0] = __builtin_amdgcn_mfma_f32_32x32x16_bf16(pa3, (bf16x8){l3##S[0], l3##S[1], l3##S[2], l3##S[3], h3##S[0], h3##S[1], h3##S[2], h3##S[3]}, o[d0], 0, 0, 0); } while (0)
    s16x4 l0a, l1a, l2a, l3a, h0a, h1a, h2a, h3a, l0b, l1b, l2b, l3b, h0b, h1b, h2b, h3b;
    PV_RD(a, 0); PV_RD(b, 1);
    asm volatile("s_waitcnt lgkmcnt(8)" ::: "memory"); SBAR(); PV_MM(a, 0); SBAR();
    PV_RD(a, 2);
    asm volatile("s_waitcnt lgkmcnt(8)" ::: "memory"); SBAR(); PV_MM(b, 1); SBAR();
    PV_RD(b, 3);
    asm volatile("s_waitcnt lgkmcnt(8)" ::: "memory"); SBAR(); PV_MM(a, 2); SBAR();
    asm volatile("s_waitcnt lgkmcnt(0)" ::: "memory"); SBAR(); PV_MM(b, 3);
#undef PV_RD
#undef PV_MM
#undef TRRD
}
__device__ __forceinline__ void attn_unit(const bf16* Qw, const bf16* cK, const bf16* cV, const bf16* wK, const bf16* wV, int nctx, int NT, int tm1, int tm2, const float* sinkp, bf16* Ob, int orow0, int ocol0, char* lds) {
    const int tid = fresh_tid(), wid = __builtin_amdgcn_readfirstlane(tid >> 6), lane = tid & 63, r32 = lane & 31, hi = lane >> 5;
    char* V_lds = lds; char* K_lds = lds + 2 * SHM_V;
    float* wsf = (float*)(lds + 2 * SHM_V + 2 * SHM_K) + wid * 64; float* li_l = wsf, * al_l = wsf + 32;
    float m_reg = -1e30f, l_reg = 0; f32x16 o[4] = {};
    const int sr = tid >> 4, sc = (tid & 15) * 8, vst0 = v_st(sr, sc), vst1 = v_st(32 + sr, sc), kws = KSWZ(sr, sc * 2);
    const int vb0 = (int)(uintptr_t)V_lds + v_rd_base(lane);
    const int qrow = 32 * (wid & 1) + r32, hq = wid >> 1, dmask = qrow - 4 * hi;
    bf16x8 qr[8];
#pragma unroll
    for (int d0 = 0; d0 < 8; ++d0) qr[d0] = *(const bf16x8*)(Qw + (size_t)qrow * D + hq * 128 + d0 * 16 + hi * 8);
    bf16x8 st_v0a, st_v1a, st_k0a, st_k1a, st_v0b, st_v1b, st_k0b, st_k1b;
#define TILEP(t, kp, vp) const bf16* kp = (t) < nctx ? cK + (size_t)(t) * 64 * KVD : wK + (size_t)((t) - nctx) * 64 * KVD; const bf16* vp = (t) < nctx ? cV + (size_t)(t) * 64 * KVD : wV + (size_t)((t) - nctx) * 64 * KVD
#define SLOAD(t, S) do { TILEP(t, kp_, vp_); st_v0##S = *(const bf16x8*)(vp_ + (size_t)sr * KVD + sc); st_v1##S = *(const bf16x8*)(vp_ + (size_t)(32 + sr) * KVD + sc); \
                      st_k0##S = *(const bf16x8*)(kp_ + (size_t)sr * KVD + sc); st_k1##S = *(const bf16x8*)(kp_ + (size_t)(32 + sr) * KVD + sc); } while (0)
#define SWRITE(bf, S) do { *(bf16x8*)(V_lds + (bf) * SHM_V + vst0) = st_v0##S; *(bf16x8*)(V_lds + (bf) * SHM_V + vst1) = st_v1##S; \
                        *(bf16x8*)(K_lds + (bf) * SHM_K + kws) = st_k0##S; *(bf16x8*)(K_lds + (bf) * SHM_K + kws + 32 * 256) = st_k1##S; } while (0)
#define VMW() asm volatile("s_waitcnt vmcnt(0)" ::: "memory")
#define RESC(a) do { if (__any((a) < 1.f)) { if (hi == 0) al_l[r32] = (a); asm volatile("s_waitcnt lgkmcnt(0)" ::: "memory");              \
                     for (int d_ = 0; d_ < 4; ++d_) for (int r = 0; r < 16; ++r) o[d_][r] *= al_l[crow(r, hi)]; } } while (0)
    f32x16 p0, p1; float mn, al; bf16x8 pa0, pa1, pa2, pa3;
#define STEP(t, B, SN, SW) do { if ((t) + 2 < NT) SLOAD((t) + 2, SN); SBAR();     \
        qkt<B>(p0, p1, K_lds, r32, hi, qr);                                                                           \
        if ((t) == tm1) mask_tile(p0, p1, dmask, 1); else if ((t) == tm2) mask_tile(p0, p1, dmask, 2);                \
        partialSM(p0, p1, m_reg, mn, al); RESC(al); finishSM(p0, p1, al, l_reg, pa0, pa1, pa2, pa3); SBAR();          \
        pv_tile<B>(o, vb0, pa0, pa1, pa2, pa3);                                                                       \
        if ((t) + 1 < NT) { SWRITE((B) ^ 1, SW); }          \
        __syncthreads(); } while (0)
    SLOAD(0, a); if (NT > 1) SLOAD(1, b); SWRITE(0, a); __syncthreads();
    for (int t = 0; t < NT; t += 2) { STEP(t, 0, a, b); if (t + 1 < NT) STEP(t + 1, 1, b, a); }
    { constexpr float C2 = 1.4426950408889634f * SCALE; const float sk = sinkp[hq];
      l_reg += __builtin_amdgcn_exp2f(sk * 1.4426950408889634f - m_reg * C2); }
    if (hi == 0) li_l[r32] = l_reg; asm volatile("s_waitcnt lgkmcnt(0)" ::: "memory");
    float rli[16];
#pragma unroll
    for (int r = 0; r < 16; ++r) rli[r] = __builtin_amdgcn_rcpf(li_l[crow(r, hi)]);
    typedef unsigned ou4 __attribute__((ext_vector_type(4)));
    char* Ost = lds + wid * 8192;
#pragma unroll
    for (int r = 0; r < 16; ++r) { const int orow = crow(r, hi);
#pragma unroll
        for (int d0 = 0; d0 < 4; ++d0) { const float v = o[d0][r] * rli[r]; const float vn = __shfl_xor(v, 1);
            if ((r32 & 1) == 0) *(unsigned*)(Ost + orow * 256 + (d0 * 32 + r32) * 2) = cvtpk(v, vn); } }
    asm volatile("s_waitcnt lgkmcnt(0)" ::: "memory");
    ou4 ov[8];
#pragma unroll
    for (int j = 0; j < 8; ++j) { const int c = j * 64 + lane; ov[j] = *(const ou4*)(Ost + (c >> 4) * 256 + (c & 15) * 16); }
#pragma unroll
    for (int j = 0; j < 8; ++j) { const int c = j * 64 + lane; *(ou4*)(Ob + ::blk_off(orow0 + 32 * (wid & 1) + (c >> 4), ocol0 + hq * 128 + (c & 15) * 8, 4096 / 32)) = ov[j]; }
    __syncthreads();
#undef TILEP
#undef SLOAD
#undef SWRITE
#undef VMW
#undef RESC
#undef STEP
}
#undef KSWZ
#undef SBAR
}

#define GAS __attribute__((address_space(1)))
#define LAS __attribute__((address_space(3)))
typedef unsigned short bf16;
typedef unsigned v4u __attribute__((ext_vector_type(4)));
typedef float f32x4 __attribute__((ext_vector_type(4)));
typedef short bf16x8 __attribute__((ext_vector_type(8)));
typedef GAS unsigned gu32;
#define RLX_AGENT __ATOMIC_RELAXED, __HIP_MEMORY_SCOPE_AGENT
#define LDS_WAIT() asm volatile("s_waitcnt lgkmcnt(0)" ::: "memory")
#define VM_WAIT() asm volatile("s_waitcnt vmcnt(0)" ::: "memory")
__device__ __forceinline__ unsigned f2bf(float f) { unsigned u = __builtin_bit_cast(unsigned, f); return (u + 0x7fffu + ((u >> 16) & 1u)) >> 16; }
__device__ __forceinline__ unsigned pk2(float lo, float hi) { return f2bf(lo) | (f2bf(hi) << 16); }
__device__ __forceinline__ float bflo(unsigned w) { return __builtin_bit_cast(float, w << 16); }
__device__ __forceinline__ float bfhi(unsigned w) { return __builtin_bit_cast(float, w & 0xffff0000u); }
__device__ __forceinline__ float wave_sum(float v) {
#pragma unroll
    for (int o = 1; o < 64; o <<= 1) v += __shfl_xor(v, o);
    return v;
}
__device__ __forceinline__ float silu_acc(float x) { return x / (1.f + __expf(-x)); }
#define XB_TMO      128
#define XB_XCNT(j)  (256  + 64 * (j))
#define XB_XSUB(j)  (1280 + 64 * (j))
#define XB_XGEN(j)  (2304 + 64 * (j))
#define XB_TOP      3328
#define XB_TOPGEN   3392
#define XCD_BAR_WORDS 3456
#define XB_SPIN_CAP (1u << 18)

__device__ __forceinline__ unsigned xb_ld(unsigned* p)              { return __hip_atomic_load(p, __ATOMIC_RELAXED, __HIP_MEMORY_SCOPE_AGENT); }
__device__ __forceinline__ unsigned xb_add(unsigned* p, unsigned v) { return __hip_atomic_fetch_add(p, v, __ATOMIC_RELAXED, __HIP_MEMORY_SCOPE_AGENT); }
__device__ __forceinline__ unsigned xb_xcc_id() { return (unsigned)__builtin_amdgcn_s_getreg((3 << 11) | 20) & 0xFu; }
#define XB_SPIN(cond, bar) do { unsigned _sp = 0; while (cond) { __builtin_amdgcn_s_sleep(1); \
    if ((++_sp & 255u) == 0u) { if (xb_ld(&(bar)[XB_TMO])) break; if (_sp > XB_SPIN_CAP) { atomicAdd(&(bar)[XB_TMO], 1u); break; } } } } while (0)

struct XcdBarrier {
    unsigned* bar; unsigned x;
    volatile LAS unsigned* st;
};

__device__ __forceinline__ XcdBarrier xcd_barrier_post(unsigned* bar, volatile LAS unsigned* st) {
    XcdBarrier b; b.bar = bar; b.x = xb_xcc_id(); b.st = st;
    if (threadIdx.x == 0) (void)xb_add(&bar[XB_XCNT(b.x)], 1u);
    return b;
}
__device__ __forceinline__ void xcd_barrier_complete(unsigned* bar, unsigned x, unsigned& nloc, unsigned& nx) {
    const unsigned G = gridDim.x * gridDim.y * gridDim.z;
    unsigned sum, cnt, mine, sp = 0u;
    for (;;) {
        sum = 0u; cnt = 0u; mine = 0u;
#pragma unroll
        for (unsigned j = 0; j < 16; ++j) { const unsigned c = xb_ld(&bar[XB_XCNT(j)]); sum += c; cnt += (c > 0u) ? 1u : 0u; mine = (j == x) ? c : mine; }
        if (sum == G) break;
        __builtin_amdgcn_s_sleep(1);
        if ((++sp & 255u) == 0u) { if (xb_ld(&bar[XB_TMO])) break; if (sp > XB_SPIN_CAP) { atomicAdd(&bar[XB_TMO], 1u); break; } }
    }
    nloc = mine > 0u ? mine : 1u; nx = cnt > 0u ? cnt : 1u;
}

__device__ __forceinline__ void xcd_barrier(const XcdBarrier& b) {
    asm volatile("s_waitcnt vmcnt(0)" ::: "memory");
    __syncthreads();
    if (threadIdx.x == 0) {
        unsigned* bar = b.bar;
        __builtin_amdgcn_s_waitcnt(0);
        unsigned nloc = b.st[0], nx = b.st[1];
        if (nloc == 0u) { xcd_barrier_complete(bar, b.x, nloc, nx); b.st[0] = nloc; b.st[1] = nx; }
        const unsigned old = xb_add(&bar[XB_XSUB(b.x)], 1u);
        const unsigned gen = old / nloc;
        if (old + 1u == (gen + 1u) * nloc) {
            __builtin_amdgcn_fence(__ATOMIC_RELEASE, "agent");
            asm volatile("s_waitcnt vmcnt(0)" ::: "memory");
            const unsigned og = xb_add(&bar[XB_TOP], 1u);
            const unsigned tg = og / nx;
            if (og + 1u == (tg + 1u) * nx) xb_add(&bar[XB_TOPGEN], 1u);
            else XB_SPIN(xb_ld(&bar[XB_TOPGEN]) == tg, bar);
            __builtin_amdgcn_fence(__ATOMIC_ACQUIRE, "agent");
            xb_add(&bar[XB_XGEN(b.x)], 1u);
            asm volatile("s_waitcnt vmcnt(0)" ::: "memory");
        } else {
            XB_SPIN(xb_ld(&bar[XB_XGEN(b.x)]) == gen, bar);
            __builtin_amdgcn_fence(__ATOMIC_ACQUIRE, "agent");
            asm volatile("s_waitcnt vmcnt(0)" ::: "memory");
        }
    }
    __syncthreads();
}


constexpr int NWAVES = 8, NTHR = NWAVES * 64;
constexpr int RING_OFF = 0, RING_BYTES = 131072;
constexpr int LDSCTL_OFF = RING_BYTES, MISC_OFF = LDSCTL_OFF + 320;
static_assert(pg8::EPI_T_OFF_ == 133120, "slab offset");
constexpr int EPI_T_OFF = 133120, EPI_T_BYTES = 8 * 2304;
constexpr int LDS_BYTES = 155648;
static_assert(att::LDS_BYTES <= RING_BYTES && MISC_OFF + 128 <= EPI_T_OFF && RING_BYTES + 1024 + 64 <= EPI_T_OFF && EPI_T_OFF + EPI_T_BYTES <= LDS_BYTES && LDS_BYTES <= 163840, "LDS map");
constexpr int N_PHASES = 27;

__device__ __forceinline__ int dest_row(int kind, int n0) {
    if (kind == 1) { const int uv = n0 / DFF, j = n0 % DFF; return 256 * (j >> 7) + 128 * uv + (j & 127); }
    if (kind == 2) {
        if (n0 < 2560) { const int isk = n0 >= 2048, nn = isk ? n0 - 2048 : n0, head = nn >> 7, d = nn & 127, part = d >> 6, x = (d >> 5) & 1;
                         return 256 * ((isk ? 8 : 0) + (head >> 1)) + 128 * x + 64 * (head & 1) + 32 * part; }
        if (n0 < 3072) return n0;
        if (n0 < 5120) { const int nn = n0 - 3072, ag = nn >> 10, j = nn & 1023; return 256 * (12 + (j >> 7)) + 128 * ag + (j & 127); }
        if (n0 < 6144) return n0;
        if (n0 < 8192) { const int nn = n0 - 6144, xv = nn >> 10, j = nn & 1023; return 256 * (24 + (j >> 7)) + 128 * xv + (j & 127); }
        return n0;
    }
    return n0;
}
__device__ __forceinline__ void p0_transpose_item(const float* W, int K, int N, bf16* WT, int kind, LAS float* scr, int item, int lane, int ldk = 0, int koff = 0) {
    if (ldk == 0) ldk = K;
    const int nblk = N / 32, kb = item / nblk, nb = item % nblk, k0 = 64 * kb, n0 = 32 * nb, drow = dest_row(kind, n0);
    { float wv_[32];
#pragma unroll
      for (int i = 0; i < 32; ++i) wv_[i] = __builtin_nontemporal_load(W + (size_t)(k0 + 2 * i + (lane >> 5)) * N + n0 + (lane & 31));
#pragma unroll
      for (int i = 0; i < 32; ++i) scr[(2 * i + (lane >> 5)) * 33 + (lane & 31)] = wv_[i]; }
    LDS_WAIT(); asm volatile("" ::: "memory");
    const int c = lane & 7;
#pragma unroll
    for (int j = 0; j < 4; ++j) { const int n = (lane >> 3) + 8 * j; const LAS float* s = scr + (8 * c) * 33 + n;
        v4u o; o.x = pk2(s[0 * 33], s[1 * 33]); o.y = pk2(s[2 * 33], s[3 * 33]); o.z = pk2(s[4 * 33], s[5 * 33]); o.w = pk2(s[6 * 33], s[7 * 33]);
        const int r_ = drow + n, c_ = koff + k0 + 8 * c, nkb_ = (ldk - PADE) / 32;
        __builtin_nontemporal_store(o, (GAS v4u*)(WT + ((size_t)((r_ >> 4) * nkb_ + (c_ >> 5)) << 9) + ((r_ & 15) << 5) + (c_ & 31))); }
    LDS_WAIT(); asm volatile("" ::: "memory");
}
constexpr int I_FI = (D / 64) * (2 * DFF / 32), I_FO = (DFF / 64) * (D / 32), I_IN = (D / 64) * (INC / 32), I_DD = (D / 64) * (D / 32), I_HD = (DCA / 64) * (D / 32);
constexpr int I_LAYER = 2 * I_FI + 2 * I_FO + I_IN + 2 * I_DD + 2 * I_HD;

constexpr int R_1I = 0, R_1O = I_FI, R_IN = R_1O + I_FO, R_AO = R_IN + I_IN, R_OUT = R_AO + I_DD + 2 * I_HD, R_2I = R_OUT + I_DD, R_2O = R_2I + I_FI, R_END = R_2O + I_FO;
static_assert(R_END == I_LAYER, "item map");
__device__ __forceinline__ void convert_range(const Args& a, unsigned char* lds, int l, int r_lo, int r_hi, int wi, int nw) {
    const int tid = fresh_tid(), lane = tid & 63, wave = __builtin_amdgcn_readfirstlane(tid >> 6);
    LAS float* scr = (LAS float*)((LAS unsigned char*)lds + wave * 16384);
    unsigned char* wl = a.ws + WS_WT + (size_t)l * WT_LAYER;
    for (int it = r_lo + wi; it < r_hi; it += nw) {
        int r = it;
        if (r < I_FI) { p0_transpose_item(a.in[9] + (size_t)l * D * 2 * DFF, D, 2 * DFF, (bf16*)(wl + WT_1I), 1, scr, r, lane, WK_D, 0); continue; } r -= I_FI;
        if (r < I_FO) { p0_transpose_item(a.in[10] + (size_t)l * DFF * D, DFF, D, (bf16*)(wl + WT_1O), 0, scr, r, lane, WK_FF, 0); continue; } r -= I_FO;
        if (r < I_IN) { p0_transpose_item(a.in[12] + (size_t)l * D * INC, D, INC, (bf16*)(wl + WT_IN), 2, scr, r, lane, WK_D, 0); continue; } r -= I_IN;
        if (r < I_DD) { p0_transpose_item(a.in[14] + (size_t)l * D * D, D, D, (bf16*)(wl + WT_MIXB), 0, scr, r, lane, WK_MIX, 2048); continue; } r -= I_DD;
        if (r < I_HD) { p0_transpose_item(a.in[18] + (size_t)l * DCA * D, DCA, D, (bf16*)(wl + WT_MIXB), 0, scr, r, lane, WK_MIX, 0); continue; } r -= I_HD;
        if (r < I_HD) { p0_transpose_item(a.in[20] + (size_t)l * DCA * D, DCA, D, (bf16*)(wl + WT_MIXB), 0, scr, r, lane, WK_MIX, 1024); continue; } r -= I_HD;
        if (r < I_DD) { p0_transpose_item(a.in[21] + (size_t)l * D * D, D, D, (bf16*)(wl + WT_OUT), 0, scr, r, lane, WK_D, 0); continue; } r -= I_DD;
        if (r < I_FI) { p0_transpose_item(a.in[23] + (size_t)l * D * 2 * DFF, D, 2 * DFF, (bf16*)(wl + WT_2I), 1, scr, r, lane, WK_D, 0); continue; } r -= I_FI;
        p0_transpose_item(a.in[24] + (size_t)l * DFF * D, DFF, D, (bf16*)(wl + WT_2O), 0, scr, r, lane, WK_FF, 0);
    }
}
__device__ __forceinline__ void ada_layer(const Args& a, unsigned char* lds, int l, int bi, int nb, int item_lo = 0, int item_hi = NMOD / 64) {
    const int tid = fresh_tid(), lane = tid & 63, wave = __builtin_amdgcn_readfirstlane(tid >> 6);
    const float* c = a.in[4]; const float* c_ctx = a.in[5]; const float* w_ada = a.in[6]; const float* b_ada = a.in[7];
    float* sv = (float*)lds;
    float* part = (float*)(lds + 24576);
    __syncthreads();
    for (int i = tid; i < D; i += NTHR) { sv[i] = silu_acc(c_ctx[i]); sv[D + i] = silu_acc(c[i]); sv[2 * D + i] = silu_acc(c[D + i]); }
    __syncthreads();
    float* MOD = (float*)(a.ws + WS_MOD);
    for (int item = item_lo + bi; item < item_hi; item += nb) {
        const int j0 = item * 64;
        const float* w = w_ada + ((size_t)l * D + wave * 256) * NMOD + j0 + lane;
        const float* s0 = sv + wave * 256;
        float a0 = 0.f, a1 = 0.f, a2 = 0.f;
#pragma unroll 16
        for (int k = 0; k < 256; ++k) { const float x = w[(size_t)k * NMOD]; a0 += s0[k] * x; a1 += s0[D + k] * x; a2 += s0[2 * D + k] * x; }
        part[(wave * 3 + 0) * 64 + lane] = a0; part[(wave * 3 + 1) * 64 + lane] = a1; part[(wave * 3 + 2) * 64 + lane] = a2;
        __syncthreads();
        if (tid < 192) { const int cc = tid >> 6, j = tid & 63; float s = b_ada[l * NMOD + j0 + j];
#pragma unroll
            for (int wv = 0; wv < 8; ++wv) s += part[(wv * 3 + cc) * 64 + j];
            MOD[(size_t)(l * 3 + cc) * NMOD + j0 + j] = s; }
        __syncthreads();
    }
}
#ifndef CVT_CHUNK
#define CVT_CHUNK 2
#endif
constexpr int CW_CVT = 16384;
__device__ __forceinline__ void convert_item(const Args& a, LAS float* scr, int gi, int lane) {
    const int l = gi < I_LAYER ? 1 : 0; int r = gi < I_LAYER ? gi : gi - I_LAYER;
    unsigned char* wl = a.ws + WS_WT + (size_t)l * WT_LAYER;
    if (r < I_FI) { p0_transpose_item(a.in[9] + (size_t)l * D * 2 * DFF, D, 2 * DFF, (bf16*)(wl + WT_1I), 1, scr, r, lane, WK_D, 0); return; } r -= I_FI;
    if (r < I_FO) { p0_transpose_item(a.in[10] + (size_t)l * DFF * D, DFF, D, (bf16*)(wl + WT_1O), 0, scr, r, lane, WK_FF, 0); return; } r -= I_FO;
    if (r < I_IN) { p0_transpose_item(a.in[12] + (size_t)l * D * INC, D, INC, (bf16*)(wl + WT_IN), 2, scr, r, lane, WK_D, 0); return; } r -= I_IN;
    if (r < I_DD) { p0_transpose_item(a.in[14] + (size_t)l * D * D, D, D, (bf16*)(wl + WT_MIXB), 0, scr, r, lane, WK_MIX, 2048); return; } r -= I_DD;
    if (r < I_HD) { p0_transpose_item(a.in[18] + (size_t)l * DCA * D, DCA, D, (bf16*)(wl + WT_MIXB), 0, scr, r, lane, WK_MIX, 0); return; } r -= I_HD;
    if (r < I_HD) { p0_transpose_item(a.in[20] + (size_t)l * DCA * D, DCA, D, (bf16*)(wl + WT_MIXB), 0, scr, r, lane, WK_MIX, 1024); return; } r -= I_HD;
    if (r < I_DD) { p0_transpose_item(a.in[21] + (size_t)l * D * D, D, D, (bf16*)(wl + WT_OUT), 0, scr, r, lane, WK_D, 0); return; } r -= I_DD;
    if (r < I_FI) { p0_transpose_item(a.in[23] + (size_t)l * D * 2 * DFF, D, 2 * DFF, (bf16*)(wl + WT_2I), 1, scr, r, lane, WK_D, 0); return; } r -= I_FI;
    p0_transpose_item(a.in[24] + (size_t)l * DFF * D, DFF, D, (bf16*)(wl + WT_2O), 0, scr, r, lane, WK_FF, 0);
}
__device__ __forceinline__ void convert_all(const Args& a, unsigned char* lds, int vcu, int G) {
    const int tid = fresh_tid(), lane = tid & 63, wave = __builtin_amdgcn_readfirstlane(tid >> 6);
    LAS float* scr = (LAS float*)((LAS unsigned char*)lds + wave * 16384);
    constexpr int TOT = 2 * I_LAYER, PER = TOT / 8, CH = CVT_CHUNK, NCH = PER / CH;
    static_assert(TOT % 8 == 0 && PER % CH == 0, "conversion chunks");
    if (G != 256) { for (int gi = vcu * NWAVES + wave; gi < TOT; gi += G * NWAVES) convert_item(a, scr, gi, lane); return; }
    const int x = vcu >> 5, r = vcu & 31;
    unsigned* cnt = (unsigned*)(a.ws + WS_CTL) + CW_CVT + 64 * x;
    int ch = r * NWAVES + wave;
    while (ch < NCH) {
        unsigned nx = 0u; if (lane == 0) nx = __hip_atomic_fetch_add(cnt, 1u, __ATOMIC_RELAXED, __HIP_MEMORY_SCOPE_AGENT);
#pragma unroll 1
        for (int j = 0; j < CH; ++j) convert_item(a, scr, x * PER + ch * CH + j, lane);
        ch = 256 + __builtin_amdgcn_readfirstlane((int)nx);
    }
}
__device__ __forceinline__ void ada_all(const Args& a, unsigned char* lds, int bi, int nb) {
    const int tid = fresh_tid(), lane = tid & 63, wave = __builtin_amdgcn_readfirstlane(tid >> 6);
    const float* c = a.in[4]; const float* c_ctx = a.in[5]; const float* w_ada = a.in[6]; const float* b_ada = a.in[7];
    float* sv = (float*)lds;
    float* part = (float*)(lds + 24576);
    __syncthreads();
    for (int i = tid; i < D; i += NTHR) { sv[i] = silu_acc(c_ctx[i]); sv[D + i] = silu_acc(c[i]); sv[2 * D + i] = silu_acc(c[D + i]); }
    __syncthreads();
    float* MOD = (float*)(a.ws + WS_MOD);
    constexpr int NI = NMOD / 64;
    for (int it = bi; it < 2 * NI; it += nb) {
        const int l = it / NI, j0 = (it - l * NI) * 64;
        const float* w = w_ada + ((size_t)l * D + wave * 256) * NMOD + j0 + lane;
        const float* s0 = sv + wave * 256;
        float a0 = 0.f, a1 = 0.f, a2 = 0.f;
#pragma unroll 1
        for (int kk = 0; kk < 256; kk += 32) { float xw[32];
#pragma unroll
            for (int i = 0; i < 32; ++i) xw[i] = __builtin_nontemporal_load(w + (size_t)(kk + i) * NMOD);
#pragma unroll
            for (int i = 0; i < 32; ++i) { a0 += s0[kk + i] * xw[i]; a1 += s0[D + kk + i] * xw[i]; a2 += s0[2 * D + kk + i] * xw[i]; } }
        part[(wave * 3 + 0) * 64 + lane] = a0; part[(wave * 3 + 1) * 64 + lane] = a1; part[(wave * 3 + 2) * 64 + lane] = a2;
        __syncthreads();
        if (tid < 192) { const int cc = tid >> 6, j = tid & 63; float s = b_ada[l * NMOD + j0 + j];
#pragma unroll
            for (int wv = 0; wv < 8; ++wv) s += part[(wv * 3 + cc) * 64 + j];
            MOD[(size_t)(l * 3 + cc) * NMOD + j0 + j] = s; }
        __syncthreads();
    }
}
#ifndef FILL_MASK
#define FILL_MASK 0
#endif
__device__ __forceinline__ void filler(const Args& a, unsigned char* lds, int job, int idle, int nidle) {
    const int wave = __builtin_amdgcn_readfirstlane(fresh_tid() >> 6), wi = idle * NWAVES + wave, nw = nidle * NWAVES;
    if (job == 1) convert_range(a, lds, 0, R_IN, R_AO, wi, nw);
    else if (job == 2) convert_range(a, lds, 0, R_AO, R_END, wi, nw);
    else if (job == 3) ada_layer(a, lds, 1, idle, nidle, 0, NMOD / 128);
    else if (job == 7) ada_layer(a, lds, 1, idle, nidle, NMOD / 128, NMOD / 64);
    else if (job == 4) convert_range(a, lds, 1, R_1I, R_IN, wi, nw);
    else if (job == 5) convert_range(a, lds, 1, R_IN, R_AO, wi, nw);
    else if (job == 6) convert_range(a, lds, 1, R_AO, R_END, wi, nw);
}
__device__ __forceinline__ void prologue(const Args& a, unsigned char* lds, int vcu, int G) {
    const int tid = fresh_tid(), wave = __builtin_amdgcn_readfirstlane(tid >> 6);
    unsigned char* ws = a.ws;
#ifdef PROLOGUE_STATIC
    ada_layer(a, lds, 0, vcu, G); ada_layer(a, lds, 1, vcu, G);
    convert_range(a, lds, 1, 0, R_END, vcu * NWAVES + wave, G * NWAVES); convert_range(a, lds, 0, 0, R_END, vcu * NWAVES + wave, G * NWAVES);
#else
    ada_all(a, lds, vcu, G);
    convert_all(a, lds, vcu, G);
#endif
    {
        const int gt = vcu * NTHR + tid, NT = G * NTHR;
        const int n8 = 2 * 2 * PAST * KVD / 8;
        for (int i = gt; i < 2 * n8; i += NT) { const bool isk = i < n8; const int j = isk ? i : i - n8;
            const f32x4* s = (const f32x4*)((isk ? a.in[2] : a.in[3]) + (size_t)j * 8); const f32x4 x = s[0], y = s[1];
            v4u o; o.x = pk2(x[0], x[1]); o.y = pk2(x[2], x[3]); o.z = pk2(y[0], y[1]); o.w = pk2(y[2], y[3]);
            *(v4u*)(ws + (isk ? WS_CK : WS_CV) + (size_t)j * 16) = o; }
        if (gt < 64 * 32) { const int pos = gt >> 5, i = gt & 31; const float inv = powf(10000.f, -(float)i / 32.f), ang = (float)pos * inv;
            float* rp = (float*)(ws + WS_ROPE) + (size_t)gt * 2; rp[0] = cosf(ang); rp[1] = sinf(ang); }
    }
}
template <bool FINAL>
__device__ __forceinline__ void norm_phase(const float* X, const float* g, const float* MODl, int sub, bf16* H, float* out, int vcu, int G, int row_lo, int row_hi, bool xt) {
    const int tid = fresh_tid(), lane = tid & 63, gw = vcu * NWAVES + __builtin_amdgcn_readfirstlane(tid >> 6), NGW = G * NWAVES;
    int m = row_lo + gw;
    if (m >= row_hi) return;
    f32x4 gv[8], scv[8], shv[8]; int cur = -1;
    const f32x4* gr = (const f32x4*)g + lane;
#pragma unroll
    for (int j = 0; j < 8; ++j) gv[j] = gr[64 * j];
    f32x4 v[8];
    {
#pragma unroll
      for (int j = 0; j < 8; ++j) v[j] = *(const f32x4*)(X + (xt ? xt_off(m, 256 * j) : (size_t)m * D + 256 * j) + 4 * lane); }
    for (; m < row_hi; m += NGW) {
        f32x4 vn[8];
        const int mn = m + NGW;
        if (mn < row_hi) {
#pragma unroll
            for (int j = 0; j < 8; ++j) vn[j] = *(const f32x4*)(X + (xt ? xt_off(mn, 256 * j) : (size_t)mn * D + 256 * j) + 4 * lane); }
        else {
#pragma unroll
            for (int j = 0; j < 8; ++j) vn[j] = v[j]; }
        if (!FINAL) { const int cond = m < MC ? 0 : (m < MC + SEQL ? 1 : 2);
            if (cond != cur) { cur = cond; const float* mod = MODl + (size_t)cond * NMOD + (size_t)sub * 3 * D;
                const f32x4* sh = (const f32x4*)mod + lane; const f32x4* sc = (const f32x4*)(mod + D) + lane;
#pragma unroll
                for (int j = 0; j < 8; ++j) { scv[j] = sc[64 * j] + 1.f; shv[j] = sh[64 * j]; } } }
        __builtin_amdgcn_sched_barrier(0);
        float ss = 0.f;
#pragma unroll
        for (int j = 0; j < 8; ++j) ss += (v[j][0] * v[j][0] + v[j][1] * v[j][1]) + (v[j][2] * v[j][2] + v[j][3] * v[j][3]);
        const float r = rsqrtf(wave_sum(ss) * (1.f / D) + EPS);
        if (FINAL) { f32x4* o = (f32x4*)(out + (size_t)m * D) + lane;
#pragma unroll
            for (int j = 0; j < 8; ++j) o[64 * j] = v[j] * r * gv[j];
        } else {
#pragma unroll
            for (int j = 0; j < 8; ++j) { const f32x4 h = v[j] * r * gv[j] * scv[j] + shv[j];
                *(unsigned long long*)(H + blk_off(m, 256 * j + 4 * lane, D / 32)) = (unsigned long long)pk2(h[0], h[1]) | ((unsigned long long)pk2(h[2], h[3]) << 32); }
        }
#pragma unroll
        for (int j = 0; j < 8; ++j) v[j] = vn[j];
    }
}
__device__ __forceinline__ void conv_a_phase(const bf16* GLU, const float* w, const float* bias, const float* g, bf16* CA, unsigned char* lds, int u_first, int u_count, int u_stride) {
    typedef float f32x2 __attribute__((ext_vector_type(2)));
    const int tid = fresh_tid(), wid = tid >> 6, lane = tid & 63;
    float* part = (float*)lds;
    float* rs = (float*)(lds + 32768);
    f32x2 wv[31];
#pragma unroll
    for (int t = 0; t < 31; ++t) wv[t] = *(const f32x2*)(w + t * DCA + 2 * tid);
    const f32x2 bb = *(const f32x2*)(bias + 2 * tid), gg = *(const f32x2*)(g + 2 * tid);
    for (int ui_ = 0; ui_ < u_count; ++ui_) { const int u = u_first + ui_ * u_stride;
        const int row0 = u * 16, s0 = row0 < MC ? (row0 & ~(SEQC - 1)) : MC + ((row0 - MC) & ~(SEQL - 1)), L = row0 < MC ? SEQC : SEQL, p0 = row0 - s0;
        f32x2 xv[46];
#pragma unroll
        for (int q = 0; q < 46; ++q) { const int p = p0 - 15 + q; unsigned xw = 0u; if (p >= 0 && p < L) xw = *(const unsigned*)(GLU + (size_t)(s0 + p) * DCA + 2 * tid); xv[q] = (f32x2){bflo(xw), bfhi(xw)}; }
        f32x2 acc[16];
#pragma unroll
        for (int r = 0; r < 16; ++r) { f32x2 s_ = bb;
#pragma unroll
            for (int t = 0; t < 31; ++t) s_ = s_ + xv[r + t] * wv[t];
            acc[r] = s_; part[r * 512 + tid] = s_.x * s_.x + s_.y * s_.y; }
        __syncthreads();
#pragma unroll
        for (int h = 0; h < 2; ++h) { const int r = wid + 8 * h; float v = 0.f;
#pragma unroll
            for (int k = 0; k < 8; ++k) v += part[r * 512 + lane + 64 * k];
            v = wave_sum(v); if (lane == 0) rs[r] = rsqrtf(v * (1.f / DCA) + EPS); }
        __syncthreads();
#pragma unroll
        for (int r = 0; r < 16; ++r) { const float rr = rs[r]; const f32x2 y = acc[r] * rr * gg;
            *(unsigned*)(CA + blk_off(row0 + r, 2 * tid, ABR_K / 32)) = pk2(silu_acc(y.x), silu_acc(y.y)); }
    }
    __syncthreads();
}
__device__ __forceinline__ void conv_b_phase(const bf16* BG, const bf16* CX, const float* w, bf16* CB, int vcu, int G, int row_lo, int row_hi) {
    const int gt = vcu * NTHR + fresh_tid(), NT = G * NTHR;
    const int c8 = (gt & 127) * 8;
    f32x4 wa[3], wb[3];
#pragma unroll
    for (int t = 0; t < 3; ++t) { wa[t] = *(const f32x4*)(w + t * DCA + c8); wb[t] = *(const f32x4*)(w + t * DCA + c8 + 4); }
    const int end = row_hi * (DCA / 8);
    constexpr int QB = 4;
    for (int idx0 = row_lo * (DCA / 8) + gt; idx0 < end; idx0 += QB * NT) {
        v4u xw[QB][3], bw[QB];
#pragma unroll
        for (int q = 0; q < QB; ++q) { const int idx = idx0 + q * NT; const int m = idx >> 7;
            const int s0 = m < MC ? (m & ~(SEQC - 1)) : MC + ((m - MC) & ~(SEQL - 1)), L = m < MC ? SEQC : SEQL, pos = m - s0;
#pragma unroll
            for (int t = 0; t < 3; ++t) { const int p = pos + t - 1; xw[q][t] = (v4u){0u, 0u, 0u, 0u};
                if (idx < end && p >= 0 && p < L) xw[q][t] = *(const v4u*)(CX + (size_t)(s0 + p) * DCA + c8); }
            bw[q] = (v4u){0u, 0u, 0u, 0u}; if (idx < end) bw[q] = *(const v4u*)(BG + (size_t)m * DCA + c8); }
        __builtin_amdgcn_sched_barrier(0);
#pragma unroll
        for (int q = 0; q < QB; ++q) { const int idx = idx0 + q * NT; const int m = idx >> 7;
            f32x4 aa = {0.f, 0.f, 0.f, 0.f}, ab = {0.f, 0.f, 0.f, 0.f};
#pragma unroll
            for (int t = 0; t < 3; ++t) { const v4u x = xw[q][t];
                aa[0] += bflo(x.x) * wa[t][0]; aa[1] += bfhi(x.x) * wa[t][1]; aa[2] += bflo(x.y) * wa[t][2]; aa[3] += bfhi(x.y) * wa[t][3];
                ab[0] += bflo(x.z) * wb[t][0]; ab[1] += bfhi(x.z) * wb[t][1]; ab[2] += bflo(x.w) * wb[t][2]; ab[3] += bfhi(x.w) * wb[t][3]; }
            const v4u b = bw[q];
            v4u o; o.x = pk2(bflo(b.x) * aa[0], bfhi(b.x) * aa[1]); o.y = pk2(bflo(b.y) * aa[2], bfhi(b.y) * aa[3]); o.z = pk2(bflo(b.z) * ab[0], bfhi(b.z) * ab[1]); o.w = pk2(bflo(b.w) * ab[2], bfhi(b.w) * ab[3]);
            if (idx < end) *(v4u*)((CB - ABR_CB) + blk_off(m, ABR_CB + c8, ABR_K / 32)) = o; }
    }
}
#ifndef ATT_LO
#define ATT_LO 1
#endif
#ifndef CONV_LO
#define CONV_LO 2
#endif
__device__ __forceinline__ void attn_lat_phase(const bf16* Qb, const bf16* Kb, const bf16* Vb, const bf16* CK, const bf16* CV, const float* sink, bf16* ATT, int layer, int bx, int vcu, int G, unsigned char* lds) {
    const bool deal = G == 256; const int x = bx & 7, r = bx >> 3;
    const int cnt = deal ? (r >= 16 ? 4 - ATT_LO : ATT_LO) : (512 - vcu + G - 1) / G;
    for (int i = 0; i < cnt; ++i) {
        const int u = deal ? x * 64 + (r >= 16 ? 16 * ATT_LO + (r - 16) * (4 - ATT_LO) + i : r * ATT_LO + i) : vcu + i * G;
        const int b = u >> 8, kvh = (u >> 6) & 3, tb = u & 63;
        const int lo = tb < 2 ? -tb : -2, hi = tb > 61 ? 63 - tb : 2, NT = 8 + (hi - lo + 1);
        const size_t seq0 = (size_t)MC + (size_t)b * SEQL, q0 = seq0 + 64 * tb, c0 = (size_t)(b * 2 + layer) * PAST;
        att::attn_unit(Qb + q0 * D + kvh * 512, CK + c0 * KVD + kvh * 128, CV + c0 * KVD + kvh * 128,
                       Kb + (seq0 + 64 * (tb + lo)) * KVD + kvh * 128, Vb + (seq0 + 64 * (tb + lo)) * KVD + kvh * 128,
                       8, NT, lo == -2 ? 8 : -1, hi == 2 ? NT - 1 : -1, sink + kvh * 4, ATT - ABR_ATT, (int)q0, ABR_ATT + kvh * 512, (char*)lds);
    }
}
__device__ __forceinline__ void attn_ctx_phase(const bf16* Qb, const bf16* Kb, const bf16* Vb, const float* sink, bf16* ATT, int vcu, int G, unsigned char* lds) {
    for (int u = vcu; u < 256; u += G) {
        const int b = u >> 4, kvh = (u >> 2) & 3, qb = u & 3;
        const size_t seq0 = (size_t)b * SEQC, q0 = seq0 + 64 * qb;
        att::attn_unit(Qb + q0 * D + kvh * 512, Kb, Vb, Kb + seq0 * KVD + kvh * 128, Vb + seq0 * KVD + kvh * 128, 0, 4, -1, -1, sink + kvh * 4, ATT - ABR_ATT, (int)q0, ABR_ATT + kvh * 512, (char*)lds);
    }
}

#define P_MOD   ((float*)(ws + WS_MOD))
#define P_CK    ((bf16*)(ws + WS_CK))
#define P_CV    ((bf16*)(ws + WS_CV))
#define P_X     ((float*)(ws + WS_X))
#define P_H     ((bf16*)(ws + WS_H))
#define P_ACT   ((bf16*)(ws + WS_ACT))
#define P_Q     ((bf16*)(ws + WS_Q))
#define P_K     ((bf16*)(ws + WS_K))
#define P_V     ((bf16*)(ws + WS_V))
#define P_GLU   ((bf16*)(ws + WS_GLU))
#define P_BG    ((bf16*)(ws + WS_BG))
#define P_CX    ((bf16*)(ws + WS_CX))
#define P_GATES ((bf16*)(ws + WS_GATES))
#define P_ABR   ((bf16*)(ws + WS_ABR))
#define P_ATT   (P_ABR + ABR_ATT)
#define P_CA    (P_ABR + ABR_CA)
#define P_CB    (P_ABR + ABR_CB)
#define P_MIX   ((bf16*)(ws + WS_MIX))
#define P_MODL  (P_MOD + (size_t)l * 3 * NMOD)
#define P_WL(off) ((const bf16*)(ws + WS_WT + (size_t)l * WT_LAYER + (off)))
__global__ void __launch_bounds__(NTHR, 2) fwd(Args args) {
    extern __shared__ __attribute__((aligned(16))) unsigned char lds[];
    const int tid = threadIdx.x;
    const int G0 = gridDim.x, bx = blockIdx.x, vcu0 = (G0 % 8 == 0) ? (bx % 8) * (G0 / 8) + bx / 8 : bx;
    LAS unsigned char* ldsl = (LAS unsigned char*)lds;
    volatile LAS unsigned* MISC = (volatile LAS unsigned*)(ldsl + MISC_OFF);
    for (int u = tid; u < (LDS_BYTES - LDSCTL_OFF) / 4; u += NTHR) ((LAS unsigned*)(ldsl + LDSCTL_OFF))[u] = 0u;
    __syncthreads();
    unsigned* barw = (unsigned*)(args.ws + WS_CTL) + CW_BAR;
    XcdBarrier bar; bar.bar = barw; bar.x = 0; bar.st = nullptr;
    if (!MK_PER_PHASE) bar = xcd_barrier_post(barw, MISC + 8);
#if MK_PER_PHASE
    const int lo = args.ph_lo, hi = args.ph_hi;
#define IN(k) (lo <= (k) && (k) < hi)
#else
#define IN(k) true
#endif
#ifndef DUP_PHASE
#define DUP_PHASE (-1)
#endif
#define EPI_T 0
#define PH_BEGIN const Args* A_ = fresh_args(); unsigned char* ws = A_->ws; (void)ws; const int vcu = fresh_i(vcu0), G = fresh_i(G0); (void)vcu; (void)G
#define FILL_JOB(j) ((l == 0 && (((FILL_MASK) >> (j)) & 1)) ? (j) : 0)
#define RUN_GEMM(EpiT, Eobj, Aptr, Bptr, N_, K_, LDA_, LDB_, kind_, job_) do { pg8::Gemm g{Aptr, Bptr, M, N_, K_}; typedef pg8::TailOrder<M, N_, K_, (((HT_MASK) >> (kind_)) & 1) != 0> SO_; SO_ S; S.init(fresh_i(G), fresh_i(bx)); \
        pg8::gemm_phase_ht<EpiT, SO_, K_, LDA_, LDB_>(ldsl + RING_OFF, g, S, Eobj); \
        { const int job__ = (job_); if (job__ > 0) { constexpr int nwg__ = (M / 256) * ((N_) / 256); const int G__ = fresh_i(G), bx__ = fresh_i(bx), Rem__ = nwg__ - (nwg__ / G__) * G__; \
            if (bx__ >= Rem__) filler(*fresh_args(), lds, job__, bx__ - Rem__, G__ - Rem__); } } } while (0)
#ifdef XTRA_BAR
#define XTRA_BAR_STMT xcd_barrier(bb_);
#else
#define XTRA_BAR_STMT
#endif
#ifndef HT_MASK
#define HT_MASK 0
#endif
#define REP(k) for (int rep_ = 0; rep_ < ((DUP_PHASE == (k)) ? 2 : 1); ++rep_)
#ifdef PROBE_PHASE
#define STAMP(k) do { unsigned long long* tsp_ = (unsigned long long*)(fresh_args()->ws + WS_CTL + 131072); if (blockIdx.x == 0 && threadIdx.x == 0) tsp_[(k) + 1] = __builtin_amdgcn_s_memrealtime(); } while (0)
#else
#define STAMP(k) do { } while (0)
#endif
#define SEAM(k) do { if (!MK_PER_PHASE && IN(k) && IN((k) + 1)) { XcdBarrier bb_ = bar; bb_.x = (unsigned)fresh_i((int)bar.x); bb_.bar = (unsigned*)(fresh_args()->ws + WS_CTL) + CW_BAR; xcd_barrier(bb_); XTRA_BAR_STMT STAMP(k); } } while (0)

#ifndef DUPX
#define DUPX (-1)
#endif
#ifndef PROBE_G
#define PROBE_G 0
#endif
#ifndef W_PNMIX
#define W_PNMIX true
#endif
#ifndef PROBE_HIT
#define PROBE_HIT 0
#endif
#define RUN_GEMM_Q(EpiT, Eobj, Aptr, Bptr, N_, K_, LDA_, LDB_, PM0_, NML_, TYPE_, MIX_, QID_) do { pg8::Gemm g{Aptr, Bptr, M, N_, K_}; g.hit = (dry_ && PROBE_HIT) ? 1 : 0; g.hitpm = PM0_; typedef pg8::QueueOrder<N_, PM0_, NML_, TYPE_, MIX_> SO_; SO_ S; \
        S.init(fresh_i(G), fresh_i(bx), (unsigned*)(ws + WS_CTL) + CW_Q + (size_t)((QID_) + (dry_ ? 50 : 0)) * 512); pg8::gemm_phase_ht<EpiT, SO_, K_, LDA_, LDB_>(ldsl + RING_OFF, g, S, Eobj); } while (0)
#define RUN_GEMM_D(EpiT, Eobj, Aptr, Bptr, N_, K_, LDA_, LDB_, PM0_, NML_, R_, KA_, KB_) RUN_GEMM_DX(EpiT, Eobj, Aptr, Bptr, N_, K_, LDA_, LDB_, PM0_, NML_, R_, KA_, KB_, false)
#define RUN_GEMM_DX(EpiT, Eobj, Aptr, Bptr, N_, K_, LDA_, LDB_, PM0_, NML_, R_, KA_, KB_, MIX_) do { pg8::Gemm g{Aptr, Bptr, M, N_, K_}; typedef pg8::DealOrder<N_, PM0_, NML_, R_, KA_, KB_, MIX_> SO_; SO_ S; S.init(fresh_i(G), fresh_i(bx)); \
        pg8::gemm_phase_ht<EpiT, SO_, K_, LDA_, LDB_>(ldsl + RING_OFF, g, S, Eobj); } while (0)
#define NORM_C(sub_, gin_, lc) { PH_BEGIN; const bool xt_ = !((sub_) == 0 && (lc) == 0); const float* xs_ = ((sub_) == 0 && (lc) == 0) ? A_->in[0] : (const float*)P_X; const int r_ = bx >> 3, x_ = bx & 7; \
        if (G != 256) norm_phase<false>(xs_, A_->in[gin_] + (lc) * D, P_MOD + (size_t)(lc) * 3 * NMOD, sub_, P_H, nullptr, vcu, G, 0, MC, xt_); \
        else { const int lo_ = 1024 * (x_ >> 1) + 512 * (x_ & 1); norm_phase<false>(xs_, A_->in[gin_] + (lc) * D, P_MOD + (size_t)(lc) * 3 * NMOD, sub_, P_H, nullptr, r_, 32, lo_, lo_ + 512, xt_); } }
#ifndef NORM_L_RANKS
#define NORM_L_RANKS 8
#endif
#define NORM_L(sub_, gin_, ll) { PH_BEGIN; const bool xt_ = !((sub_) == 0 && (ll) == 0); const float* xs_ = ((sub_) == 0 && (ll) == 0) ? A_->in[1] - (size_t)MC * D : (const float*)P_X; const int r_ = bx >> 3, x_ = bx & 7; \
        if (G != 256) norm_phase<false>(xs_, A_->in[gin_] + (ll) * D, P_MOD + (size_t)(ll) * 3 * NMOD, sub_, P_H, nullptr, vcu, G, MC, M, xt_); \
        else { constexpr int NR_ = ((sub_) == 1) ? 16 : NORM_L_RANKS;     \
            if (r_ >= 32 - NR_) { const int lo_ = MC + 1024 * x_; norm_phase<false>(xs_, A_->in[gin_] + (ll) * D, P_MOD + (size_t)(ll) * 3 * NMOD, sub_, P_H, nullptr, r_ - (32 - NR_), NR_, lo_, lo_ + 1024, xt_); } } }
#define WLY(lx, off) ((const bf16*)(ws + WS_WT + (size_t)(lx) * WT_LAYER + (off)))
#define MODLY(lx) (P_MOD + (size_t)(lx) * 3 * NMOD)
    STAMP(-1);
    if (IN(0)) REP(0) { prologue(*fresh_args(), lds, vcu0, G0); } SEAM(0);
    if (IN(1)) NORM_C(0, 8, 0)
    SEAM(1);
    for (int l = 0; l < 2; ++l) {
        const int pb = 2 + 12 * l;
        if (IN(pb + 0)) for (int rep_ = 0; rep_ < ((DUPX == 99 || (DUPX == 0 && l == 0)) ? 2 : 1); ++rep_) { const bool dry_ = ((DUPX == 99 || (DUPX == 0 && l == 0)) && rep_ == 0); (void)dry_; NORM_L(0, 8, l)
            { PH_BEGIN; pg8::EpiSwiglu E{P_ACT, ACT_LD}; RUN_GEMM_Q(pg8::EpiSwiglu, E, P_H, WLY(l, WT_1I), 2 * DFF, D, H_LD, WK_D, 0, 16, 0, false, l * 14 + 0); } }
        SEAM(pb + 0);
        if (IN(pb + 1)) for (int rep_ = 0; rep_ < ((DUPX == 99 || (DUPX == 1 && l == 0)) ? 2 : 1); ++rep_) { const bool dry_ = ((DUPX == 99 || (DUPX == 1 && l == 0)) && rep_ == 0); (void)dry_;
            { PH_BEGIN; pg8::EpiResid E{P_X, MODLY(l) + 2 * D, l == 0 ? A_->in[0] : (const float*)P_X, dry_ ? 0.f : 0.5f, l == 0 ? 0 : 1}; RUN_GEMM_Q(pg8::EpiResid, E, P_ACT, WLY(l, WT_1O), D, DFF, ACT_LD, WK_FF, 0, 16, 0, false, l * 14 + 1); }
            { PH_BEGIN; pg8::EpiSwiglu E{P_ACT, ACT_LD}; RUN_GEMM_Q(pg8::EpiSwiglu, E, P_H, WLY(l, WT_1I), 2 * DFF, D, H_LD, WK_D, 16, 32, 1, false, l * 14 + 2); } }
        SEAM(pb + 1);
        if (IN(pb + 2)) for (int rep_ = 0; rep_ < ((DUPX == 99 || (DUPX == 2 && l == 0)) ? 2 : 1); ++rep_) { const bool dry_ = ((DUPX == 99 || (DUPX == 2 && l == 0)) && rep_ == 0); (void)dry_; NORM_C(1, 11, l)
            { PH_BEGIN; pg8::EpiResid E{P_X, MODLY(l) + 2 * D, l == 0 ? A_->in[1] - (size_t)MC * D : (const float*)P_X, dry_ ? 0.f : 0.5f, l == 0 ? 0 : 1}; RUN_GEMM_Q(pg8::EpiResid, E, P_ACT, WLY(l, WT_1O), D, DFF, ACT_LD, WK_FF, 16, 32, 0, false, l * 14 + 3); } }
        SEAM(pb + 2);
        if (IN(pb + 3)) for (int rep_ = 0; rep_ < ((DUPX == 99 || (DUPX == 3 && l == 0)) ? 2 : 1); ++rep_) { const bool dry_ = ((DUPX == 99 || (DUPX == 3 && l == 0)) && rep_ == 0); (void)dry_; NORM_L(1, 11, l)
#if defined(PROBE_W)
            if (l == 0) {
#if PROBE_W == 1
                { PH_BEGIN; pg8::EpiSwiglu E{P_ACT, ACT_LD}; RUN_GEMM_Q(pg8::EpiSwiglu, E, P_H, WLY(l, WT_IN), INC, D, H_LD, WK_D, 0, 16, 0, true, 40); }
#else
                { PH_BEGIN; pg8::EpiWin E{ws, A_->out, l}; RUN_GEMM_Q(pg8::EpiWin, E, P_H, WLY(l, WT_IN), INC, D, H_LD, WK_D, 0, 16, 0, true, 40); }
#endif
            }
#endif
            { PH_BEGIN; pg8::EpiWin E{ws, A_->out, l}; RUN_GEMM_Q(pg8::EpiWin, E, P_H, WLY(l, WT_IN), INC, D, H_LD, WK_D, 0, 16, 0, W_PNMIX, l * 14 + 4); } }
        SEAM(pb + 3);
        if (IN(pb + 4)) for (int rep_ = 0; rep_ < ((DUPX == 99 || (DUPX == 4 && l == 0)) ? 2 : 1); ++rep_) { const bool dry_ = ((DUPX == 99 || (DUPX == 4 && l == 0)) && rep_ == 0); (void)dry_;
            { PH_BEGIN; attn_ctx_phase(P_Q, P_K, P_V, A_->in[13] + l * 16, P_ATT, vcu, G, lds); }
            { PH_BEGIN; conv_a_phase(P_GLU, A_->in[15] + (size_t)l * 31 * DCA, A_->in[16] + l * DCA, A_->in[17] + l * DCA, P_CA, lds, vcu, (MC / 16 - vcu + G - 1) / G, G); }
            { PH_BEGIN; conv_b_phase(P_BG, P_CX, A_->in[19] + (size_t)l * 3 * DCA, P_CB, vcu, G, 0, MC); } }
        SEAM(pb + 4);
        if (IN(pb + 5)) for (int rep_ = 0; rep_ < ((DUPX == 99 || (DUPX == 5 && l == 0)) ? 2 : 1); ++rep_) { const bool dry_ = ((DUPX == 99 || (DUPX == 5 && l == 0)) && rep_ == 0); (void)dry_;
            { PH_BEGIN; pg8::EpiMixK E{P_MIX, P_GATES}; RUN_GEMM_Q(pg8::EpiMixK, E, P_ABR, WLY(l, WT_MIXB), D, ABR_K, ABR_LD, WK_MIX, 0, 16, 0, false, l * 14 + 5); }
            { PH_BEGIN; pg8::EpiWin E{ws, A_->out, l}; RUN_GEMM_Q(pg8::EpiWin, E, P_H, WLY(l, WT_IN), INC, D, H_LD, WK_D, 16, 32, 1, W_PNMIX, l * 14 + 6); } }
        SEAM(pb + 5);
        if (IN(pb + 6)) for (int rep_ = 0; rep_ < ((DUPX == 99 || (DUPX == 6 && l == 0)) ? 2 : 1); ++rep_) { const bool dry_ = ((DUPX == 99 || (DUPX == 6 && l == 0)) && rep_ == 0); (void)dry_;
            if (!((PROBE_G & 4) && dry_)) { PH_BEGIN; pg8::EpiResid E{P_X, MODLY(l) + 5 * D, P_X, dry_ ? 0.f : 1.0f, 1}; RUN_GEMM_Q(pg8::EpiResid, E, P_MIX, WLY(l, WT_OUT), D, D, MIX_LD, WK_D, 0, 16, 0, false, l * 14 + 7); }
#ifdef ATT_DUP
            for (int rep_ = 0; rep_ < 2; ++rep_)
#endif
            if (!((PROBE_G & 1) && dry_)) { PH_BEGIN; attn_lat_phase(P_Q, P_K, P_V, P_CK, P_CV, A_->in[13] + l * 16, P_ATT, l, bx, vcu, G, lds); }
#ifdef CONV_DUP
            for (int crep_ = 0; crep_ < 2; ++crep_)
#endif
            if (!((PROBE_G & 2) && dry_)) { PH_BEGIN; const int r_ = bx >> 3, x_ = bx & 7; const int nu = (M - MC) / 16, u0 = MC / 16;
              if (G != 256) conv_a_phase(P_GLU, A_->in[15] + (size_t)l * 31 * DCA, A_->in[16] + l * DCA, A_->in[17] + l * DCA, P_CA, lds, u0 + vcu, (nu - vcu + G - 1) / G, G);
              else if (r_ < 16) conv_a_phase(P_GLU, A_->in[15] + (size_t)l * 31 * DCA, A_->in[16] + l * DCA, A_->in[17] + l * DCA, P_CA, lds, u0 + r_ * 8 + x_, CONV_LO, 128);
              else conv_a_phase(P_GLU, A_->in[15] + (size_t)l * 31 * DCA, A_->in[16] + l * DCA, A_->in[17] + l * DCA, P_CA, lds, u0 + 128 * CONV_LO + (r_ - 16) * 8 + x_, 4 - CONV_LO, 128); }
            if (!((PROBE_G & 8) && dry_)) { PH_BEGIN; conv_b_phase(P_BG, P_CX, A_->in[19] + (size_t)l * 3 * DCA, P_CB, vcu, G, MC, M); } }
        SEAM(pb + 6);
        if (IN(pb + 7)) for (int rep_ = 0; rep_ < ((DUPX == 99 || (DUPX == 7 && l == 0)) ? 2 : 1); ++rep_) { const bool dry_ = ((DUPX == 99 || (DUPX == 7 && l == 0)) && rep_ == 0); (void)dry_; PH_BEGIN; pg8::EpiMixK E{P_MIX, P_GATES}; RUN_GEMM_Q(pg8::EpiMixK, E, P_ABR, WLY(l, WT_MIXB), D, ABR_K, ABR_LD, WK_MIX, 16, 32, 0, false, l * 14 + 8); }
        SEAM(pb + 7);
        if (IN(pb + 8)) for (int rep_ = 0; rep_ < ((DUPX == 99 || (DUPX == 8 && l == 0)) ? 2 : 1); ++rep_) { const bool dry_ = ((DUPX == 99 || (DUPX == 8 && l == 0)) && rep_ == 0); (void)dry_; NORM_C(2, 22, l)
            { PH_BEGIN; pg8::EpiResid E{P_X, MODLY(l) + 5 * D, P_X, dry_ ? 0.f : 1.0f, 1}; RUN_GEMM_Q(pg8::EpiResid, E, P_MIX, WLY(l, WT_OUT), D, D, MIX_LD, WK_D, 16, 32, 0, false, l * 14 + 9); } }
        SEAM(pb + 8);
        if (IN(pb + 9)) for (int rep_ = 0; rep_ < ((DUPX == 99 || (DUPX == 9 && l == 0)) ? 2 : 1); ++rep_) { const bool dry_ = ((DUPX == 99 || (DUPX == 9 && l == 0)) && rep_ == 0); (void)dry_; NORM_L(2, 22, l)
            { PH_BEGIN; pg8::EpiSwiglu E{P_ACT, ACT_LD}; RUN_GEMM_Q(pg8::EpiSwiglu, E, P_H, WLY(l, WT_2I), 2 * DFF, D, H_LD, WK_D, 0, 16, 0, false, l * 14 + 10); } }
        SEAM(pb + 9);
        if (IN(pb + 10)) for (int rep_ = 0; rep_ < ((DUPX == 99 || (DUPX == 10 && l == 0)) ? 2 : 1); ++rep_) { const bool dry_ = ((DUPX == 99 || (DUPX == 10 && l == 0)) && rep_ == 0); (void)dry_;
            { PH_BEGIN; pg8::EpiResid E{P_X, MODLY(l) + 8 * D, P_X, dry_ ? 0.f : 0.5f, 1}; RUN_GEMM_Q(pg8::EpiResid, E, P_ACT, WLY(l, WT_2O), D, DFF, ACT_LD, WK_FF, 0, 16, 0, false, l * 14 + 11); }
            { PH_BEGIN; pg8::EpiSwiglu E{P_ACT, ACT_LD}; RUN_GEMM_Q(pg8::EpiSwiglu, E, P_H, WLY(l, WT_2I), 2 * DFF, D, H_LD, WK_D, 16, 32, 1, false, l * 14 + 12); } }
        SEAM(pb + 10);
        if (IN(pb + 11)) for (int rep_ = 0; rep_ < ((DUPX == 99 || (DUPX == 11 && l == 0)) ? 2 : 1); ++rep_) { const bool dry_ = ((DUPX == 99 || (DUPX == 11 && l == 0)) && rep_ == 0); (void)dry_;
            if (l == 0) NORM_C(0, 8, 1)
            else { PH_BEGIN; norm_phase<true>(P_X, A_->in[25], nullptr, 0, nullptr, A_->out, vcu, G, 0, MC, true); }
            { PH_BEGIN; pg8::EpiResid E{P_X, MODLY(l) + 8 * D, P_X, dry_ ? 0.f : 0.5f, 1}; RUN_GEMM_Q(pg8::EpiResid, E, P_ACT, WLY(l, WT_2O), D, DFF, ACT_LD, WK_FF, 16, 32, 0, false, l * 14 + 13); } }
        SEAM(pb + 11);
    }
#ifdef PROBE_PHASE
    { XcdBarrier bb_ = bar; bb_.x = (unsigned)fresh_i((int)bar.x); bb_.bar = (unsigned*)(fresh_args()->ws + WS_CTL) + CW_BAR; xcd_barrier(bb_); }
    { PH_BEGIN; const unsigned long long* ts = (const unsigned long long*)(ws + WS_CTL + 131072);
      const unsigned long long t1 = __hip_atomic_load(ts + (PROBE_PHASE >= 100 ? 26 : PROBE_PHASE + 1), __ATOMIC_RELAXED, __HIP_MEMORY_SCOPE_AGENT), t0 = __hip_atomic_load(ts + (PROBE_PHASE >= 100 ? 0 : PROBE_PHASE), __ATOMIC_RELAXED, __HIP_MEMORY_SCOPE_AGENT);
      const float us = (float)(t1 - t0) * 0.01f, fac = 1.f + us * (PROBE_PHASE >= 100 ? 1e-4f : 1e-3f);
      norm_phase<true>(P_X, A_->in[25], nullptr, 0, nullptr, A_->out, vcu, G, MC, M, true);
      __syncthreads(); asm volatile("s_waitcnt vmcnt(0)" ::: "memory");
      const int tid_ = fresh_tid(), wv_ = tid_ >> 6, ln_ = tid_ & 63;
      for (int m = MC + vcu * NWAVES + wv_; m < M; m += G * NWAVES) { f32x4* o = (f32x4*)(A_->out + (size_t)m * D) + ln_;
#pragma unroll
          for (int j = 0; j < 8; ++j) o[64 * j] = o[64 * j] * fac; } }
#else
#ifdef DUP26
    if (IN(26)) for (int rep_ = 0; rep_ < DUP26; ++rep_) { PH_BEGIN; norm_phase<true>(P_X, A_->in[25], nullptr, 0, nullptr, A_->out, fresh_i(vcu), fresh_i(G) + fresh_i(rep_) * 0, MC, M, true); }
#else
    if (IN(26)) { PH_BEGIN; norm_phase<true>(P_X, A_->in[25], nullptr, 0, nullptr, A_->out, vcu, G, MC, M, true); }
#endif
#endif
#undef IN
#undef SEAM
}

extern "C" void kernel_launch(void* const* d_in, const int* in_sizes, int n_in, void* d_out, int out_size, void* d_ws, size_t ws_size, hipStream_t stream) {
    static int grid = 0;
    if (grid == 0) {
        if (n_in != 26 || ws_size < WS_END) { fprintf(stderr, "kernel_launch: built for 26 inputs and >= %zu bytes of workspace; got n_in %d, ws %zu; nothing launched\n", (size_t)WS_END, n_in, ws_size); grid = -1; return; }
        int dev = 0, cus = 0, per_cu = 0;
        if (hipGetDevice(&dev) != hipSuccess || hipDeviceGetAttribute(&cus, hipDeviceAttributeMultiprocessorCount, dev) != hipSuccess) { fprintf(stderr, "kernel_launch: device query failed\n"); grid = -1; return; }
        if (hipFuncSetAttribute((const void*)fwd, hipFuncAttributeMaxDynamicSharedMemorySize, LDS_BYTES) != hipSuccess) { fprintf(stderr, "kernel_launch: hipFuncSetAttribute failed\n"); grid = -1; return; }
        if (hipOccupancyMaxActiveBlocksPerMultiprocessor(&per_cu, (const void*)fwd, NTHR, LDS_BYTES) != hipSuccess || per_cu < 1)
            fprintf(stderr, "kernel_launch: note: occupancy query reports %d workgroups per CU\n", per_cu);
        (void)hipGetLastError();
        grid = cus;
    }
    if (grid < 0) return;
    if (hipMemsetAsync((char*)d_ws + WS_CTL, 0, CTL_ZERO_BYTES, stream) != hipSuccess) { fprintf(stderr, "kernel_launch: hipMemsetAsync failed\n"); return; }
    Args a{};
    for (int i = 0; i < 26; ++i) a.in[i] = (const float*)d_in[i];
    a.out = (float*)d_out; a.ws = (unsigned char*)d_ws;
#if MK_PER_PHASE
    for (int p = 0; p < N_PHASES; ++p) { a.ph_lo = p; a.ph_hi = p + 1; hipLaunchKernelGGL(fwd, dim3(grid), dim3(NTHR), LDS_BYTES, stream, a); }
#else
    a.ph_lo = 0; a.ph_hi = N_PHASES; hipLaunchKernelGGL(fwd, dim3(grid), dim3(NTHR), LDS_BYTES, stream, a);
#endif
    const hipError_t le = hipPeekAtLastError();
    if (le != hipSuccess) fprintf(stderr, "kernel_launch: launch failed: %s\n", hipGetErrorName(le));
}
```
